# Optimizing an MI355X kernel written in HIP

```python
import jax, jax.numpy as jnp
from jax import lax
import numpy as np

D_MODEL = 1024
BATCH = 8
SEQ = 2048
DEPTH = 4

GRID_W = 64
CTX_LEN = 256
HEAD_DIM = 64
ROPE_THETA = 10000.0
EPS = 1e-6
Q_BLOCK = 128

GLA_HEADS = D_MODEL // 128
GLA_DK = 32
GLA_DV = 64
GLA_RANK = 16
GLA_TAU = 16.0
GLA_CHUNK = 64
GLA_QK_W = GLA_HEADS * GLA_DK
GLA_V_W = GLA_HEADS * GLA_DV
B_HEADS = D_MODEL // 128
B_KV_HEADS = 2
C_HEADS = D_MODEL // HEAD_DIM
C_KV_HEADS = 2
WINDOW = 128
FFN_HIDDEN = -(-8 * D_MODEL // (3 * 256)) * 256

EVEN_WIDTHS = (GLA_QK_W, GLA_QK_W, GLA_V_W, GLA_V_W, GLA_RANK, GLA_RANK,
               B_HEADS * HEAD_DIM, B_KV_HEADS * HEAD_DIM, B_KV_HEADS * HEAD_DIM)
EVEN_IN = sum(EVEN_WIDTHS)
EVEN_MIX = GLA_V_W + B_HEADS * HEAD_DIM
ODD_WIDTHS = (C_HEADS * HEAD_DIM, C_KV_HEADS * HEAD_DIM, C_KV_HEADS * HEAD_DIM)
ODD_IN = sum(ODD_WIDTHS)
ODD_MIX = C_HEADS * HEAD_DIM
N_EVEN = (DEPTH + 1) // 2
N_ODD = DEPTH // 2

kernel_name = "hybrid_gla_gqa_swa_prefix_dit"


def rms_norm(x, g):
    xf = x.astype(jnp.float32)
    y = xf * lax.rsqrt(jnp.mean(xf * xf, axis=-1, keepdims=True) + EPS)
    return y.astype(x.dtype) * g


def modulate(h, shift, scale):
    return h * (1 + scale) + shift


def split_cols(t, widths):
    idx = np.cumsum(np.array(widths))[:-1].tolist()
    return jnp.split(t, idx, axis=-1)


def heads(t, n_heads):
    return t.reshape(t.shape[0], t.shape[1], n_heads, -1)


def rope_tables(n_tokens, dtype):
    rows = n_tokens // GRID_W
    r, cidx = jnp.meshgrid(jnp.arange(rows), jnp.arange(GRID_W), indexing="ij")
    row = r.reshape(-1).astype(jnp.float32)
    col = cidx.reshape(-1).astype(jnp.float32)
    half = HEAD_DIM // 2
    inv = ROPE_THETA ** (-jnp.arange(0, half, 2, dtype=jnp.float32) / half)
    ang_r = row[:, None] * inv[None]
    ang_c = col[:, None] * inv[None]
    ang = jnp.concatenate([ang_r, ang_r, ang_c, ang_c], axis=-1)
    return jnp.cos(ang)[:, None, :].astype(dtype), jnp.sin(ang)[:, None, :].astype(dtype)


def apply_rope(x, cos, sin):
    q = HEAD_DIM // 4
    x0, x1, x2, x3 = x[..., :q], x[..., q:2 * q], x[..., 2 * q:3 * q], x[..., 3 * q:]
    rot = jnp.concatenate([-x1, x0, -x3, x2], axis=-1)
    return x * cos + rot * sin


def gla_chunk_scan(q, k, v, gk, s0):
    bn, L, H, _ = q.shape
    dv = v.shape[-1]
    nc = L // GLA_CHUNK

    def to_chunks(t):
        return t.astype(jnp.float32).reshape(bn, nc, GLA_CHUNK, H, t.shape[-1]).transpose(1, 0, 3, 2, 4)

    lower = jnp.tril(jnp.ones((GLA_CHUNK, GLA_CHUNK), dtype=bool))

    def step(S, inp):
        qc, kc, vc, gc = inp
        b = jnp.cumsum(gc, axis=2)
        o_inter = jnp.einsum("bhik,bhkv->bhiv", qc * jnp.exp(b), S)
        diff = jnp.where(lower[:, :, None], b[:, :, :, None, :] - b[:, :, None, :, :], -jnp.inf)
        A = jnp.einsum("bhik,bhjk,bhijk->bhij", qc, kc, jnp.exp(diff))
        o_intra = jnp.einsum("bhij,bhjv->bhiv", A, vc)
        b_last = b[:, :, -1]
        S = S * jnp.exp(b_last)[..., None] + jnp.einsum(
            "bhjk,bhjv->bhkv", kc * jnp.exp(b_last[:, :, None] - b), vc)
        return S, o_intra + o_inter

    S, o = lax.scan(step, s0, (to_chunks(q), to_chunks(k), to_chunks(v), to_chunks(gk)))
    o = o.transpose(1, 0, 3, 2, 4).reshape(bn, L, H, dv)
    return o, S


def dense_block_attention(q, k, v):
    bn, L, H, D = q.shape
    hkv = k.shape[2]
    nb = L // Q_BLOCK
    qb = q.reshape(bn, nb, Q_BLOCK, hkv, H // hkv, D).transpose(1, 0, 2, 3, 4, 5)
    scale = D ** -0.5

    def one(qblk):
        s = jnp.einsum("bqhgd,bkhd->bhgqk", qblk, k).astype(jnp.float32) * scale
        p = jax.nn.softmax(s, axis=-1).astype(v.dtype)
        return jnp.einsum("bhgqk,bkhd->bqhgd", p, v)

    o = lax.map(one, qb)
    return o.transpose(1, 0, 2, 3, 4, 5).reshape(bn, L, H * D)


def window_sink_attention(q, k, v, kc, vc, sink):
    bn, L, H, D = q.shape
    hkv = k.shape[2]
    g = H // hkv
    nb = L // Q_BLOCK
    band = Q_BLOCK + 2 * WINDOW
    pad = ((0, 0), (WINDOW, WINDOW), (0, 0), (0, 0))
    kp, vp = jnp.pad(k, pad), jnp.pad(v, pad)
    qb = q.reshape(bn, nb, Q_BLOCK, hkv, g, D).transpose(1, 0, 2, 3, 4, 5)
    sink_l = sink.reshape(hkv, g).astype(jnp.float32)
    scale = D ** -0.5
    s_ctx_len = kc.shape[1]

    def one(args):
        n, qblk = args
        start = n * Q_BLOCK
        kb = lax.dynamic_slice_in_dim(kp, start, band, axis=1)
        vb = lax.dynamic_slice_in_dim(vp, start, band, axis=1)
        qpos = start + jnp.arange(Q_BLOCK)
        kpos = start - WINDOW + jnp.arange(band)
        valid = (jnp.abs(qpos[:, None] - kpos[None, :]) <= WINDOW) & (kpos >= 0)[None] & (kpos < L)[None]
        s_loc = jnp.einsum("bqhgd,bkhd->bhgqk", qblk, kb).astype(jnp.float32) * scale
        s_loc = jnp.where(valid, s_loc, -jnp.inf)
        s_ctx = jnp.einsum("bqhgd,bkhd->bhgqk", qblk, kc).astype(jnp.float32) * scale
        s_sink = jnp.broadcast_to(sink_l[None, :, :, None, None], s_loc.shape[:-1] + (1,))
        p = jax.nn.softmax(jnp.concatenate([s_loc, s_ctx, s_sink], axis=-1), axis=-1).astype(v.dtype)
        return (jnp.einsum("bhgqk,bkhd->bqhgd", p[..., :band], vb)
                + jnp.einsum("bhgqk,bkhd->bqhgd", p[..., band:band + s_ctx_len], vc))

    o = lax.map(one, (jnp.arange(nb), qb))
    return o.transpose(1, 0, 2, 3, 4, 5).reshape(bn, L, H * D)


def ctx_sink_attention(q, k, v, sink):
    bn, Lc, H, D = q.shape
    hkv = k.shape[2]
    g = H // hkv
    qg = q.reshape(bn, Lc, hkv, g, D)
    s = jnp.einsum("bqhgd,bkhd->bhgqk", qg, k).astype(jnp.float32) * D ** -0.5
    s_sink = jnp.broadcast_to(sink.reshape(hkv, g).astype(jnp.float32)[None, :, :, None, None], s.shape[:-1] + (1,))
    p = jax.nn.softmax(jnp.concatenate([s, s_sink], axis=-1), axis=-1)[..., :Lc].astype(v.dtype)
    return jnp.einsum("bhgqk,bkhd->bqhgd", p, v).reshape(bn, Lc, H * D)


def even_mixer(hx, hc, w_in, w_out, gk_w, gk_b, gla_g, qn_g, kn_g, cos, sin, with_ctx):
    def project(h):
        gq, gkk, gv, gg, lr_f, lr_b, bq, bk, bv = split_cols(h @ w_in, EVEN_WIDTHS)
        dec_f = jax.nn.log_sigmoid((lr_f @ gk_w[0] + gk_b[0]).astype(jnp.float32)) / GLA_TAU
        dec_b = jax.nn.log_sigmoid((lr_b @ gk_w[1] + gk_b[1]).astype(jnp.float32)) / GLA_TAU
        gla = (heads(gq, GLA_HEADS) * GLA_DK ** -0.5, heads(gkk, GLA_HEADS), heads(gv, GLA_HEADS),
               gg, heads(dec_f, GLA_HEADS), heads(dec_b, GLA_HEADS))
        att = (rms_norm(heads(bq, B_HEADS), qn_g), rms_norm(heads(bk, B_KV_HEADS), kn_g), heads(bv, B_KV_HEADS))
        return gla, att

    (qx, kx, vx, gx, dfx, dbx), (aqx, akx, avx) = project(hx)
    (qc, kc, vc, gc, dfc, dbc), (aqc, akc, avc) = project(hc)

    def flip(t):
        return t[:, ::-1]

    s0 = jnp.zeros((hc.shape[0], GLA_HEADS, GLA_DK, GLA_DV), jnp.float32)
    ocf, s_f = gla_chunk_scan(qc, kc, vc, dfc, s0)
    ocb, s_b = gla_chunk_scan(flip(qc), flip(kc), flip(vc), flip(dbc), s0)
    oxf, _ = gla_chunk_scan(qx, kx, vx, dfx, s_f)
    oxb, _ = gla_chunk_scan(flip(qx), flip(kx), flip(vx), flip(dbx), s_b)

    def gla_out(o, gate):
        o = rms_norm(o.astype(gate.dtype), gla_g) * jax.nn.silu(heads(gate, GLA_HEADS))
        return o.reshape(o.shape[0], o.shape[1], GLA_V_W)

    aqx, akx = apply_rope(aqx, cos, sin), apply_rope(akx, cos, sin)
    k_all = jnp.concatenate([akx, akc], axis=1)
    v_all = jnp.concatenate([avx, avc], axis=1)
    ax = dense_block_attention(aqx, k_all, v_all)
    ox = jnp.concatenate([gla_out(oxf + flip(oxb), gx), ax], axis=-1) @ w_out
    if not with_ctx:
        return ox, None
    ac = dense_block_attention(aqc, akc, avc)
    oc = jnp.concatenate([gla_out(ocf + flip(ocb), gc), ac], axis=-1) @ w_out
    return ox, oc


def odd_mixer(hx, hc, w_in, w_out, sink, cos, sin, with_ctx):
    qx, kx, vx = split_cols(hx @ w_in, ODD_WIDTHS)
    qc, kc, vc = split_cols(hc @ w_in, ODD_WIDTHS)
    qx = apply_rope(heads(qx, C_HEADS), cos, sin)
    kx = apply_rope(heads(kx, C_KV_HEADS), cos, sin)
    vx = heads(vx, C_KV_HEADS)
    qc, kc, vc = heads(qc, C_HEADS), heads(kc, C_KV_HEADS), heads(vc, C_KV_HEADS)
    ox = window_sink_attention(qx, kx, vx, kc, vc, sink) @ w_out
    if not with_ctx:
        return ox, None
    oc = ctx_sink_attention(qc, kc, vc, sink) @ w_out
    return ox, oc


def swiglu(h, w1, w3, w2):
    return (jax.nn.silu(h @ w1) * (h @ w3)) @ w2


def setup_inputs(seed: int = 0) -> dict:
    key = jax.random.key(seed)
    ks = jax.random.split(key, 24)

    def nrm(k, shape, scale):
        return jax.random.normal(k, shape, jnp.float32) * scale

    def gain(k, shape):
        return 1.0 + nrm(k, shape, 0.02)

    D = D_MODEL
    return {
        "x": nrm(ks[0], (BATCH, SEQ, D), 1.0),
        "c": nrm(ks[1], (BATCH, D), 1.0),
        "ctx": nrm(ks[2], (BATCH, CTX_LEN, D), 1.0),
        "c_ctx": nrm(ks[3], (D,), 1.0),
        "ada_w": nrm(ks[4], (DEPTH, D, 6 * D), D ** -0.5),
        "ada_b": nrm(ks[5], (DEPTH, 6 * D), 0.02),
        "norm1_g": gain(ks[6], (DEPTH, D)),
        "norm2_g": gain(ks[7], (DEPTH, D)),
        "ffn_w1": nrm(ks[8], (DEPTH, D, FFN_HIDDEN), D ** -0.5),
        "ffn_w3": nrm(ks[9], (DEPTH, D, FFN_HIDDEN), D ** -0.5),
        "ffn_w2": nrm(ks[10], (DEPTH, FFN_HIDDEN, D), FFN_HIDDEN ** -0.5),
        "mixab_w_in": nrm(ks[11], (N_EVEN, D, EVEN_IN), D ** -0.5),
        "mixab_w_out": nrm(ks[12], (N_EVEN, EVEN_MIX, D), EVEN_MIX ** -0.5),
        "gla_gk_w": nrm(ks[13], (N_EVEN, 2, GLA_RANK, GLA_QK_W), GLA_RANK ** -0.5),
        "gla_gk_b": nrm(ks[14], (N_EVEN, 2, GLA_QK_W), 0.02),
        "gla_norm_g": gain(ks[15], (N_EVEN, GLA_DV)),
        "attn_qnorm_g": gain(ks[16], (N_EVEN, HEAD_DIM)),
        "attn_knorm_g": gain(ks[17], (N_EVEN, HEAD_DIM)),
        "win_w_in": nrm(ks[18], (N_ODD, D, ODD_IN), D ** -0.5),
        "win_w_out": nrm(ks[19], (N_ODD, ODD_MIX, D), ODD_MIX ** -0.5),
        "win_sink": nrm(ks[20], (N_ODD, C_HEADS), 0.5),
        "final_g": gain(ks[21], (D,)),
    }


def reference(x, c, ctx, c_ctx, ada_w, ada_b, norm1_g, norm2_g, ffn_w1, ffn_w3, ffn_w2,
              mixab_w_in, mixab_w_out, gla_gk_w, gla_gk_b, gla_norm_g, attn_qnorm_g, attn_knorm_g,
              win_w_in, win_w_out, win_sink, final_g):
    n_tokens = x.shape[1]
    cos, sin = rope_tables(n_tokens, x.dtype)
    sc = jax.nn.silu(c)
    scc = jax.nn.silu(c_ctx)[None]
    xc = ctx
    for l in range(DEPTH):
        with_ctx = l < DEPTH - 1
        mod_x = (sc @ ada_w[l] + ada_b[l])[:, None, :]
        mod_c = (scc @ ada_w[l] + ada_b[l])[:, None, :]
        sh1x, sc1x, g1x, sh2x, sc2x, g2x = jnp.split(mod_x, 6, axis=-1)
        sh1c, sc1c, g1c, sh2c, sc2c, g2c = jnp.split(mod_c, 6, axis=-1)
        hx = modulate(rms_norm(x, norm1_g[l]), sh1x, sc1x)
        hc = modulate(rms_norm(xc, norm1_g[l]), sh1c, sc1c)
        if l % 2 == 0:
            i = l // 2
            ox, oc = even_mixer(hx, hc, mixab_w_in[i], mixab_w_out[i], gla_gk_w[i], gla_gk_b[i],
                                gla_norm_g[i], attn_qnorm_g[i], attn_knorm_g[i], cos, sin, with_ctx)
        else:
            i = l // 2
            ox, oc = odd_mixer(hx, hc, win_w_in[i], win_w_out[i], win_sink[i], cos, sin, with_ctx)
        x = x + g1x * ox
        x = x + g2x * swiglu(modulate(rms_norm(x, norm2_g[l]), sh2x, sc2x), ffn_w1[l], ffn_w3[l], ffn_w2[l])
        if with_ctx:
            xc = xc + g1c * oc
            xc = xc + g2c * swiglu(modulate(rms_norm(xc, norm2_g[l]), sh2c, sc2c), ffn_w1[l], ffn_w3[l], ffn_w2[l])
    return rms_norm(x, final_g)
```

```cpp
#include <hip/hip_runtime.h>
#include <cstdio>
#include <cstdint>
namespace nv {
constexpr int D = 1024, NB = 8, SEQ = 2048, CTX = 256, DEPTH = 4, FFH = 2816, EVEN_IN = 2336, ODD_IN = 1280, ROWS = SEQ + CTX;
constexpr float EPS = 1e-6f;

__device__ __forceinline__ float siluf(float v) { return v / (1.f + __expf(-v)); }
__device__ __forceinline__ float wsum(float v) {
#pragma unroll
    for (int o = 1; o < 64; o <<= 1) v += __shfl_xor(v, o);
    return v;
}

__global__ void __launch_bounds__(256) k_mod(const float* c, const float* c_ctx, const float* ada_w, const float* ada_b, float* mod) {
    __shared__ float sc[9 * 1024];
    const int tid = threadIdx.x;
    for (int i = tid; i < 9 * 1024; i += 256) { const int j = i >> 10, k = i & 1023; const float v = j < 8 ? c[j * 1024 + k] : c_ctx[k]; sc[i] = siluf(v); }
    __syncthreads();
    const int gid = blockIdx.x * 256 + tid, l = gid / 6144, n = gid % 6144;
    float acc[9];
#pragma unroll
    for (int j = 0; j < 9; ++j) acc[j] = 0.f;
    const float* w = ada_w + (size_t)l * 1024 * 6144 + n;
    for (int k = 0; k < 1024; ++k) { const float wv = w[(size_t)k * 6144];
#pragma unroll
        for (int j = 0; j < 9; ++j) acc[j] += sc[j * 1024 + k] * wv; }
#pragma unroll
    for (int j = 0; j < 9; ++j) mod[((size_t)l * 9 + j) * 6144 + n] = acc[j] + ada_b[l * 6144 + n];
}

__global__ void __launch_bounds__(256) k_norm_mod(const float* src, const float* g, const float* shift, const float* scale, float* dst) {
    __shared__ float red[4];
    const int tid = threadIdx.x; const size_t row = blockIdx.x;
    const float4 v = *(const float4*)(src + row * D + tid * 4);
    float s = v.x * v.x + v.y * v.y + v.z * v.z + v.w * v.w;
    s = wsum(s); if ((tid & 63) == 0) red[tid >> 6] = s; __syncthreads();
    const float tot = red[0] + red[1] + red[2] + red[3];
    const float r = rsqrtf(tot * (1.f / D) + EPS);
    const float4 gg = *(const float4*)(g + tid * 4);
    float4 o; o.x = v.x * r * gg.x; o.y = v.y * r * gg.y; o.z = v.z * r * gg.z; o.w = v.w * r * gg.w;
    if (scale) { const float4 sc = *(const float4*)(scale + tid * 4), sh = *(const float4*)(shift + tid * 4);
        o.x = o.x * (1.f + sc.x) + sh.x; o.y = o.y * (1.f + sc.y) + sh.y; o.z = o.z * (1.f + sc.z) + sh.z; o.w = o.w * (1.f + sc.w) + sh.w; }
    *(float4*)(dst + row * D + tid * 4) = o;
}

__global__ void __launch_bounds__(256) k_sgemm(const float* A, int lda, const float* W, int ldw, float* C, int ldc, int M, int N, int K) {
    __shared__ float As[16][68];
    __shared__ float Ws[16][68];
    const int tid = threadIdx.x, tx = tid & 15, ty = tid >> 4, bm = blockIdx.y * 64, bn = blockIdx.x * 64;
    float acc[4][4];
#pragma unroll
    for (int i = 0; i < 4; ++i)
#pragma unroll
        for (int j = 0; j < 4; ++j) acc[i][j] = 0.f;
    const int ar = tid >> 2, ak = (tid & 3) * 4, wk = tid >> 4, wn = (tid & 15) * 4;
    for (int k0 = 0; k0 < K; k0 += 16) {
        const float4 a = *(const float4*)(A + (size_t)(bm + ar) * lda + k0 + ak);
        float4 w = make_float4(0.f, 0.f, 0.f, 0.f);
        if (bn + wn < N) w = *(const float4*)(W + (size_t)(k0 + wk) * ldw + bn + wn);
        As[ak + 0][ar] = a.x; As[ak + 1][ar] = a.y; As[ak + 2][ar] = a.z; As[ak + 3][ar] = a.w;
        *(float4*)&Ws[wk][wn] = w;
        __syncthreads();
#pragma unroll
        for (int kk = 0; kk < 16; ++kk) {
            const float4 av = *(const float4*)&As[kk][ty * 4], bv = *(const float4*)&Ws[kk][tx * 4];
            const float aa[4] = {av.x, av.y, av.z, av.w}, bb[4] = {bv.x, bv.y, bv.z, bv.w};
#pragma unroll
            for (int i = 0; i < 4; ++i)
#pragma unroll
                for (int j = 0; j < 4; ++j) acc[i][j] += aa[i] * bb[j];
        }
        __syncthreads();
    }
    if (bn + tx * 4 < N)
#pragma unroll
        for (int i = 0; i < 4; ++i) *(float4*)(C + (size_t)(bm + ty * 4 + i) * ldc + bn + tx * 4) = make_float4(acc[i][0], acc[i][1], acc[i][2], acc[i][3]);
}

__global__ void __launch_bounds__(256) k_resid(float* x, const float* gate, const float* t) {
    const size_t o = (size_t)blockIdx.x * D + threadIdx.x * 4;
    float4 xv = *(float4*)(x + o); const float4 tv = *(const float4*)(t + o), gv = *(const float4*)(gate + threadIdx.x * 4);
    xv.x += gv.x * tv.x; xv.y += gv.y * tv.y; xv.z += gv.z * tv.z; xv.w += gv.w * tv.w; *(float4*)(x + o) = xv;
}
__global__ void __launch_bounds__(256) k_swiglu(float* a1, const float* a3, size_t n) {
    const size_t i = (size_t)blockIdx.x * 256 + threadIdx.x; if (i < n) a1[i] = siluf(a1[i]) * a3[i];
}
__global__ void __launch_bounds__(256) k_copy(float* dst, const float* src, size_t n4) {
    const size_t i = (size_t)blockIdx.x * 256 + threadIdx.x; if (i < n4) ((float4*)dst)[i] = ((const float4*)src)[i];
}

__global__ void k_rope_tab(float2* tab) {
    const int p = threadIdx.x >> 4, i = threadIdx.x & 15;
    const float inv = powf(10000.f, -(float)(2 * i) / 32.f);
    const float ang = (float)p * inv;
    const double x = (double)ang; const double twopi = 6.283185307179586476925286766559;
    double r = x - twopi * __builtin_rint(x / twopi);
    const double hp = 1.5707963267948966192313216916398; const double q = __builtin_rint(r / hp); r -= q * hp; const int qi = ((int)q) & 3;
    const double r2 = r * r;
    double s = r * (1.0 + r2 * (-1.0 / 6 + r2 * (1.0 / 120 + r2 * (-1.0 / 5040 + r2 * (1.0 / 362880 + r2 * (-1.0 / 39916800 + r2 * (1.0 / 6227020800.0)))))));
    double c = 1.0 + r2 * (-0.5 + r2 * (1.0 / 24 + r2 * (-1.0 / 720 + r2 * (1.0 / 40320 + r2 * (-1.0 / 3628800 + r2 * (1.0 / 479001600.0 + r2 * (-1.0 / 87178291200.0)))))));
    double cs, sn;
    if (qi == 0) { cs = c; sn = s; } else if (qi == 1) { cs = -s; sn = c; } else if (qi == 2) { cs = -c; sn = -s; } else { cs = s; sn = -c; }
    tab[threadIdx.x] = make_float2((float)cs, (float)sn);
}

__global__ void __launch_bounds__(64) k_head_prep(float* P, int ld, int col0, const float* gn, const float2* tab, float outscale) {
    const int tok = blockIdx.x, h = blockIdx.y, d = threadIdx.x;
    float* p = P + (size_t)tok * ld + col0 + h * 64;
    float v = p[d];
    if (gn) { const float ms = wsum(v * v) * (1.f / 64.f); v = v * rsqrtf(ms + EPS) * gn[d]; }
    if (tok < SEQ) {
        const int i = d & 15, pos = (d < 32) ? (tok >> 6) : (tok & 63);
        const float2 cs = tab[pos * 16 + i];
        const float partner = __shfl_xor(v, 16);
        const float rot = (d & 16) ? partner : -partner;
        v = v * cs.x + rot * cs.y;
    }
    p[d] = v * outscale;
}

__global__ void __launch_bounds__(256) k_gla_dec(const float* P, const float* gkw, const float* gkb, float* dec) {
    const int tok = blockIdx.x, dir = blockIdx.y, col = threadIdx.x;
    const float* lr = P + (size_t)tok * EVEN_IN + 1536 + dir * 16;
    float x = gkb[dir * 256 + col];
#pragma unroll
    for (int r = 0; r < 16; ++r) x += lr[r] * gkw[(dir * 16 + r) * 256 + col];
    const float ls = fminf(x, 0.f) - log1pf(__expf(-fabsf(x)));
    dec[((size_t)dir * ROWS + tok) * 256 + col] = ls * (1.f / 16.f);
}
__global__ void __launch_bounds__(64) k_gla_scan(const float* P, const float* dec, float* O) {
    const int h = blockIdx.x, dir = blockIdx.y, dv = threadIdx.x;
    float S[32];
#pragma unroll
    for (int k = 0; k < 32; ++k) S[k] = 0.f;
    const float qs = 0.17677669529663687f;
    for (int step = 0; step < ROWS; ++step) {
        int tok;
        if (dir == 0) tok = step < CTX ? SEQ + step : step - CTX;
        else tok = step < CTX ? SEQ + (CTX - 1 - step) : (SEQ - 1) - (step - CTX);
        const float* pr = P + (size_t)tok * EVEN_IN;
        const float* gq = pr + h * 32; const float* gk = pr + 256 + h * 32; const float* gd = dec + ((size_t)dir * ROWS + tok) * 256 + h * 32;
        const float v = pr[512 + h * 64 + dv];
        float o = 0.f;
#pragma unroll
        for (int k = 0; k < 32; ++k) { S[k] = __expf(gd[k]) * S[k] + gk[k] * v; o += gq[k] * qs * S[k]; }
        O[((size_t)dir * ROWS + tok) * 512 + h * 64 + dv] = o;
    }
}
__global__ void __launch_bounds__(512) k_gla_out(const float* O, const float* P, const float* gg, float* MIX) {
    const int tok = blockIdx.x, col = threadIdx.x;
    const float o = O[(size_t)tok * 512 + col] + O[((size_t)ROWS + tok) * 512 + col];
    const float ms = wsum(o * o) * (1.f / 64.f);
    const float gate = P[(size_t)tok * EVEN_IN + 1024 + col];
    MIX[(size_t)tok * D + col] = o * rsqrtf(ms + EPS) * gg[col & 63] * siluf(gate);
}

struct AttnArgs { const float* Q; int ldq; const float* K; const float* V; int ldkv; float* O; int ldo; int group; int q_row0; int k1_lo, k1_hi, window; int k2_lo, k2_hi; const float* sink; };
__global__ void __launch_bounds__(128) k_attn(AttnArgs a) {
    __shared__ float Ks[32][64];
    __shared__ float Vs[32][64];
    const int tid = threadIdx.x, h = blockIdx.y, kvh = h / a.group;
    const int q0 = a.q_row0 + blockIdx.x * 128, qi = q0 + tid;
    float q[64], o[64];
    { const float* qp = a.Q + (size_t)qi * a.ldq + h * 64;
#pragma unroll
      for (int d = 0; d < 64; d += 4) { const float4 v = *(const float4*)(qp + d); q[d] = v.x * 0.125f; q[d + 1] = v.y * 0.125f; q[d + 2] = v.z * 0.125f; q[d + 3] = v.w * 0.125f; }
    }
#pragma unroll
    for (int d = 0; d < 64; ++d) o[d] = 0.f;
    float m = -1e30f, l = 0.f;
    for (int rng = 0; rng < 2; ++rng) {
        int lo = rng == 0 ? a.k1_lo : a.k2_lo, hi = rng == 0 ? a.k1_hi : a.k2_hi;
        const bool win = (rng == 0) && a.window > 0;
        if (win) { lo = max(lo, q0 - a.window); hi = min(hi, q0 + 127 + a.window + 1); lo &= ~31; hi = (hi + 31) & ~31; hi = min(hi, a.k1_hi); }
        for (int t0 = lo; t0 < hi; t0 += 32) {
            __syncthreads();
            for (int i = tid; i < 32 * 16; i += 128) { const int r = i >> 4, c4 = (i & 15) * 4;
                *(float4*)&Ks[r][c4] = *(const float4*)(a.K + (size_t)(t0 + r) * a.ldkv + kvh * 64 + c4);
                *(float4*)&Vs[r][c4] = *(const float4*)(a.V + (size_t)(t0 + r) * a.ldkv + kvh * 64 + c4); }
            __syncthreads();
            float s[32]; float mt = -1e30f; unsigned vmask = 0u;
#pragma unroll
            for (int j = 0; j < 32; ++j) {
                float acc = 0.f;
#pragma unroll
                for (int d = 0; d < 64; ++d) acc += q[d] * Ks[j][d];
                const int kp = t0 + j; const bool valid = !win || (abs(qi - kp) <= a.window);
                s[j] = acc; if (valid) { vmask |= (1u << j); mt = fmaxf(mt, acc); }
            }
            if (vmask) {
                const float mn = fmaxf(m, mt), corr = __expf(m - mn);
                l *= corr;
#pragma unroll
                for (int d = 0; d < 64; ++d) o[d] *= corr;
#pragma unroll
                for (int j = 0; j < 32; ++j) {
                    const float p = ((vmask >> j) & 1u) ? __expf(s[j] - mn) : 0.f;
                    l += p;
#pragma unroll
                    for (int d = 0; d < 64; ++d) o[d] += p * Vs[j][d];
                }
                m = mn;
            }
        }
    }
    if (a.sink) { const float sk = a.sink[h]; const float mn = fmaxf(m, sk), corr = __expf(m - mn); l = l * corr + __expf(sk - mn);
#pragma unroll
        for (int d = 0; d < 64; ++d) o[d] *= corr; }
    const float rl = 1.f / l;
    float* op = a.O + (size_t)qi * a.ldo + h * 64;
#pragma unroll
    for (int d = 0; d < 64; d += 4) *(float4*)(op + d) = make_float4(o[d] * rl, o[d + 1] * rl, o[d + 2] * rl, o[d + 3] * rl);
}

struct WS { float *mod, *XC, *H1, *PROJ, *DEC, *OG, *MIX, *TMP, *A1, *A3; float2* tab; };
inline size_t carve(WS& w, float* base) {
    size_t o = 0; auto take = [&](size_t n) { float* p = base + o; o += (n + 63) & ~(size_t)63; return p; };
    w.mod = take((size_t)DEPTH * 9 * 6144); w.tab = (float2*)take(64 * 16 * 2); w.XC = take((size_t)NB * CTX * D);
    w.H1 = take((size_t)ROWS * D); w.PROJ = take((size_t)ROWS * EVEN_IN); w.DEC = take((size_t)2 * ROWS * 256); w.OG = take((size_t)2 * ROWS * 512);
    w.MIX = take((size_t)ROWS * D); w.TMP = take((size_t)ROWS * D); w.A1 = take((size_t)ROWS * FFH); w.A3 = take((size_t)ROWS * FFH);
    return o;
}

struct Inputs { const float *x, *c, *ctx, *c_ctx, *ada_w, *ada_b, *norm1_g, *norm2_g, *ffn_w1, *ffn_w3, *ffn_w2, *mixab_w_in, *mixab_w_out, *gla_gk_w, *gla_gk_b, *gla_norm_g, *attn_qnorm_g, *attn_knorm_g, *win_w_in, *win_w_out, *win_sink, *final_g; };

inline void gemm(hipStream_t st, const float* A, int lda, const float* W, int ldw, float* C, int ldc, int M, int N, int K) {
    hipLaunchKernelGGL(k_sgemm, dim3((N + 63) / 64, M / 64), dim3(256), 0, st, A, lda, W, ldw, C, ldc, M, N, K);
}

inline void forward(hipStream_t st, const Inputs& in, float* X, float* wsf, int b0, int b1) {
    WS w; carve(w, wsf);
    hipLaunchKernelGGL(k_mod, dim3(DEPTH * 6144 / 256), dim3(256), 0, st, in.c, in.c_ctx, in.ada_w, in.ada_b, w.mod);
    hipLaunchKernelGGL(k_rope_tab, dim3(1), dim3(1024), 0, st, w.tab);
    for (int b = b0; b < b1; ++b) {
        float* xb = X + (size_t)b * SEQ * D; float* xc = w.XC + (size_t)b * CTX * D;
        hipLaunchKernelGGL(k_copy, dim3(SEQ * D / 4 / 256), dim3(256), 0, st, xb, in.x + (size_t)b * SEQ * D, (size_t)SEQ * D / 4);
        hipLaunchKernelGGL(k_copy, dim3(CTX * D / 4 / 256), dim3(256), 0, st, xc, in.ctx + (size_t)b * CTX * D, (size_t)CTX * D / 4);
        for (int l = 0; l < DEPTH; ++l) {
            const bool with_ctx = l < DEPTH - 1; const int i = l / 2;
            const float* mx = w.mod + ((size_t)l * 9 + b) * 6144; const float* mc = w.mod + ((size_t)l * 9 + 8) * 6144;
            hipLaunchKernelGGL(k_norm_mod, dim3(SEQ), dim3(256), 0, st, xb, in.norm1_g + l * D, mx, mx + D, w.H1);
            hipLaunchKernelGGL(k_norm_mod, dim3(CTX), dim3(256), 0, st, xc, in.norm1_g + l * D, mc, mc + D, w.H1 + (size_t)SEQ * D);
            if ((l & 1) == 0) {
                gemm(st, w.H1, D, in.mixab_w_in + (size_t)i * D * EVEN_IN, EVEN_IN, w.PROJ, EVEN_IN, ROWS, EVEN_IN, D);
                hipLaunchKernelGGL(k_gla_dec, dim3(ROWS, 2), dim3(256), 0, st, w.PROJ, in.gla_gk_w + (size_t)i * 2 * 16 * 256, in.gla_gk_b + (size_t)i * 2 * 256, w.DEC);
                hipLaunchKernelGGL(k_gla_scan, dim3(8, 2), dim3(64), 0, st, w.PROJ, w.DEC, w.OG);
                hipLaunchKernelGGL(k_gla_out, dim3(ROWS), dim3(512), 0, st, w.OG, w.PROJ, in.gla_norm_g + i * 64, w.MIX);
                hipLaunchKernelGGL(k_head_prep, dim3(ROWS, 8), dim3(64), 0, st, w.PROJ, EVEN_IN, 1568, in.attn_qnorm_g + i * 64, w.tab, 1.f);
                hipLaunchKernelGGL(k_head_prep, dim3(ROWS, 2), dim3(64), 0, st, w.PROJ, EVEN_IN, 2080, in.attn_knorm_g + i * 64, w.tab, 1.f);
                AttnArgs a{w.PROJ + 1568, EVEN_IN, w.PROJ + 2080, w.PROJ + 2208, EVEN_IN, w.MIX + 512, D, 4, 0, 0, ROWS, 0, 0, 0, nullptr};
                hipLaunchKernelGGL(k_attn, dim3(SEQ / 128, 8), dim3(128), 0, st, a);
                if (with_ctx) { AttnArgs c2 = a; c2.q_row0 = SEQ; c2.k1_lo = SEQ; c2.k1_hi = ROWS; hipLaunchKernelGGL(k_attn, dim3(CTX / 128, 8), dim3(128), 0, st, c2); }
                gemm(st, w.MIX, D, in.mixab_w_out + (size_t)i * D * D, D, w.TMP, D, with_ctx ? ROWS : SEQ, D, D);
            } else {
                gemm(st, w.H1, D, in.win_w_in + (size_t)i * D * ODD_IN, ODD_IN, w.PROJ, ODD_IN, ROWS, ODD_IN, D);
                hipLaunchKernelGGL(k_head_prep, dim3(ROWS, 16), dim3(64), 0, st, w.PROJ, ODD_IN, 0, (const float*)nullptr, w.tab, 1.f);
                hipLaunchKernelGGL(k_head_prep, dim3(ROWS, 2), dim3(64), 0, st, w.PROJ, ODD_IN, 1024, (const float*)nullptr, w.tab, 1.f);
                AttnArgs a{w.PROJ, ODD_IN, w.PROJ + 1024, w.PROJ + 1152, ODD_IN, w.MIX, D, 8, 0, 0, SEQ, 128, SEQ, ROWS, in.win_sink + i * 16};
                hipLaunchKernelGGL(k_attn, dim3(SEQ / 128, 16), dim3(128), 0, st, a);
                if (with_ctx) { AttnArgs c2 = a; c2.q_row0 = SEQ; c2.k1_lo = SEQ; c2.k1_hi = ROWS; c2.window = 0; c2.k2_lo = 0; c2.k2_hi = 0; hipLaunchKernelGGL(k_attn, dim3(CTX / 128, 16), dim3(128), 0, st, c2); }
                gemm(st, w.MIX, D, in.win_w_out + (size_t)i * D * D, D, w.TMP, D, with_ctx ? ROWS : SEQ, D, D);
            }
            hipLaunchKernelGGL(k_resid, dim3(SEQ), dim3(256), 0, st, xb, mx + 2 * D, w.TMP);
            if (with_ctx) hipLaunchKernelGGL(k_resid, dim3(CTX), dim3(256), 0, st, xc, mc + 2 * D, w.TMP + (size_t)SEQ * D);
            const int rows = with_ctx ? ROWS : SEQ;
            hipLaunchKernelGGL(k_norm_mod, dim3(SEQ), dim3(256), 0, st, xb, in.norm2_g + l * D, mx + 3 * D, mx + 4 * D, w.H1);
            if (with_ctx) hipLaunchKernelGGL(k_norm_mod, dim3(CTX), dim3(256), 0, st, xc, in.norm2_g + l * D, mc + 3 * D, mc + 4 * D, w.H1 + (size_t)SEQ * D);
            gemm(st, w.H1, D, in.ffn_w1 + (size_t)l * D * FFH, FFH, w.A1, FFH, rows, FFH, D);
            gemm(st, w.H1, D, in.ffn_w3 + (size_t)l * D * FFH, FFH, w.A3, FFH, rows, FFH, D);
            hipLaunchKernelGGL(k_swiglu, dim3((unsigned)(((size_t)rows * FFH + 255) / 256)), dim3(256), 0, st, w.A1, w.A3, (size_t)rows * FFH);
            gemm(st, w.A1, FFH, in.ffn_w2 + (size_t)l * FFH * D, D, w.TMP, D, rows, D, FFH);
            hipLaunchKernelGGL(k_resid, dim3(SEQ), dim3(256), 0, st, xb, mx + 5 * D, w.TMP);
            if (with_ctx) hipLaunchKernelGGL(k_resid, dim3(CTX), dim3(256), 0, st, xc, mc + 5 * D, w.TMP + (size_t)SEQ * D);
        }
        hipLaunchKernelGGL(k_norm_mod, dim3(SEQ), dim3(256), 0, st, xb, in.final_g, (const float*)nullptr, (const float*)nullptr, xb);
    }
}
}
extern "C" void kernel_launch(void* const* d_in, const int* in_sizes, int n_in, void* d_out, int out_size, void* d_ws, size_t ws_size, hipStream_t stream) {
    nv::Inputs in;
    const float** p = (const float**)&in;
    for (int i = 0; i < 22; ++i) p[i] = (const float*)d_in[i];
    nv::forward(stream, in, (float*)d_out, (float*)d_ws, 0, nv::NB);
}
```

```cpp
#define MK_PER_PHASE 1
#include <hip/hip_runtime.h>
#include <hip/hip_bf16.h>
#include <cstdio>
#include <cstdint>
#include <cmath>
namespace cfg {
constexpr int D = 1024, NB = 8, SEQ = 2048, CTX = 256, RB = SEQ + CTX  , M = NB * RB  , FFH = 2816;
constexpr int LDE = 2560  , LDO = 1280, DEPTH = 4;
constexpr float EPS = 1e-6f, LOG2E = 1.4426950408889634f, C2 = 0.125f * 1.4426950408889634f;
constexpr int E_GQ = 0, E_GK = 256, E_GV = 512, E_GG = 1024, E_BQ = 1536, E_BK = 2048, E_BV = 2176, E_LR = 2304;
constexpr int O_Q = 0, O_K = 1024, O_V = 1152;
}
__device__ __forceinline__ int olane() { int l = __builtin_amdgcn_mbcnt_hi(~0u, __builtin_amdgcn_mbcnt_lo(~0u, 0u)); asm volatile("" : "+v"(l)); return l; }
__device__ __forceinline__ int obid() { int b = blockIdx.x; asm volatile("" : "+s"(b)); return b; }
__device__ __forceinline__ int ogrid() { int g = gridDim.x; asm volatile("" : "+s"(g)); return g; }
namespace pg8 {
#define PG8_LAS __attribute__((address_space(3)))
typedef unsigned short bf16_t;
typedef short bf16x8 __attribute__((ext_vector_type(8)));
typedef float f32x4 __attribute__((ext_vector_type(4)));
typedef unsigned u32x4 __attribute__((ext_vector_type(4)));
constexpr int BM = 256, BK = 64, HALF = 128, HTB = HALF * BK * 2  , STAGE_BYTES = 8 * HTB, NXCD = 8, WGM = 8;

__host__ __device__ __forceinline__ int lds_byte(int r, int c) { const int st = (r >> 4) * 2 + (c >> 5), rr = r & 15, cc = c & 31, ob = rr * 64 + cc * 2; return st * 1024 + (ob ^ (((ob >> 9) & 1) << 5)); }
__host__ __device__ __forceinline__ void stage_rc(int b, int& R, int& C) { const int st = b / 1024, sb = b % 1024, swz = sb ^ (((sb >> 9) & 1) << 5); R = (st >> 1) * 16 + swz / 64; C = (st & 1) * 32 + (swz % 64) / 2; }
__host__ __device__ __forceinline__ int perm32(int rho) { const int n = rho >> 4, i = rho & 15; return 8 * (i >> 2) + 4 * n + (i & 3); }

struct Unit { int pm, pn; };
struct Gemm { const bf16_t* A; const bf16_t* Bt; int M, N, K; };

struct StaticOrder {
    int nM, nN, nwg, G, c;
    __host__ __device__ void init(int M, int N, int G_, int c_) { nM = M / BM; nN = N / BM; nwg = nM * nN; G = G_; c = c_; }
    __host__ __device__ bool next(int i, Unit& u) const {
        const long L = (long)i * G + c; if (L >= nwg) return false;
        int wgid = (int)L; { const int q = nwg / NXCD, r = nwg % NXCD, xcd = wgid % NXCD, off = wgid / NXCD; wgid = (xcd < r ? xcd * (q + 1) : r * (q + 1) + (xcd - r) * q) + off; }
        const int nig = WGM * nN, gid = wgid / nig, fm = gid * WGM, gsz = (nM - fm) < WGM ? (nM - fm) : WGM;
        u.pm = fm + ((wgid % nig) % gsz); u.pn = (wgid % nig) / gsz; return true;
    }
    __device__ __forceinline__ void a_ready(const Unit&) const {}
    __device__ __forceinline__ void done(const Unit&) const {}
};

__device__ __forceinline__ unsigned cvt_pk_bf16(float lo, float hi) { unsigned r; asm volatile("v_cvt_pk_bf16_f32 %0, %1, %2" : "=v"(r) : "v"(lo), "v"(hi)); return r; }
struct EpiProj {
    static constexpr bool PERM = true, AFTER_DRAIN = false;
    bf16_t* O; int ldc; float* LR; int lr_pn;
    __device__ __forceinline__ void operator()(const f32x4 (&acc)[2][2][4][2], const Unit& u, int wr, int wc, int fr_in, int fq_in) const {
        int fr = fr_in, fq = fq_in; asm volatile("" : "+v"(fr), "+v"(fq));
        const int row0 = u.pm * BM + wr * 64 + fr;
        if (u.pn == lr_pn) {
            if (wc == 0) {
#pragma unroll
                for (int ai = 0; ai < 2; ++ai)
#pragma unroll
                    for (int m = 0; m < 4; ++m) { float* p = LR + (size_t)(row0 + ai * HALF + m * 16) * 32 + 8 * fq; *(f32x4*)p = acc[ai][0][m][0]; *(f32x4*)(p + 4) = acc[ai][0][m][1]; }
            }
            return;
        }
        const int col0 = u.pn * BM + wc * 32 + 8 * fq;
#pragma unroll
        for (int ai = 0; ai < 2; ++ai)
#pragma unroll
            for (int m = 0; m < 4; ++m) { bf16_t* rowp = O + (size_t)(row0 + ai * HALF + m * 16) * ldc + col0;
#pragma unroll
                for (int bj = 0; bj < 2; ++bj) { const f32x4 v0 = acc[ai][bj][m][0], v1 = acc[ai][bj][m][1];
                    u32x4 w; w.x = cvt_pk_bf16(v0[0], v0[1]); w.y = cvt_pk_bf16(v0[2], v0[3]); w.z = cvt_pk_bf16(v1[0], v1[1]); w.w = cvt_pk_bf16(v1[2], v1[3]);
                    *(u32x4*)(rowp + bj * HALF) = w; } }
    }
};
__device__ __forceinline__ float silu_mul(float a, float b) { return a * __builtin_amdgcn_rcpf(1.f + __builtin_amdgcn_exp2f(-1.4426950408889634f * a)) * b; }
struct EpiSwiglu {
    static constexpr bool PERM = true, AFTER_DRAIN = false;
    bf16_t* H; int ldh;
    __device__ __forceinline__ void operator()(const f32x4 (&acc)[2][2][4][2], const Unit& u, int wr, int wc, int fr_in, int fq_in) const {
        int fr = fr_in, fq = fq_in; asm volatile("" : "+v"(fr), "+v"(fq));
        const int row0 = u.pm * BM + wr * 64 + fr, col0 = u.pn * HALF + wc * 32 + 8 * fq;
#pragma unroll
        for (int ai = 0; ai < 2; ++ai)
#pragma unroll
            for (int m = 0; m < 4; ++m) { const f32x4 a0 = acc[ai][0][m][0], a1 = acc[ai][0][m][1], b0 = acc[ai][1][m][0], b1 = acc[ai][1][m][1];
                u32x4 w; w.x = cvt_pk_bf16(silu_mul(a0[0], b0[0]), silu_mul(a0[1], b0[1])); w.y = cvt_pk_bf16(silu_mul(a0[2], b0[2]), silu_mul(a0[3], b0[3]));
                w.z = cvt_pk_bf16(silu_mul(a1[0], b1[0]), silu_mul(a1[1], b1[1])); w.w = cvt_pk_bf16(silu_mul(a1[2], b1[2]), silu_mul(a1[3], b1[3]));
                *(u32x4*)(H + (size_t)(row0 + ai * HALF + m * 16) * ldh + col0) = w; }
    }
};
struct EpiResid {
    static constexpr bool PERM = false, AFTER_DRAIN = false;
    const float* xin_lat; const float* xin_ctx; float* xout_lat; float* xout_ctx; const float* gate_base;
    __device__ __forceinline__ void operator()(const f32x4 (&acc)[2][2][4][2], const Unit& u, int wr, int wc, int fr_in, int fq_in) const {
        int fr = fr_in, fq = fq_in; asm volatile("" : "+v"(fr), "+v"(fq));
        const int b = u.pm / 9, j = u.pm - 9 * b;
        const float* xin; float* xout; const float* gate;
        if (j < 8) { const size_t off = ((size_t)b * 2048 + 256 * j) * 1024; xin = xin_lat + off; xout = xout_lat + off; gate = gate_base + 6144 * b; }
        else { const size_t off = (size_t)b * 256 * 1024; xin = xin_ctx + off; xout = xout_ctx + off; gate = gate_base + 6144 * 8; }
        const int col0 = u.pn * BM + wc * 32 + 4 * fq;
        xin += col0; xout += col0; gate += col0;
#pragma unroll
        for (int ai = 0; ai < 2; ++ai)
#pragma unroll
            for (int m = 0; m < 4; ++m) { const size_t ro = (size_t)(ai * HALF + wr * 64 + m * 16 + fr) * 1024;
#pragma unroll
                for (int bj = 0; bj < 2; ++bj)
#pragma unroll
                    for (int n = 0; n < 2; ++n) { const f32x4 xv = *(const f32x4*)(xin + ro + bj * HALF + n * 16), gv = *(const f32x4*)(gate + bj * HALF + n * 16); *(f32x4*)(xout + ro + bj * HALF + n * 16) = xv + gv * acc[ai][bj][m][n]; }
                asm volatile("" ::: "memory"); }
    }
};
struct RowSched {
    StaticOrder so; bool compact;
    __device__ void init(int ntile_m, int N, int G, int c, bool compact_) { so.init(ntile_m * BM, N, G, c); compact = compact_; }
    __device__ __forceinline__ bool next(int i, Unit& u) const { if (!so.next(i, u)) return false; if (compact) u.pm += u.pm >> 3; return true; }
    __device__ __forceinline__ void a_ready(const Unit&) const {}
    __device__ __forceinline__ void done(const Unit&) const {}
};
template <class Epi, class Sched, bool ALIGN_EPI = false, bool SP2 = false>
__device__ __forceinline__ void gemm_phase(PG8_LAS unsigned char* lds, const Gemm g, const Sched& S, const Epi& E, const int tid) {
    const int wid = __builtin_amdgcn_readfirstlane(tid >> 6), lane = tid & 63, wr = wid >> 2, wc = wid & 3, fr = lane & 15, fq = lane >> 4;
    const int K = g.K, nt = K / BK;
    unsigned voffA[2], voffB[2];
#pragma unroll
    for (int i = 0; i < 2; ++i) { int R, C; stage_rc(tid * 16 + i * 8192, R, C); const int Rb = Epi::PERM ? ((R & ~31) + perm32(R & 31)) : R;
        voffA[i] = (unsigned)(R * K + C) * 2u; voffB[i] = (unsigned)(Rb * K + C) * 2u; }
    const size_t kstep = (size_t)(BK * 2);
    const size_t hstep = (size_t)HALF * K * 2;
    const size_t tstep = 2 * hstep;
    const unsigned ldsw = (unsigned)wid * 1024u;
    const int aoff = lds_byte(wr * 64 + fr, fq * 8), boff = lds_byte(wc * 32 + fr, fq * 8);
#define PG8_SA(b, h) (((b) * 2 + (h)) * HTB)
#define PG8_SB(b, h) ((4 + (b) * 2 + (h)) * HTB)
#define PG8_STAGE(bufoff, gbase, voff) do { _Pragma("unroll") for (int _i = 0; _i < 2; ++_i) \
        __builtin_amdgcn_global_load_lds((const unsigned*)((const char*)(gbase) + (voff)[_i]), (PG8_LAS unsigned*)(lds + (bufoff) + ldsw + _i * 8192), 16, 0, 0); } while (0)
#define PG8_LDA(dst, b, h) do { _Pragma("unroll") for (int m = 0; m < 4; ++m) _Pragma("unroll") for (int k = 0; k < 2; ++k) dst[m][k] = *(const PG8_LAS bf16x8*)(lds + PG8_SA(b, h) + aoff + m * 2048 + k * 1024); } while (0)
#define PG8_LDB(dst, b, h) do { _Pragma("unroll") for (int n = 0; n < 2; ++n) _Pragma("unroll") for (int k = 0; k < 2; ++k) dst[n][k] = *(const PG8_LAS bf16x8*)(lds + PG8_SB(b, h) + boff + n * 2048 + k * 1024); } while (0)
#define PG8_MMA(ai, bj, At, Bt) do { __builtin_amdgcn_s_setprio(1); _Pragma("unroll") for (int m = 0; m < 4; ++m) _Pragma("unroll") for (int n = 0; n < 2; ++n) _Pragma("unroll") for (int k = 0; k < 2; ++k) \
        acc[ai][bj][m][n] = __builtin_amdgcn_mfma_f32_16x16x32_bf16(Bt[n][k], At[m][k], acc[ai][bj][m][n], 0, 0, 0); __builtin_amdgcn_s_setprio(0); } while (0)
#define PG8_WAIT_V(n) asm volatile("s_waitcnt vmcnt(" #n ")" ::: "memory")
#define PG8_WAIT_L(n) asm volatile("s_waitcnt lgkmcnt(" #n ")" ::: "memory")
#define PG8_BAR __builtin_amdgcn_s_barrier()
#define PG8_SCHED __builtin_amdgcn_sched_barrier(0)
    Unit cur, nxt; int ui = 0;
    if (!S.next(0, cur)) return;
    f32x4 acc[2][2][4][2];
#pragma unroll
    for (int a = 0; a < 2; ++a)
#pragma unroll
        for (int b = 0; b < 2; ++b)
#pragma unroll
            for (int m = 0; m < 4; ++m)
#pragma unroll
                for (int n = 0; n < 2; ++n) acc[a][b][m][n] = (f32x4){0.f, 0.f, 0.f, 0.f};
    bf16x8 At[4][2], B0[2][2], B1[2][2];
    const char* cA = (const char*)g.A + (size_t)cur.pm * tstep; const char* cB = (const char*)g.Bt + (size_t)cur.pn * tstep;
    S.a_ready(cur);
    if constexpr (SP2) {
        PG8_STAGE(PG8_SB(0, 0), cB, voffB); PG8_STAGE(PG8_SB(0, 1), cB + hstep, voffB); PG8_STAGE(PG8_SA(0, 0), cA, voffA); PG8_STAGE(PG8_SA(0, 1), cA + hstep, voffA);
        if (wr == 1) PG8_BAR;
        PG8_WAIT_V(2); PG8_BAR;
        PG8_STAGE(PG8_SB(1, 0), cB + kstep, voffB); PG8_STAGE(PG8_SA(1, 0), cA + kstep, voffA); PG8_STAGE(PG8_SB(1, 1), cB + hstep + kstep, voffB);
        PG8_WAIT_V(6); PG8_BAR;
    } else {
        PG8_STAGE(PG8_SB(0, 0), cB, voffB); PG8_STAGE(PG8_SA(0, 0), cA, voffA); PG8_STAGE(PG8_SB(0, 1), cB + hstep, voffB); PG8_STAGE(PG8_SA(0, 1), cA + hstep, voffA);
        if (wr == 1) PG8_BAR;
        PG8_WAIT_V(4); PG8_BAR;
        PG8_STAGE(PG8_SB(1, 0), cB + kstep, voffB); PG8_STAGE(PG8_SA(1, 0), cA + kstep, voffA); PG8_STAGE(PG8_SB(1, 1), cB + hstep + kstep, voffB);
        PG8_WAIT_V(6); PG8_BAR;
    }
    for (;;) {
        const bool has_next = S.next(ui + 1, nxt);
        const char* nA = has_next ? (const char*)g.A + (size_t)nxt.pm * tstep : cA; const char* nB = has_next ? (const char*)g.Bt + (size_t)nxt.pn * tstep : cB;
        for (int t = 0; t < nt; t += 2) {
            const bool last = (t == nt - 2);
            const char* a1 = cA + (size_t)(t + 1) * kstep;
            const char* a2 = last ? nA : cA + (size_t)(t + 2) * kstep; const char* b2 = last ? nB : cB + (size_t)(t + 2) * kstep;
            const char* a3 = a2 + kstep; const char* b3 = b2 + kstep;
            if (last && has_next) S.a_ready(nxt);
            if constexpr (SP2) {
            PG8_LDB(B0, 0, 0); PG8_LDB(B1, 0, 1); PG8_SCHED; PG8_LDA(At, 0, 0); PG8_STAGE(PG8_SA(1, 1), a1 + hstep, voffA);
            PG8_WAIT_V(8); PG8_WAIT_L(0); PG8_BAR; PG8_MMA(0, 0, At, B0); PG8_MMA(0, 1, At, B1); PG8_BAR; PG8_SCHED;
            PG8_LDA(At, 0, 1); PG8_STAGE(PG8_SB(0, 0), b2, voffB); PG8_STAGE(PG8_SB(0, 1), b2 + hstep, voffB); PG8_STAGE(PG8_SA(0, 0), a2, voffA);
            PG8_WAIT_V(8); PG8_WAIT_L(0); PG8_BAR; PG8_MMA(1, 0, At, B0); PG8_MMA(1, 1, At, B1); PG8_BAR; PG8_SCHED;
            PG8_LDB(B0, 1, 0); PG8_LDB(B1, 1, 1); PG8_SCHED; PG8_LDA(At, 1, 0); PG8_STAGE(PG8_SA(0, 1), a2 + hstep, voffA);
            PG8_WAIT_V(8); PG8_WAIT_L(0); PG8_BAR; PG8_MMA(0, 0, At, B0); PG8_MMA(0, 1, At, B1); PG8_BAR; PG8_SCHED;
            PG8_LDA(At, 1, 1); PG8_STAGE(PG8_SB(1, 0), b3, voffB); PG8_STAGE(PG8_SB(1, 1), b3 + hstep, voffB); PG8_STAGE(PG8_SA(1, 0), a3, voffA);
            PG8_WAIT_V(8); PG8_WAIT_L(0); PG8_BAR; PG8_MMA(1, 0, At, B0); PG8_MMA(1, 1, At, B1); PG8_BAR; PG8_SCHED;
            } else {
            PG8_LDB(B0, 0, 0); PG8_SCHED; PG8_LDA(At, 0, 0); PG8_STAGE(PG8_SA(1, 1), a1 + hstep, voffA);
            PG8_WAIT_L(8); PG8_BAR; PG8_WAIT_L(0); PG8_MMA(0, 0, At, B0); PG8_BAR; PG8_SCHED;
            PG8_LDB(B1, 0, 1); PG8_STAGE(PG8_SB(0, 0), b2, voffB);
            PG8_BAR; PG8_WAIT_L(0); PG8_MMA(0, 1, At, B1); PG8_BAR;
            PG8_LDA(At, 0, 1); PG8_STAGE(PG8_SA(0, 0), a2, voffA);
            PG8_BAR; PG8_WAIT_L(0); PG8_MMA(1, 0, At, B0); PG8_BAR; PG8_SCHED;
            PG8_STAGE(PG8_SB(0, 1), b2 + hstep, voffB);
            PG8_WAIT_V(6); PG8_BAR; PG8_MMA(1, 1, At, B1); PG8_BAR;
            PG8_LDB(B0, 1, 0); PG8_SCHED; PG8_LDA(At, 1, 0); PG8_STAGE(PG8_SA(0, 1), a2 + hstep, voffA);
            PG8_WAIT_L(8); PG8_BAR; PG8_WAIT_L(0); PG8_MMA(0, 0, At, B0); PG8_BAR; PG8_SCHED;
            PG8_LDB(B1, 1, 1); PG8_STAGE(PG8_SB(1, 0), b3, voffB);
            PG8_BAR; PG8_WAIT_L(0); PG8_MMA(0, 1, At, B1); PG8_BAR;
            PG8_LDA(At, 1, 1); PG8_STAGE(PG8_SA(1, 0), a3, voffA);
            PG8_BAR; PG8_WAIT_L(0); PG8_MMA(1, 0, At, B0); PG8_BAR; PG8_SCHED;
            PG8_STAGE(PG8_SB(1, 1), b3 + hstep, voffB);
            PG8_WAIT_V(6); PG8_BAR; PG8_MMA(1, 1, At, B1); PG8_BAR;
            }
        }
        if constexpr (ALIGN_EPI) { if (wr == 0) PG8_BAR; }
        if constexpr (!Epi::AFTER_DRAIN) { E(acc, cur, wr, wc, fr, fq); S.done(cur); }
        if (!has_next) break;
#pragma unroll
        for (int a = 0; a < 2; ++a)
#pragma unroll
            for (int b = 0; b < 2; ++b)
#pragma unroll
                for (int m = 0; m < 4; ++m)
#pragma unroll
                    for (int n = 0; n < 2; ++n) acc[a][b][m][n] = (f32x4){0.f, 0.f, 0.f, 0.f};
        cur = nxt; cA = nA; cB = nB; ++ui;
        if constexpr (ALIGN_EPI) { if (wr == 1) PG8_BAR; }
    }
    PG8_WAIT_V(0);
    if constexpr (!ALIGN_EPI) { if (wr == 0) PG8_BAR; }
    PG8_BAR;
    if constexpr (Epi::AFTER_DRAIN) { E.fused(acc, cur, wr, wc, fr, fq, lds, wid, lane); S.done(cur); }
#undef PG8_SA
#undef PG8_SB
#undef PG8_STAGE
#undef PG8_LDA
#undef PG8_LDB
#undef PG8_MMA
#undef PG8_WAIT_V
#undef PG8_WAIT_L
#undef PG8_BAR
#undef PG8_SCHED
}
}
namespace ab {
using bf16=__hip_bfloat16;
using bf16x8=__attribute__((ext_vector_type(8)))short;
using s16x4=__attribute__((ext_vector_type(4)))short;
using f32x16=__attribute__((ext_vector_type(16)))float;
using u32x4=__attribute__((ext_vector_type(4)))unsigned;
constexpr int D=64;
constexpr int NW=8,QBLK=32,QB=QBLK*NW,KVBLK=64;
__device__ __forceinline__ int crow(int r,int hi){return (r&3)+8*(r>>2)+4*hi;}
#define SBAR() __builtin_amdgcn_sched_barrier(0)
constexpr int NSLOT=3, SLOTB=8192;
constexpr int LDS_K=0, LDS_V=NSLOT*SLOTB, LDS_WS=2*NSLOT*SLOTB, LDS_OST=LDS_WS+NW*64*4, LDS_BYTES=LDS_OST+NW*4096;
constexpr float C2=0.125f*1.4426950408889634f;
__device__ __forceinline__ void glds16(const void*gsrc,unsigned lds_dst){unsigned keep;
  asm volatile("s_mov_b32 %0, m0\n\ts_mov_b32 m0, %2\n\ts_nop 0\n\tglobal_load_lds_dwordx4 %1, off\n\ts_mov_b32 m0, %0":"=&s"(keep):"v"(gsrc),"s"(lds_dst):"memory");}
__device__ __forceinline__ float max3f(float a,float b,float c){float r;asm("v_max3_f32 %0, %1, %2, %3":"=v"(r):"v"(a),"v"(b),"v"(c));return r;}
__device__ __forceinline__ float max2f(float a,float b){float r;asm("v_max_f32_e32 %0, %1, %2":"=v"(r):"v"(a),"v"(b));return r;}
__device__ __forceinline__ float fadd_s(float a,float b){float r;asm("v_add_f32_e32 %0, %1, %2":"=v"(r):"v"(a),"v"(b));return r;}
__device__ __forceinline__ float fsub_s(float a,float b){float r;asm("v_sub_f32_e32 %0, %1, %2":"=v"(r):"v"(a),"v"(b));return r;}
typedef float f32x2_t __attribute__((ext_vector_type(2))); typedef __bf16 bf16x2_t __attribute__((ext_vector_type(2)));
__device__ __forceinline__ unsigned cvtpk_s(float lo,float hi){f32x2_t v={lo,hi};bf16x2_t b=__builtin_convertvector(v,bf16x2_t);return __builtin_bit_cast(unsigned,b);}
#define WAIT_BAR(N) asm volatile("s_waitcnt vmcnt(" #N ") lgkmcnt(0)\n\ts_barrier":::"memory")

__device__ __forceinline__ void qkt(f32x16&p0,f32x16&p1,const char*Kslot,const bf16x8*qr,const f32x16&negm,int r32,int hi){
  const char*kb=Kslot+hi*1024+r32*16;
  #pragma unroll
  for(int d0=0;d0<4;++d0){
    const bf16x8 b0=*reinterpret_cast<const bf16x8*>(kb+d0*2048);
    const bf16x8 b1=*reinterpret_cast<const bf16x8*>(kb+d0*2048+512);
    if(d0==0){p0=__builtin_amdgcn_mfma_f32_32x32x16_bf16(b0,qr[0],negm,0,0,0);p1=__builtin_amdgcn_mfma_f32_32x32x16_bf16(b1,qr[0],negm,0,0,0);}
    else{p0=__builtin_amdgcn_mfma_f32_32x32x16_bf16(b0,qr[d0],p0,0,0,0);p1=__builtin_amdgcn_mfma_f32_32x32x16_bf16(b1,qr[d0],p1,0,0,0);}}
}
typedef __attribute__((address_space(3))) const char* lds_cptr;
typedef short v4i16_t __attribute__((ext_vector_type(4)));
__device__ __forceinline__ void kload8(bf16x8*kf,lds_cptr kp){
  kf[0]=*(const __attribute__((address_space(3))) bf16x8*)(kp);      kf[1]=*(const __attribute__((address_space(3))) bf16x8*)(kp+512);
  kf[2]=*(const __attribute__((address_space(3))) bf16x8*)(kp+2048); kf[3]=*(const __attribute__((address_space(3))) bf16x8*)(kp+2560);
  kf[4]=*(const __attribute__((address_space(3))) bf16x8*)(kp+4096); kf[5]=*(const __attribute__((address_space(3))) bf16x8*)(kp+4608);
  kf[6]=*(const __attribute__((address_space(3))) bf16x8*)(kp+6144); kf[7]=*(const __attribute__((address_space(3))) bf16x8*)(kp+6656);
}
__device__ __forceinline__ void kload2(bf16x8*kf,lds_cptr kp,int j){ kf[2*j]=*(const __attribute__((address_space(3))) bf16x8*)(kp+j*2048); kf[2*j+1]=*(const __attribute__((address_space(3))) bf16x8*)(kp+j*2048+512); }
__device__ __forceinline__ s16x4 vtr(lds_cptr p){ return __builtin_bit_cast(s16x4,__builtin_amdgcn_ds_read_tr16_b64_v4i16((__attribute__((address_space(3))) v4i16_t*)p)); }
__device__ __forceinline__ float rowmax(const f32x16&p0,const f32x16&p1){
  float a=max3f(p0[0],p0[1],p1[0]),b=max3f(p0[2],p0[3],p1[1]);a=max3f(a,p1[2],p1[3]);
  #pragma unroll
  for(int r=4;r<16;r+=4){a=max3f(a,p0[r],p0[r+1]);b=max3f(b,p0[r+2],p0[r+3]);a=max3f(a,p1[r],p1[r+1]);b=max3f(b,p1[r+2],p1[r+3]);}
  const float m=max2f(a,b);
  auto rr=__builtin_amdgcn_permlane32_swap(__float_as_uint(m),__float_as_uint(m),false,false);
  return max2f(__uint_as_float(rr[0]),__uint_as_float(rr[1]));
}
__device__ __forceinline__ void pv(f32x16*o,int vb,bf16x8 pa0,bf16x8 pa1,bf16x8 pa2,bf16x8 pa3){
  #pragma unroll
  for(int d0=0;d0<2;++d0){s16x4 lo[4],hi[4];
    #pragma unroll
    for(int ks=0;ks<4;++ks){
      asm volatile("ds_read_b64_tr_b16 %0,%1 offset:%c2":"=&v"(lo[ks]):"v"(vb),"i"(d0*4096+ks*1024):"memory");
      asm volatile("ds_read_b64_tr_b16 %0,%1 offset:%c2":"=&v"(hi[ks]):"v"(vb),"i"(d0*4096+ks*1024+512):"memory");}
    asm volatile("s_waitcnt lgkmcnt(0)":::"memory");SBAR();
    #define PK(k) (bf16x8){lo[k][0],lo[k][1],lo[k][2],lo[k][3],hi[k][0],hi[k][1],hi[k][2],hi[k][3]}
    o[d0]=__builtin_amdgcn_mfma_f32_32x32x16_bf16(pa0,PK(0),o[d0],0,0,0);
    o[d0]=__builtin_amdgcn_mfma_f32_32x32x16_bf16(pa1,PK(1),o[d0],0,0,0);
    o[d0]=__builtin_amdgcn_mfma_f32_32x32x16_bf16(pa2,PK(2),o[d0],0,0,0);
    o[d0]=__builtin_amdgcn_mfma_f32_32x32x16_bf16(pa3,PK(3),o[d0],0,0,0);
    #undef PK
  }
}

#ifndef ATTN_STORE16
#define ATTN_STORE16(p,v) (*(u32x4*)(p)=(v))
#endif
struct AUnit { const bf16* Q; const bf16* K; const bf16* V; bf16* O; int r1, r2, NT, q0; float sink2; };
template<int LD,int MODE,int THRL> __device__ __forceinline__ void attn_unit(const AUnit& U,char*shm,const int tid){
  const int lane=tid&63,r32=lane&31,hi=lane>>5; const int wid=__builtin_amdgcn_readfirstlane(tid>>6);
  constexpr int n1=4; const int r1=U.r1,r2=U.r2;
  #define TROW(t) (MODE==0?r1+64*(t):((t)<n1?r1+64*(t):r2+64*((t)-n1)))
  const bf16*Qw=U.Q+(long)(wid*QBLK)*LD;
  const bf16*Kh=U.K,*Vh=U.V;
  const unsigned lds0=(unsigned)(uintptr_t)shm;
  float*wsf=(float*)(shm+LDS_WS)+wid*64;
  const bf16*ksrc=Kh+(long)lane*LD+wid*8;
  const bf16*vsrc=Vh+(long)(16*(wid&3)+(lane>>2))*LD+(wid>>2)*32+(lane&3)*8;
  const unsigned kdst=lds0+LDS_K+wid*1024, vdst=lds0+LDS_V+wid*1024;
  #define DMA_K(t,slot) glds16(ksrc+(long)TROW(t)*LD,(unsigned)__builtin_amdgcn_readfirstlane(kdst+(slot)))
  #define DMA_V(t,slot) glds16(vsrc+(long)TROW(t)*LD,(unsigned)__builtin_amdgcn_readfirstlane(vdst+(slot)))
  const int vb0=(int)(lds0+LDS_V)+((lane>>4)&1)*32+(lane&3)*8+(4*hi+((lane&15)>>2))*64;
  const char*Kbase=shm+LDS_K; bf16x8 kf[8];
  const lds_cptr shm3=(lds_cptr)shm; const lds_cptr kp0=shm3+LDS_K+hi*1024+r32*16; const lds_cptr vp0=shm3+LDS_V+((lane>>4)&1)*32+(lane&3)*8+(4*hi+((lane&15)>>2))*64;
  const int NT=U.NT;
  DMA_K(0,0);DMA_V(0,0);DMA_K(1,SLOTB);
  bf16x8 qr[4];
  #pragma unroll
  for(int d0=0;d0<4;++d0)qr[d0]=*reinterpret_cast<const bf16x8*>(&Qw[(long)r32*LD+d0*16+hi*8]);
  float mhat=0.f,l_reg=0.f;f32x16 o[2];o[0]=f32x16{};o[1]=f32x16{};f32x16 negm=f32x16{};asm volatile("":"+v"(negm));
  const int qpos=U.q0+wid*QBLK+r32;
  #define CMASK(P0,P1,t) do{ if(MODE==1){ if((t)>=n1){ const int tlo_=TROW(t), qw_=U.q0+wid*QBLK; \
      if(!(tlo_-qw_-31>=-128 && tlo_+63-qw_<=128)){ const int db_=tlo_-qpos+4*hi+128; \
        _Pragma("unroll") for(int r=0;r<16;++r){ const int c_=(r&3)+8*(r>>2); if((unsigned)(db_+c_)>256u)P0[r]=-INFINITY; if((unsigned)(db_+c_+32)>256u)P1[r]=-INFINITY; } } } } }while(0)
  bool resc=false;
  #define START(P0,P1) do{ const float rm=rowmax(P0,P1); resc=false; \
    { const float dl=rm; mhat=fadd_s(mhat,dl); \
      _Pragma("unroll") for(int r=0;r<16;++r){P0[r]=fsub_s(P0[r],dl);P1[r]=fsub_s(P1[r],dl);} \
      _Pragma("unroll") for(int r=0;r<16;++r)negm[r]=-mhat; asm volatile("":"+v"(negm)); } \
    _Pragma("unroll") for(int r=0;r<16;++r)P0[r]=__builtin_amdgcn_exp2f(P0[r]); }while(0)
  #define RESC() do{ if(resc){ asm volatile("s_waitcnt lgkmcnt(0)":::"memory"); \
      _Pragma("unroll") for(int d_=0;d_<2;++d_) _Pragma("unroll") for(int r=0;r<16;++r)o[d_][r]*=wsf[crow(r,hi)]; } }while(0)
  f32x16 pA0,pA1,pB0,pB1;
  int sl_prev=0,sl_cur=0,sl_next=SLOTB;
  #define ROT() do{sl_prev=sl_cur;sl_cur=sl_next;sl_next=(sl_next==(NSLOT-1)*SLOTB)?0:sl_next+SLOTB;}while(0)
  DMA_K(2,2*SLOTB);
  WAIT_BAR(3);
  qkt(pA0,pA1,Kbase,qr,negm,r32,hi);asm volatile("s_nop 15\n\ts_nop 7":"+v"(pA0),"+v"(pA1));CMASK(pA0,pA1,0);
  START(pA0,pA1);
  _Pragma("unroll") for(int r=0;r<16;++r)pA1[r]=__builtin_amdgcn_exp2f(pA1[r]);
  WAIT_BAR(0);
  DMA_K(3,0);DMA_V(1,SLOTB);
  ROT();
  kload8(kf,kp0+sl_cur);
  WAIT_BAR(2);
  s16x4 vlo[8],vhi[8]; u32x4 pw0,pw1,pw2,pw3;
  #define PKW(P,B) cvtpk_s(P[B],P[B+1])
  #define PAF(k) __builtin_bit_cast(bf16x8,pw##k)
  #define VFR(i) (bf16x8){vlo[i][0],vlo[i][1],vlo[i][2],vlo[i][3],vhi[i][0],vhi[i][1],vhi[i][2],vhi[i][3]}
  #define PIN(x) asm volatile("":"+v"(x))
  #define MX3(a,b,c) __builtin_fmaxf(__builtin_fmaxf((a),(b)),(c))
  #define GAPA(MF,A0,A1,A2,A3,W0,W1,PW) do{ MF; sacc+=A0; sacc+=A1; sacc+=A2; sacc+=A3; PIN(sacc); W0; W1; PIN(PW); SBAR(); }while(0)
  #define EX(v) __builtin_amdgcn_exp2f(v)
  #define GAPB(MF,X,B) do{ MF; X[B]=EX(X[B]); X[B+1]=EX(X[B+1]); X[B+2]=EX(X[B+2]); X[B+3]=EX(X[B+3]); PIN(X); SBAR(); }while(0)
  #define VRD(i) do{ vlo[i]=vtr(vp_+(((i)>>2)*4096+((i)&3)*1024)); vhi[i]=vtr(vp_+(((i)>>2)*4096+((i)&3)*1024+512)); }while(0)
  #define KRD(G,j) do{ if(G){ kload2(kf,kp0+sl_next,j); SBAR(); } }while(0)
  #define STEP(C0,C1,P0,P1,t,GK,GV,GL) do{ SBAR(); \
    const lds_cptr vp_=vp0+sl_prev; \
    VRD(0); SBAR(); float sacc=(P0[0]+P0[1]); \
    GAPA(C0=__builtin_amdgcn_mfma_f32_32x32x16_bf16(kf[0],qr[0],negm,0,0,0), P0[2],P0[3],P0[4],P0[5],     pw0[0]=PKW(P0,0), pw0[1]=PKW(P0,2), pw0); \
    VRD(4); SBAR(); GAPA(C1=__builtin_amdgcn_mfma_f32_32x32x16_bf16(kf[1],qr[0],negm,0,0,0), P0[6],P0[7],P0[8],P0[9],     pw0[2]=PKW(P0,4), pw0[3]=PKW(P0,6), pw0); \
    VRD(1); SBAR(); GAPA(C0=__builtin_amdgcn_mfma_f32_32x32x16_bf16(kf[2],qr[1],C0,0,0,0),   P0[10],P0[11],P0[12],P0[13], pw1[0]=PKW(P0,8), pw1[1]=PKW(P0,10), pw1); \
    VRD(5); SBAR(); GAPA(C1=__builtin_amdgcn_mfma_f32_32x32x16_bf16(kf[3],qr[1],C1,0,0,0),   P0[14],P0[15],P1[0],P1[1],   pw1[2]=PKW(P0,12),pw1[3]=PKW(P0,14), pw1); \
    VRD(2); SBAR(); GAPA(C0=__builtin_amdgcn_mfma_f32_32x32x16_bf16(kf[4],qr[2],C0,0,0,0),   P1[2],P1[3],P1[4],P1[5],     pw2[0]=PKW(P1,0), pw2[1]=PKW(P1,2), pw2); \
    VRD(6); SBAR(); GAPA(C1=__builtin_amdgcn_mfma_f32_32x32x16_bf16(kf[5],qr[2],C1,0,0,0),   P1[6],P1[7],P1[8],P1[9],     pw2[2]=PKW(P1,4), pw2[3]=PKW(P1,6), pw2); \
    VRD(3); SBAR(); GAPA(C0=__builtin_amdgcn_mfma_f32_32x32x16_bf16(kf[6],qr[3],C0,0,0,0),   P1[10],P1[11],P1[12],P1[13], pw3[0]=PKW(P1,8), pw3[1]=PKW(P1,10), pw3); \
    VRD(7); SBAR(); GAPA(C1=__builtin_amdgcn_mfma_f32_32x32x16_bf16(kf[7],qr[3],C1,0,0,0),   P1[14],P1[15],0.f,0.f,       pw3[2]=PKW(P1,12),pw3[3]=PKW(P1,14), pw3); \
    l_reg+=sacc; \
    if(GK){DMA_K((t)+3,sl_cur);} if(GV){DMA_V((t)+1,sl_next);} \
    CMASK(C0,C1,t); \
    { float a=MX3(C0[0],C0[1],C1[0]),b=MX3(C0[2],C0[3],C1[1]); a=MX3(a,C1[2],C1[3]); \
      _Pragma("unroll") for(int r=4;r<16;r+=4){a=MX3(a,C0[r],C0[r+1]);b=MX3(b,C0[r+2],C0[r+3]);a=MX3(a,C1[r],C1[r+1]);b=MX3(b,C1[r+2],C1[r+3]);} \
      float rm=__builtin_fmaxf(a,b); { auto rr=__builtin_amdgcn_permlane32_swap(__float_as_uint(rm),__float_as_uint(rm),false,false); rm=__builtin_fmaxf(__uint_as_float(rr[0]),__uint_as_float(rr[1])); } \
      resc=false; \
      if(__builtin_expect(__any(rm>(float)THRL),0)){ const float dl=__builtin_fmaxf(rm,0.f); mhat+=dl; \
        _Pragma("unroll") for(int r=0;r<16;++r){C0[r]-=dl;C1[r]-=dl;} \
        _Pragma("unroll") for(int r=0;r<16;++r)negm[r]=-mhat; asm volatile("":"+v"(negm)); \
        const float f=__builtin_amdgcn_exp2f(-dl); l_reg*=f; if(hi==0)wsf[r32]=f; resc=true; } } \
    SBAR(); \
    GAPB(o[0]=__builtin_amdgcn_mfma_f32_32x32x16_bf16(PAF(0),VFR(0),o[0],0,0,0), C0,0); \
    GAPB(o[1]=__builtin_amdgcn_mfma_f32_32x32x16_bf16(PAF(0),VFR(4),o[1],0,0,0), C0,4); \
    KRD(GL,0); GAPB(o[0]=__builtin_amdgcn_mfma_f32_32x32x16_bf16(PAF(1),VFR(1),o[0],0,0,0), C0,8); \
    KRD(GL,1); GAPB(o[1]=__builtin_amdgcn_mfma_f32_32x32x16_bf16(PAF(1),VFR(5),o[1],0,0,0), C0,12); \
    KRD(GL,2); GAPB(o[0]=__builtin_amdgcn_mfma_f32_32x32x16_bf16(PAF(2),VFR(2),o[0],0,0,0), C1,0); \
    KRD(GL,3); GAPB(o[1]=__builtin_amdgcn_mfma_f32_32x32x16_bf16(PAF(2),VFR(6),o[1],0,0,0), C1,4); \
    GAPB(o[0]=__builtin_amdgcn_mfma_f32_32x32x16_bf16(PAF(3),VFR(3),o[0],0,0,0), C1,8); \
    GAPB(o[1]=__builtin_amdgcn_mfma_f32_32x32x16_bf16(PAF(3),VFR(7),o[1],0,0,0), C1,12); \
    }while(0)
  int t=1;
  for(;t+5<NT;t+=2){
    STEP(pB0,pB1,pA0,pA1,t,true,true,true);     WAIT_BAR(2); RESC(); ROT();
    STEP(pA0,pA1,pB0,pB1,t+1,true,true,true);   WAIT_BAR(2); RESC(); ROT();
  }
  #define ENDW(tt) do{ if((tt)+3<NT){WAIT_BAR(2);} else if((tt)+2<NT){WAIT_BAR(1);} else {WAIT_BAR(0);} }while(0)
  for(;t+1<NT;t+=2){
    STEP(pB0,pB1,pA0,pA1,t,(t+3<NT),(t+1<NT),(t+1<NT));       ENDW(t);   RESC(); ROT();
    STEP(pA0,pA1,pB0,pB1,t+1,(t+4<NT),(t+2<NT),(t+2<NT));     ENDW(t+1); RESC(); ROT();
  }
  STEP(pB0,pB1,pA0,pA1,NT-1,false,false,false); RESC();
  { float sacc=pB0[0]+pB0[1]; _Pragma("unroll") for(int r=2;r<16;++r)sacc+=pB0[r]; _Pragma("unroll") for(int r=0;r<16;++r)sacc+=pB1[r]; l_reg+=sacc;
    pw0=(u32x4){PKW(pB0,0),PKW(pB0,2),PKW(pB0,4),PKW(pB0,6)};pw1=(u32x4){PKW(pB0,8),PKW(pB0,10),PKW(pB0,12),PKW(pB0,14)};pw2=(u32x4){PKW(pB1,0),PKW(pB1,2),PKW(pB1,4),PKW(pB1,6)};pw3=(u32x4){PKW(pB1,8),PKW(pB1,10),PKW(pB1,12),PKW(pB1,14)};
    SBAR(); pv(o,vb0+sl_cur,PAF(0),PAF(1),PAF(2),PAF(3)); }
  #undef PKW
  #undef PAF
  #undef VFR
  #undef PIN
  #undef MX3
  #undef GAPA
  #undef GAPB
  #undef EX
  #undef VRD
  #undef KRD
  #undef STEP
  #undef ENDW
  if(hi==0)l_reg+=__builtin_amdgcn_exp2f(U.sink2-mhat);
  {auto rr=__builtin_amdgcn_permlane32_swap(__float_as_uint(l_reg),__float_as_uint(l_reg),false,false);l_reg=__uint_as_float(rr[0])+__uint_as_float(rr[1]);}
  if(hi==0)wsf[32+r32]=l_reg;asm volatile("s_waitcnt lgkmcnt(0)":::"memory");
  float rli[16];
  #pragma unroll
  for(int r=0;r<16;++r)rli[r]=__builtin_amdgcn_rcpf(wsf[32+crow(r,hi)]);
  bf16*Ow=U.O+(long)(wid*QBLK)*1024;
  { bf16*stg=(bf16*)(shm+LDS_OST)+wid*2048;
    #pragma unroll
    for(int r=0;r<16;++r){const int orow=crow(r,hi);
      #pragma unroll
      for(int d0=0;d0<2;++d0)stg[orow*64+d0*32+r32]=__float2bfloat16(o[d0][r]*rli[r]);}
    asm volatile("s_waitcnt lgkmcnt(0)":::"memory");
    #pragma unroll
    for(int i=0;i<4;++i){const int row=i*8+(lane>>3),ch=lane&7; const u32x4 v=*(const u32x4*)(stg+row*64+ch*8); ATTN_STORE16(Ow+(long)row*1024+ch*8,v);} }
  asm volatile("s_waitcnt lgkmcnt(0)\n\ts_barrier":::"memory");
  #undef TROW
  #undef DMA_K
  #undef DMA_V
  #undef CMASK
  #undef START
  #undef RESC
  #undef ROT
}
constexpr int ATTN_LDS_BYTES=LDS_BYTES;
#undef SBAR
#undef WAIT_BAR
}
namespace gla {
using bf16 = unsigned short;
using bf16x8 = __attribute__((ext_vector_type(8))) short;
using s16x4 = __attribute__((ext_vector_type(4))) short;
using f32x16 = __attribute__((ext_vector_type(16))) float;
using f32x4 = __attribute__((ext_vector_type(4))) float;
using u32x4 = __attribute__((ext_vector_type(4))) unsigned;
using u32x2 = __attribute__((ext_vector_type(2))) unsigned;
typedef short v4i16_t __attribute__((ext_vector_type(4)));
#define GLAS __attribute__((address_space(3)))
constexpr int LD = cfg::LDE, M = cfg::M;
constexpr float QS = 0.17677669529663687f;
constexpr int KT_STRIDE = 80, KH_STRIDE = 144;
constexpr int WAVE_LDS = 16384;
__device__ __forceinline__ float ex(float x) { return __builtin_amdgcn_exp2f(x * 1.4426950408889634f); }
__device__ __forceinline__ float bf2f(unsigned short v) { return __builtin_bit_cast(float, (unsigned)v << 16); }
__device__ __forceinline__ unsigned short f2bf(float f) { unsigned u = __builtin_bit_cast(unsigned, f); return (unsigned short)((u + 0x7fffu + ((u >> 16) & 1u)) >> 16); }
__device__ __forceinline__ unsigned pk2(float lo, float hi) { return (unsigned)f2bf(lo) | ((unsigned)f2bf(hi) << 16); }
__device__ __forceinline__ int crow(int r, int hi) { return (r & 3) + 8 * (r >> 2) + 4 * hi; }
__device__ __forceinline__ s16x4 vtr(const GLAS char* p) { return __builtin_bit_cast(s16x4, __builtin_amdgcn_ds_read_tr16_b64_v4i16((GLAS v4i16_t*)p)); }
#define GLA_MFMA(a, b, c) __builtin_amdgcn_mfma_f32_32x32x16_bf16(a, b, c, 0, 0, 0)
#define GLA_LDSWAIT() asm volatile("s_waitcnt lgkmcnt(0)" ::: "memory")

struct Ctx {
    const bf16* P;
    const float* DEC;
    size_t mbase;
    int h, bh;
    bf16* US; bf16* SB; float* DD;
    bf16* MIX; const float* gg;
};

template <int DIR> __device__ __forceinline__ void load_cum(const float* gp, int lane, float (&b)[32], float& T) {
    const int k = lane & 31, half = lane >> 5;
    const float* p = gp + (size_t)(32 * half) * 256 + k;
#pragma unroll
    for (int i = 0; i < 32; ++i) b[i] = p[(size_t)i * 256];
    float run = 0.f;
    if (DIR == 0) {
#pragma unroll
        for (int i = 0; i < 32; ++i) { run += b[i]; b[i] = run; }
    } else {
#pragma unroll
        for (int i = 31; i >= 0; --i) { run += b[i]; b[i] = run; }
    }
    const float other = __shfl_xor(run, 32);
    const float add = (DIR == 0 ? (half == 1) : (half == 0)) ? other : 0.f;
#pragma unroll
    for (int i = 0; i < 32; ++i) b[i] += add;
    T = run + other;
}
__device__ __forceinline__ void load_vtile(const bf16* vp  , GLAS char* vt, int lane) {
#pragma unroll
    for (int p = 0; p < 8; ++p) {
        const u32x4 v = *(const u32x4*)(vp + (size_t)(16 * (p & 3) + (lane >> 2)) * LD + (p >> 2) * 32 + (lane & 3) * 8);
        *(GLAS u32x4*)(vt + p * 1024 + lane * 16) = v;
    }
}
template <int DIR> __device__ __forceinline__ void stage_a(const Ctx& X, int c, GLAS char* wl, int lane_in) {
    int lane = lane_in; asm volatile("" : "+v"(lane));
    const int k = lane & 31, half = lane >> 5, r32 = lane & 31, hi = lane >> 5;
    GLAS char* khT = wl; GLAS char* vt = wl + 32 * KH_STRIDE;
    float b[32], T;
    load_cum<DIR>(X.DEC + ((size_t)DIR * M + X.mbase + 64 * c) * 256 + X.h * 32, lane, b, T);
    const bf16* kp = X.P + (size_t)(64 * c + 32 * half) * LD + cfg::E_GK + X.h * 32 + k;
    unsigned w[16];
#pragma unroll
    for (int i = 0; i < 32; i += 2) { const float k0 = bf2f(kp[(size_t)i * LD]) * ex(T - b[i]), k1 = bf2f(kp[(size_t)(i + 1) * LD]) * ex(T - b[i + 1]); w[i >> 1] = pk2(k0, k1); }
#pragma unroll
    for (int g = 0; g < 4; ++g) *(GLAS u32x4*)(khT + k * KH_STRIDE + (32 * half + 8 * g) * 2) = (u32x4){w[4 * g], w[4 * g + 1], w[4 * g + 2], w[4 * g + 3]};
    const size_t slot = ((size_t)(X.bh * 2 + DIR) * 36 + c);
    if (half == 0) X.DD[slot * 32 + k] = ex(T);
    load_vtile(X.P + (size_t)(64 * c) * LD + cfg::E_GV + X.h * 64, vt, lane);
    GLA_LDSWAIT();
    f32x16 u0 = f32x16{}, u1 = f32x16{};
    const GLAS char* vb = vt + ((lane >> 4) & 1) * 32 + (lane & 3) * 8 + (8 * hi + ((lane & 15) >> 2)) * 64;
#pragma unroll
    for (int s = 0; s < 4; ++s) {
        const bf16x8 a = *(const GLAS bf16x8*)(khT + r32 * KH_STRIDE + (16 * s + 8 * hi) * 2);
        const s16x4 l0 = vtr(vb + s * 1024), h0 = vtr(vb + s * 1024 + 256), l1 = vtr(vb + 4096 + s * 1024), h1 = vtr(vb + 4096 + s * 1024 + 256);
        u0 = GLA_MFMA(a, ((bf16x8){l0[0], l0[1], l0[2], l0[3], h0[0], h0[1], h0[2], h0[3]}), u0);
        u1 = GLA_MFMA(a, ((bf16x8){l1[0], l1[1], l1[2], l1[3], h1[0], h1[1], h1[2], h1[3]}), u1);
    }
    bf16* up = X.US + slot * 2048;
#pragma unroll
    for (int g = 0; g < 4; ++g) {
        *(u32x2*)(up + (r32) * 32 + 8 * g + 4 * hi) = (u32x2){pk2(u0[4 * g], u0[4 * g + 1]), pk2(u0[4 * g + 2], u0[4 * g + 3])};
        *(u32x2*)(up + (r32 + 32) * 32 + 8 * g + 4 * hi) = (u32x2){pk2(u1[4 * g], u1[4 * g + 1]), pk2(u1[4 * g + 2], u1[4 * g + 3])};
    }
    GLA_LDSWAIT();
}
template <int DIR> __device__ __forceinline__ void stage_c_dir(const Ctx& X, int c, int qh, GLAS char* wl, int lane_in, f32x16 (&o)[2]) {
    int lane = lane_in; asm volatile("" : "+v"(lane));
    const int k = lane & 31, half = lane >> 5, r32 = lane & 31, hi = lane >> 5;
    GLAS char* kt = wl; GLAS char* qt = wl + 64 * KT_STRIDE; GLAS char* vt = wl + 96 * KT_STRIDE;
    float b[32], T;
    load_cum<DIR>(X.DEC + ((size_t)DIR * M + X.mbase + 64 * c) * 256 + X.h * 32, lane, b, T);
    const bf16* kp = X.P + (size_t)(64 * c + 32 * half) * LD + cfg::E_GK + X.h * 32 + k;
#pragma unroll
    for (int i = 0; i < 32; ++i) *(GLAS unsigned short*)(kt + (32 * half + i) * KT_STRIDE + k * 2) = f2bf(bf2f(kp[(size_t)i * LD]) * ex(-b[i]));
    if (half == qh) {
        const bf16* qp = X.P + (size_t)(64 * c + 32 * half) * LD + cfg::E_GQ + X.h * 32 + k;
#pragma unroll
        for (int i = 0; i < 32; ++i) *(GLAS unsigned short*)(qt + i * KT_STRIDE + k * 2) = f2bf(bf2f(qp[(size_t)i * LD]) * (ex(b[i]) * QS));
    }
    GLA_LDSWAIT();
    const bool use0 = !(DIR == 1 && qh == 1), use1 = !(DIR == 0 && qh == 0);
    f32x16 p0 = f32x16{}, p1 = f32x16{};
    bf16x8 bq[2];
#pragma unroll
    for (int s = 0; s < 2; ++s) {
        bq[s] = *(const GLAS bf16x8*)(qt + r32 * KT_STRIDE + (16 * s + 8 * hi) * 2);
        if (use0) { const bf16x8 a0 = *(const GLAS bf16x8*)(kt + r32 * KT_STRIDE + (16 * s + 8 * hi) * 2); p0 = GLA_MFMA(a0, bq[s], p0); }
        if (use1) { const bf16x8 a1 = *(const GLAS bf16x8*)(kt + (32 + r32) * KT_STRIDE + (16 * s + 8 * hi) * 2); p1 = GLA_MFMA(a1, bq[s], p1); }
    }
    const int iq = 32 * qh + r32;
#pragma unroll
    for (int r = 0; r < 16; ++r) { const int j0 = crow(r, hi), j1 = 32 + j0;
        if (DIR == 0) { if (j0 > iq) p0[r] = 0.f; if (j1 > iq) p1[r] = 0.f; } else { if (j0 < iq) p0[r] = 0.f; if (j1 < iq) p1[r] = 0.f; } }
    const GLAS char* vb = vt + ((lane >> 4) & 1) * 32 + (lane & 3) * 8 + (4 * hi + ((lane & 15) >> 2)) * 64;
#pragma unroll
    for (int ks = 0; ks < 4; ++ks) {
        if ((ks < 2) ? !use0 : !use1) continue;
        const f32x16& p = (ks < 2) ? p0 : p1; const int r0 = (ks & 1) * 8;
        const u32x4 pw = (u32x4){pk2(p[r0], p[r0 + 1]), pk2(p[r0 + 2], p[r0 + 3]), pk2(p[r0 + 4], p[r0 + 5]), pk2(p[r0 + 6], p[r0 + 7])};
        const bf16x8 pa = __builtin_bit_cast(bf16x8, pw);
        const s16x4 l0 = vtr(vb + ks * 1024), h0 = vtr(vb + ks * 1024 + 512), l1 = vtr(vb + 4096 + ks * 1024), h1 = vtr(vb + 4096 + ks * 1024 + 512);
        o[0] = GLA_MFMA(pa, ((bf16x8){l0[0], l0[1], l0[2], l0[3], h0[0], h0[1], h0[2], h0[3]}), o[0]);
        o[1] = GLA_MFMA(pa, ((bf16x8){l1[0], l1[1], l1[2], l1[3], h1[0], h1[1], h1[2], h1[3]}), o[1]);
    }
    const bf16* sp = X.SB + ((size_t)(X.bh * 2 + DIR) * 36 + c) * 2048;
#pragma unroll
    for (int s = 0; s < 2; ++s) {
        const bf16x8 s0 = *(const bf16x8*)(sp + (r32) * 32 + 16 * s + 8 * hi), s1 = *(const bf16x8*)(sp + (r32 + 32) * 32 + 16 * s + 8 * hi);
        o[0] = GLA_MFMA(bq[s], s0, o[0]); o[1] = GLA_MFMA(bq[s], s1, o[1]);
    }
    GLA_LDSWAIT();
}
__device__ __forceinline__ void stage_c(const Ctx& X, int c, int qh, GLAS char* wl, int lane_in) {
    int lane = lane_in; asm volatile("" : "+v"(lane));
    GLAS char* vt = wl + 96 * KT_STRIDE;
    load_vtile(X.P + (size_t)(64 * c) * LD + cfg::E_GV + X.h * 64, vt, lane);
    f32x16 o[2]; o[0] = f32x16{}; o[1] = f32x16{};
    stage_c_dir<0>(X, c, qh, wl, lane, o);
    stage_c_dir<1>(X, c, qh, wl, lane, o);
    asm volatile("" : "+v"(lane));
    const int r32 = lane & 31, hi = lane >> 5;
    const float g0 = X.gg[r32], g1 = X.gg[r32 + 32];
#pragma unroll
    for (int r = 0; r < 16; ++r) {
        float ss = o[0][r] * o[0][r] + o[1][r] * o[1][r];
#pragma unroll
        for (int x = 1; x < 32; x <<= 1) ss += __shfl_xor(ss, x);
        const float rs = __builtin_amdgcn_rsqf(ss * (1.f / 64.f) + cfg::EPS);
        const size_t row = (size_t)(64 * c + 32 * qh + crow(r, hi));
        const bf16* gp = X.P + row * LD + cfg::E_GG + X.h * 64 + r32;
        const float ga = bf2f(gp[0]), gb = bf2f(gp[32]);
        bf16* mp = X.MIX + (X.mbase + row) * 1024 + X.h * 64 + r32;
        mp[0] = f2bf(o[0][r] * rs * g0 * (ga * __builtin_amdgcn_rcpf(1.f + ex(-ga))));
        mp[32] = f2bf(o[1][r] * rs * g1 * (gb * __builtin_amdgcn_rcpf(1.f + ex(-gb))));
    }
}
__device__ __forceinline__ void unit(const Ctx& X, GLAS char* lds, const int tid) {
    const int lane = tid & 63, wid = __builtin_amdgcn_readfirstlane(tid >> 6);
    GLAS char* wl = lds + wid * WAVE_LDS;
    for (int t = wid; t < 72; t += 8) { const int c = t >> 1; if (t & 1) stage_a<1>(X, c, wl, lane); else stage_a<0>(X, c, wl, lane); }
    asm volatile("s_waitcnt vmcnt(0)" ::: "memory"); __syncthreads();
    {
        const int dir = tid >> 8, dv = (tid >> 2) & 63, k8 = (tid & 3) * 8;
        float S[8];
#pragma unroll
        for (int i = 0; i < 8; ++i) S[i] = 0.f;
        const size_t base = (size_t)(X.bh * 2 + dir) * 36;
#pragma unroll 4
        for (int s = 0; s < 36; ++s) {
            const int c = dir == 0 ? (s < 4 ? 32 + s : s - 4) : 35 - s;
            const u32x4 uw = *(const u32x4*)(X.US + (base + c) * 2048 + dv * 32 + k8);
            const f32x4 d0 = *(const f32x4*)(X.DD + (base + c) * 32 + k8), d1 = *(const f32x4*)(X.DD + (base + c) * 32 + k8 + 4);
            *(u32x4*)(X.SB + (base + c) * 2048 + dv * 32 + k8) = (u32x4){pk2(S[0], S[1]), pk2(S[2], S[3]), pk2(S[4], S[5]), pk2(S[6], S[7])};
            const unsigned uu[4] = {uw.x, uw.y, uw.z, uw.w};
#pragma unroll
            for (int i = 0; i < 4; ++i) {
                S[2 * i] = (i < 2 ? d0[2 * i] : d1[2 * i - 4]) * S[2 * i] + __builtin_bit_cast(float, uu[i] << 16);
                S[2 * i + 1] = (i < 2 ? d0[2 * i + 1] : d1[2 * i - 3]) * S[2 * i + 1] + __builtin_bit_cast(float, uu[i] & 0xffff0000u);
            }
        }
    }
    asm volatile("s_waitcnt vmcnt(0)" ::: "memory"); __syncthreads();
    for (int t = wid; t < 72; t += 8) stage_c(X, t >> 1, t & 1, wl, lane);
    asm volatile("s_waitcnt vmcnt(0) lgkmcnt(0)" ::: "memory"); __syncthreads();
}
#undef GLAS
}
namespace fw {
using namespace cfg;
constexpr int NWAVES = 8;
constexpr size_t MiB = 1u << 20;
constexpr size_t WS_CTL = 0, CTL_ZERO_BYTES = 64 * 1024;
constexpr size_t WS_MOD = 1 * MiB;
constexpr size_t WS_TAB = 1 * MiB + 896 * 1024;
constexpr size_t WS_DD = 2 * MiB;
constexpr size_t WS_LR = 3 * MiB;
constexpr size_t WS_XC = 6 * MiB;
constexpr size_t WS_W = 14 * MiB;
constexpr size_t W_IN_E = (size_t)LDE * D * 2, W_IN_O = (size_t)LDO * D * 2, W_OUT = (size_t)D * D * 2, W_13 = (size_t)2 * FFH * D * 2, W_2 = (size_t)D * FFH * 2;
constexpr size_t W_LAYER_E = W_IN_E + W_OUT + W_13 + W_2, W_LAYER_O = W_IN_O + W_OUT + W_13 + W_2;
constexpr size_t WS_HN = 103 * MiB;
constexpr size_t WS_PROJ = 139 * MiB;
constexpr size_t WS_MIX = 229 * MiB;
constexpr size_t WS_H = 139 * MiB;
constexpr size_t WS_US = 265 * MiB, WS_SB = 283 * MiB;
constexpr size_t WS_END = 301 * MiB;
static_assert(WS_W + 2 * W_LAYER_E + 2 * W_LAYER_O <= WS_HN && WS_HN + (size_t)M * D * 2 <= WS_PROJ && WS_PROJ + (size_t)M * LDE * 2 <= WS_MIX && WS_MIX + (size_t)M * D * 2 <= WS_US, "ws map");
static_assert((size_t)2 * M * 256 * 4 <= (size_t)M * D * 2 && WS_H + (size_t)M * FFH * 2 <= WS_US && (size_t)64 * 72 * 4096 <= 18 * MiB, "ws map 2");
__host__ __device__ constexpr size_t w_layer_off(int l) { return (size_t)(l >> 1) * (W_LAYER_E + W_LAYER_O) + ((l & 1) ? W_LAYER_E : 0); }
constexpr int CW_TMO = 0, CW_BAR = 1024, CW_Q = 8192;
constexpr int RING_BYTES = 131072, MISC_OFF = RING_BYTES + 320, LDS_BYTES = 147456;

#define GAS __attribute__((address_space(1)))
#define LAS __attribute__((address_space(3)))
typedef unsigned short bf16;
typedef unsigned v4u __attribute__((ext_vector_type(4)));
typedef float f32x4 __attribute__((ext_vector_type(4)));
typedef GAS unsigned gu32;
#define RLX_AGENT __ATOMIC_RELAXED, __HIP_MEMORY_SCOPE_AGENT
#define LDS_WAIT() asm volatile("s_waitcnt lgkmcnt(0)" ::: "memory")
#define VM_WAIT() asm volatile("s_waitcnt vmcnt(0)" ::: "memory")
__device__ __forceinline__ unsigned f2bf(float f) { unsigned u = __builtin_bit_cast(unsigned, f); return (u + 0x7fffu + ((u >> 16) & 1u)) >> 16; }
__device__ __forceinline__ unsigned pk2(float lo, float hi) { return f2bf(lo) | (f2bf(hi) << 16); }
__device__ __forceinline__ float bf2f(unsigned short v) { return __builtin_bit_cast(float, (unsigned)v << 16); }
__device__ __forceinline__ float wave_sum(float v) {
#pragma unroll
    for (int o = 1; o < 64; o <<= 1) v += __shfl_xor(v, o);
    return v;
}

#define XB_TMO      128
#define XB_XCNT(j)  (256  + 64 * (j))
#define XB_XSUB(j)  (1280 + 64 * (j))
#define XB_XGEN(j)  (2304 + 64 * (j))
#define XB_TOP      3328
#define XB_TOPGEN   3392
#define XCD_BAR_WORDS 3456
#define XB_SPIN_CAP (1u << 18)
__device__ __forceinline__ unsigned xb_ld(unsigned* p)              { return __hip_atomic_load(p, __ATOMIC_RELAXED, __HIP_MEMORY_SCOPE_AGENT); }
__device__ __forceinline__ unsigned xb_add(unsigned* p, unsigned v) { return __hip_atomic_fetch_add(p, v, __ATOMIC_RELAXED, __HIP_MEMORY_SCOPE_AGENT); }
__device__ __forceinline__ unsigned xb_xcc_id() { return (unsigned)__builtin_amdgcn_s_getreg((3 << 11) | 20) & 0xFu; }
#define XB_SPIN(cond, bar) do { unsigned _sp = 0; while (cond) { __builtin_amdgcn_s_sleep(1); \
    if ((++_sp & 255u) == 0u) { if (xb_ld(&(bar)[XB_TMO])) break; if (_sp > XB_SPIN_CAP) { atomicAdd(&(bar)[XB_TMO], 1u); break; } } } } while (0)
struct XcdBarrier { unsigned* bar; unsigned x; volatile LAS unsigned* st; };
__device__ __forceinline__ XcdBarrier xcd_barrier_post(unsigned* bar, volatile LAS unsigned* st) {
    XcdBarrier b; b.bar = bar; b.x = xb_xcc_id(); b.st = st;
    if (threadIdx.x == 0) (void)xb_add(&bar[XB_XCNT(b.x)], 1u);
    return b;
}
__device__ __forceinline__ void xcd_barrier_complete(unsigned* bar, unsigned x, unsigned& nloc, unsigned& nx) {
    const unsigned G = gridDim.x * gridDim.y * gridDim.z;
    unsigned sum, cnt, mine, sp = 0u;
    for (;;) {
        sum = 0u; cnt = 0u; mine = 0u;
#pragma unroll
        for (unsigned j = 0; j < 16; ++j) { const unsigned c = xb_ld(&bar[XB_XCNT(j)]); sum += c; cnt += (c > 0u) ? 1u : 0u; mine = (j == x) ? c : mine; }
        if (sum == G) break;
        __builtin_amdgcn_s_sleep(1);
        if ((++sp & 255u) == 0u) { if (xb_ld(&bar[XB_TMO])) break; if (sp > XB_SPIN_CAP) { atomicAdd(&bar[XB_TMO], 1u); break; } }
    }
    nloc = mine > 0u ? mine : 1u; nx = cnt > 0u ? cnt : 1u;
}
__device__ __forceinline__ void xcd_barrier(const XcdBarrier& b, const bool t0) {
    asm volatile("s_waitcnt vmcnt(0)" ::: "memory");
    __syncthreads();
    if (t0) {
        unsigned* bar = b.bar;
        __builtin_amdgcn_s_waitcnt(0);
        unsigned nloc = b.st[0], nx = b.st[1];
        if (nloc == 0u) { xcd_barrier_complete(bar, b.x, nloc, nx); b.st[0] = nloc; b.st[1] = nx; }
        const unsigned old = xb_add(&bar[XB_XSUB(b.x)], 1u);
        const unsigned gen = old / nloc;
        if (old + 1u == (gen + 1u) * nloc) {
            __builtin_amdgcn_fence(__ATOMIC_RELEASE, "agent");
            asm volatile("s_waitcnt vmcnt(0)" ::: "memory");
            const unsigned og = xb_add(&bar[XB_TOP], 1u);
            const unsigned tg = og / nx;
            if (og + 1u == (tg + 1u) * nx) xb_add(&bar[XB_TOPGEN], 1u);
            else XB_SPIN(xb_ld(&bar[XB_TOPGEN]) == tg, bar);
            __builtin_amdgcn_fence(__ATOMIC_ACQUIRE, "agent");
            xb_add(&bar[XB_XGEN(b.x)], 1u);
            asm volatile("s_waitcnt vmcnt(0)" ::: "memory");
        } else {
            XB_SPIN(xb_ld(&bar[XB_XGEN(b.x)]) == gen, bar);
            __builtin_amdgcn_fence(__ATOMIC_ACQUIRE, "agent");
            asm volatile("s_waitcnt vmcnt(0)" ::: "memory");
        }
    }
    __syncthreads();
}

struct Args { const float* in[22]; float* out; unsigned char* ws; int ph_lo, ph_hi; };
typedef const __attribute__((address_space(4))) Args* ArgP;
enum { I_X = 0, I_C, I_CTX, I_CCTX, I_ADAW, I_ADAB, I_N1G, I_N2G, I_W1, I_W3, I_W2, I_EIN, I_EOUT, I_GKW, I_GKB, I_GLAG, I_QNG, I_KNG, I_OIN, I_OOUT, I_SINK, I_FG };
constexpr int N_PHASES = 34;

__device__ __forceinline__ void p0_mods(ArgP A, LAS unsigned char* lds, int vcu, int G, int tid, int lane, int wave) {
    LAS float* sc = (LAS float*)lds;
    LAS float* part = (LAS float*)(lds + 40960);
    if (vcu >= 384) return;
    for (int i = tid; i < 9 * 1024; i += 512) { const int j = i >> 10, k = i & 1023; const float v = j < 8 ? A->in[I_C][j * 1024 + k] : A->in[I_CCTX][k]; sc[i] = v * __builtin_amdgcn_rcpf(1.f + __builtin_amdgcn_exp2f(-LOG2E * v)); }
    __syncthreads();
    float* mod = (float*)(A->ws + WS_MOD);
    for (int t = vcu; t < 384; t += G) {
        const int l = t / 96, cg = t % 96, n = cg * 64 + lane;
        const float* w = A->in[I_ADAW] + ((size_t)l * 1024 + wave * 128) * 6144 + n;
        float acc[9];
#pragma unroll
        for (int j = 0; j < 9; ++j) acc[j] = 0.f;
#pragma unroll 8
        for (int k = 0; k < 128; ++k) { const float wv = w[(size_t)k * 6144];
#pragma unroll
            for (int j = 0; j < 9; ++j) acc[j] += sc[j * 1024 + wave * 128 + k] * wv; }
#pragma unroll
        for (int j = 0; j < 9; ++j) part[(wave * 9 + j) * 64 + lane] = acc[j];
        __syncthreads();
        for (int o = tid; o < 576; o += 512) { const int j = o >> 6, c = o & 63; float s = 0.f;
#pragma unroll
            for (int w8 = 0; w8 < 8; ++w8) s += part[(w8 * 9 + j) * 64 + c];
            mod[((size_t)l * 9 + j) * 6144 + cg * 64 + c] = s + A->in[I_ADAB][l * 6144 + cg * 64 + c]; }
        __syncthreads();
    }
}
__device__ __forceinline__ void p0_item(const float* W, int Nsrc, int srccol, int k0, bf16* WT, int K, int dstrow, LAS float* scr, int lane) {
    if (srccol >= 0) {
#pragma unroll 8
        for (int i = 0; i < 32; ++i) { const int kk = 2 * i + (lane >> 5); scr[kk * 33 + (lane & 31)] = W[(size_t)(k0 + kk) * Nsrc + srccol + (lane & 31)]; }
    } else {
#pragma unroll 8
        for (int i = 0; i < 32; ++i) { const int kk = 2 * i + (lane >> 5); scr[kk * 33 + (lane & 31)] = 0.f; }
    }
    LDS_WAIT(); asm volatile("" ::: "memory");
    const int c = lane & 7;
#pragma unroll
    for (int j = 0; j < 4; ++j) { const int n = (lane >> 3) + 8 * j; const LAS float* s = scr + (8 * c) * 33 + n;
        v4u o; o.x = pk2(s[0 * 33], s[1 * 33]); o.y = pk2(s[2 * 33], s[3 * 33]); o.z = pk2(s[4 * 33], s[5 * 33]); o.w = pk2(s[6 * 33], s[7 * 33]);
        *(GAS v4u*)(WT + (size_t)(dstrow + n) * K + k0 + 8 * c) = o; }
    LDS_WAIT(); asm volatile("" ::: "memory");
}
__device__ __forceinline__ void p0_weights(ArgP A, LAS unsigned char* lds, int vcu, int G, int lane, int wave) {
    LAS float* scr = (LAS float*)(lds + wave * 16384);
    const int gw = vcu * NWAVES + wave, NGW = G * NWAVES;
    constexpr int IT_E = 16 * 80, IT_O = 16 * 40, IT_OUT = 16 * 32, IT_13 = 16 * 176, IT_2 = 44 * 32;
    constexpr int PER_E = IT_E + IT_OUT + IT_13 + IT_2, PER_O = IT_O + IT_OUT + IT_13 + IT_2, TOTAL = 2 * (PER_E + PER_O);
    for (int it = gw; it < TOTAL; it += NGW) {
        int r = it; const int pair = r / (PER_E + PER_O); r -= pair * (PER_E + PER_O);
        const int odd = r >= PER_E ? 1 : 0; if (odd) r -= PER_E;
        const int l = 2 * pair + odd, i = pair;
        bf16* wl = (bf16*)(A->ws + WS_W + w_layer_off(l));
        const int it_in = odd ? IT_O : IT_E; const size_t w_in_b = odd ? W_IN_O : W_IN_E;
        if (r < it_in) {
            const int nblk = odd ? 40 : 80, kb = r / nblk, nb = r % nblk, d0 = 32 * nb;
            if (odd) p0_item(A->in[I_OIN] + (size_t)i * D * LDO, LDO, d0, 64 * kb, wl, D, d0, scr, lane);
            else { const int sc = d0 < 1536 ? d0 : (d0 < 2304 ? d0 + 32 : (d0 == 2304 ? 1536 : -1)); p0_item(A->in[I_EIN] + (size_t)i * D * 2336, 2336, sc, 64 * kb, wl, D, d0, scr, lane); }
            continue; }
        r -= it_in;
        if (r < IT_OUT) { const int kb = r / 32, nb = r % 32; p0_item((odd ? A->in[I_OOUT] : A->in[I_EOUT]) + (size_t)i * D * D, D, 32 * nb, 64 * kb, (bf16*)((unsigned char*)wl + w_in_b), D, 32 * nb, scr, lane); continue; }
        r -= IT_OUT;
        if (r < IT_13) { const int kb = r / 176, nb = r % 176, d0 = 32 * nb, tile = d0 >> 8, within = d0 & 255;
            const float* src = (within < 128 ? A->in[I_W1] : A->in[I_W3]) + (size_t)l * D * FFH;
            p0_item(src, FFH, 128 * tile + (within & 127), 64 * kb, (bf16*)((unsigned char*)wl + w_in_b + W_OUT), D, d0, scr, lane); continue; }
        r -= IT_13;
        { const int kb = r / 32, nb = r % 32; p0_item(A->in[I_W2] + (size_t)l * FFH * D, D, 32 * nb, 64 * kb, (bf16*)((unsigned char*)wl + w_in_b + W_OUT + W_13), FFH, 32 * nb, scr, lane); }
    }
}
__device__ __forceinline__ void p0_tab(ArgP A, int tid) {
    float2* tab = (float2*)(A->ws + WS_TAB);
    for (int e = tid; e < 1024; e += 512) {
        const int p = e >> 4, i = e & 15;
        const float inv = __builtin_amdgcn_exp2f(-(float)(2 * i) * (1.f / 32.f) * 13.287712379549449f);
        const float ang = (float)p * inv;
        const double x = (double)ang; const double twopi = 6.283185307179586476925286766559, hp = 1.5707963267948966192313216916398;
        double r = x - twopi * __builtin_rint(x / twopi);
        const double q = __builtin_rint(r / hp); r -= q * hp; const int qi = ((int)q) & 3;
        const double r2 = r * r;
        const double s = r * (1.0 + r2 * (-1.0 / 6 + r2 * (1.0 / 120 + r2 * (-1.0 / 5040 + r2 * (1.0 / 362880 + r2 * (-1.0 / 39916800 + r2 * (1.0 / 6227020800.0)))))));
        const double c = 1.0 + r2 * (-0.5 + r2 * (1.0 / 24 + r2 * (-1.0 / 720 + r2 * (1.0 / 40320 + r2 * (-1.0 / 3628800 + r2 * (1.0 / 479001600.0 + r2 * (-1.0 / 87178291200.0)))))));
        double cs, sn;
        if (qi == 0) { cs = c; sn = s; } else if (qi == 1) { cs = -s; sn = c; } else if (qi == 2) { cs = -c; sn = -s; } else { cs = s; sn = -c; }
        tab[e] = make_float2((float)cs, (float)sn);
    }
}

__device__ __forceinline__ const float* x_row(const float* lat, const float* ctx, int b, int t) { return t < SEQ ? lat + ((size_t)b * SEQ + t) * D : ctx + ((size_t)b * CTX + (t - SEQ)) * D; }

__device__ __forceinline__ void norm_phase(ArgP A, int l, int which, bool with_ctx, int gw, int NGW, int lane) {
    const float* lat = l == 0 && which == 0 ? A->in[I_X] : A->out; const float* cx = l == 0 && which == 0 ? A->in[I_CTX] : (const float*)(A->ws + WS_XC);
    const float* g = (which ? A->in[I_N2G] : A->in[I_N1G]) + l * D; const float* mod = (const float*)(A->ws + WS_MOD) + (size_t)l * 9 * 6144 + which * 3 * D;
    bf16* HN = (bf16*)(A->ws + WS_HN);
    f32x4 gv[4];
#pragma unroll
    for (int j = 0; j < 4; ++j) gv[j] = *(const f32x4*)(g + lane * 4 + 256 * j);
    for (int m = gw; m < M; m += NGW) {
        const int b = m / RB, t = m - b * RB;
        if (t >= SEQ && !with_ctx) continue;
        const float* xr = x_row(lat, cx, b, t) + lane * 4; const float* mp = mod + (size_t)(t < SEQ ? b : 8) * 6144 + lane * 4;
        f32x4 v[4]; float s = 0.f;
#pragma unroll
        for (int j = 0; j < 4; ++j) { v[j] = *(const f32x4*)(xr + 256 * j); s += (v[j].x * v[j].x + v[j].y * v[j].y) + (v[j].z * v[j].z + v[j].w * v[j].w); }
        const float r = __builtin_amdgcn_rsqf(wave_sum(s) * (1.f / D) + EPS);
        unsigned long long* o8 = (unsigned long long*)(HN + (size_t)m * D) + lane;
#pragma unroll
        for (int j = 0; j < 4; ++j) { const f32x4 sh = *(const f32x4*)(mp + 256 * j), sc = *(const f32x4*)(mp + D + 256 * j);
            const f32x4 y = v[j] * r * gv[j] * (sc + 1.f) + sh;
            o8[64 * j] = (unsigned long long)pk2(y.x, y.y) | ((unsigned long long)pk2(y.z, y.w) << 32); }
    }
}
__device__ __forceinline__ void final_phase(ArgP A, int gw, int NGW, int lane) {
    f32x4 gv[4];
#pragma unroll
    for (int j = 0; j < 4; ++j) gv[j] = *(const f32x4*)(A->in[I_FG] + lane * 4 + 256 * j);
    for (int m = gw; m < NB * SEQ; m += NGW) {
        float* xr = A->out + (size_t)m * D + lane * 4; f32x4 v[4]; float s = 0.f;
#pragma unroll
        for (int j = 0; j < 4; ++j) { v[j] = *(const f32x4*)(xr + 256 * j); s += (v[j].x * v[j].x + v[j].y * v[j].y) + (v[j].z * v[j].z + v[j].w * v[j].w); }
        const float r = __builtin_amdgcn_rsqf(wave_sum(s) * (1.f / D) + EPS);
#pragma unroll
        for (int j = 0; j < 4; ++j) *(f32x4*)(xr + 256 * j) = v[j] * r * gv[j];
    }
}
__device__ __forceinline__ void head_prep(bf16* p, int lane, bool norm, float gn, bool latent, const float2* tab, int t, float outscale) {
    float v = bf2f(p[lane]);
    if (norm) { const float ms = wave_sum(v * v) * (1.f / 64.f); v = v * __builtin_amdgcn_rsqf(ms + EPS) * gn; }
    if (latent) { const int i = lane & 15, pos = (lane < 32) ? (t >> 6) : (t & 63); const float2 cs = tab[pos * 16 + i];
        const float partner = __shfl_xor(v, 16); const float rot = (lane & 16) ? partner : -partner; v = v * cs.x + rot * cs.y; }
    p[lane] = (bf16)f2bf(v * outscale);
}
__device__ __forceinline__ void prep_even(ArgP A, int i, LAS unsigned char* lds, int gw, int NGW, int tid, int lane) {
    LAS float* gkw = (LAS float*)lds;
    for (int e = tid; e < 2 * 16 * 256; e += 512) gkw[e] = A->in[I_GKW][(size_t)i * 2 * 16 * 256 + e];
    __syncthreads();
    bf16* P = (bf16*)(A->ws + WS_PROJ); const float* LR = (const float*)(A->ws + WS_LR); float* DEC = (float*)(A->ws + WS_HN); const float2* tab = (const float2*)(A->ws + WS_TAB);
    const float qn = A->in[I_QNG][i * 64 + lane], kn = A->in[I_KNG][i * 64 + lane];
    const float* gkb = A->in[I_GKB] + (size_t)i * 512 + lane * 4;
    for (int m = gw; m < M; m += NGW) {
        const int b = m / RB, t = m - b * RB; const bool latent = t < SEQ;
        bf16* pr = P + (size_t)m * LDE;
#pragma nounroll
        for (int hh = 0; hh < 10; ++hh) head_prep(pr + (hh < 8 ? E_BQ + 64 * hh : E_BK + 64 * (hh - 8)), lane, true, hh < 8 ? qn : kn, latent, tab, t, hh < 8 ? C2 : 1.f);
        const float* lr = LR + (size_t)m * 32;
#pragma nounroll
        for (int dir = 0; dir < 2; ++dir) {
            f32x4 x = *(const f32x4*)(gkb + dir * 256);
#pragma nounroll
            for (int r4 = 0; r4 < 4; ++r4) { const f32x4 lv = *(const f32x4*)(lr + dir * 16 + r4 * 4);
#pragma unroll
                for (int q = 0; q < 4; ++q) x += lv[q] * *(const LAS f32x4*)(gkw + (dir * 16 + r4 * 4 + q) * 256 + lane * 4); }
            f32x4 o;
#pragma unroll
            for (int q = 0; q < 4; ++q) o[q] = (fminf(x[q], 0.f) - __logf(1.f + __expf(-fabsf(x[q])))) * (1.f / 16.f);
            *(f32x4*)(DEC + ((size_t)dir * M + m) * 256 + lane * 4) = o;
        }
    }
}
__device__ __forceinline__ void prep_odd(ArgP A, int gw, int NGW, int lane) {
    bf16* P = (bf16*)(A->ws + WS_PROJ); const float2* tab = (const float2*)(A->ws + WS_TAB);
    for (int m = gw; m < M; m += NGW) {
        const int b = m / RB, t = m - b * RB; const bool latent = t < SEQ;
        bf16* pr = P + (size_t)m * LDO;
#pragma nounroll
        for (int hh = 0; hh < 18; ++hh) { if (hh >= 16 && !latent) break; head_prep(pr + (hh < 16 ? O_Q + 64 * hh : O_K + 64 * (hh - 16)), lane, false, 1.f, latent, tab, t, hh < 16 ? C2 : 1.f); }
    }
}

__device__ __forceinline__ int q_next(gu32* ctr, volatile LAS unsigned* slot, int tid) {
    __syncthreads();
    if (tid == 0) slot[0] = __hip_atomic_fetch_add(ctr, 1u, RLX_AGENT);
    __syncthreads();
    return (int)slot[0];
}
__device__ __forceinline__ void mixer_even(ArgP A, int l, LAS unsigned char* ldsl, char* lds, volatile LAS unsigned* MISC, int tid) {
    const int i = l >> 1; gu32* ctr = (gu32*)(A->ws + WS_CTL) + CW_Q + 64 * l;
    const ab::bf16* P = (const ab::bf16*)(A->ws + WS_PROJ); ab::bf16* MIXp = (ab::bf16*)(A->ws + WS_MIX);
    const int total = 64 + 512 + 64;
    for (;;) {
        const int idx = q_next(ctr, MISC + 16, tid);
        if (idx >= total) break;
        if (idx < 64) {
            gla::Ctx X; const int b = idx >> 3, h = idx & 7;
            X.P = (const gla::bf16*)(A->ws + WS_PROJ) + (size_t)b * RB * LDE; X.DEC = (const float*)(A->ws + WS_HN); X.mbase = (size_t)b * RB; X.h = h; X.bh = idx;
            X.US = (gla::bf16*)(A->ws + WS_US); X.SB = (gla::bf16*)(A->ws + WS_SB); X.DD = (float*)(A->ws + WS_DD); X.MIX = (gla::bf16*)(A->ws + WS_MIX); X.gg = A->in[I_GLAG] + i * 64;
#ifndef NO_GLA
            { int t_ = tid; asm volatile("" : "+v"(t_)); gla::unit(X, (__attribute__((address_space(3))) char*)ldsl, t_); }
#endif
        } else {
            ab::AUnit U; int b, head, j;
            if (idx < 64 + 512) { const int r = idx - 64; b = r >> 6; head = (r >> 3) & 7; j = r & 7; U.r1 = 0; U.NT = 36; }
            else { const int r = idx - 576; b = r >> 3; head = r & 7; j = 8; U.r1 = SEQ; U.NT = 4; }
            const size_t row0 = (size_t)b * RB, qrow = row0 + 256 * j;
            U.Q = P + qrow * LDE + E_BQ + 64 * head; U.K = P + row0 * LDE + E_BK + 64 * (head >> 2); U.V = P + row0 * LDE + E_BV + 64 * (head >> 2);
            U.O = MIXp + qrow * 1024 + 512 + 64 * head; U.r2 = 0; U.q0 = 256 * j; U.sink2 = -INFINITY;
#ifndef NO_ATTB
            { int t_ = tid; asm volatile("" : "+v"(t_)); ab::attn_unit<LDE, 0, 8>(U, lds, t_); }
#endif
        }
    }
}
__device__ __forceinline__ void mixer_odd(ArgP A, int l, bool with_ctx, char* lds, volatile LAS unsigned* MISC, int tid) {
    const int i = l >> 1; gu32* ctr = (gu32*)(A->ws + WS_CTL) + CW_Q + 64 * l;
    const ab::bf16* P = (const ab::bf16*)(A->ws + WS_PROJ); ab::bf16* MIXp = (ab::bf16*)(A->ws + WS_MIX);
    const int total = 1024 + (with_ctx ? 128 : 0);
    for (;;) {
        const int idx = q_next(ctr, MISC + 16, tid);
        if (idx >= total) break;
        ab::AUnit U; int b, head, j;
        U.r1 = SEQ;
        if (idx < 1024) { b = idx >> 7; head = (idx >> 3) & 15; j = idx & 7; const int lo = max(0, 256 * j - 128), hi = min(SEQ, 256 * j + 384); U.r2 = lo; U.NT = 4 + (hi - lo) / 64; }
        else { const int r = idx - 1024; b = r >> 4; head = r & 15; j = 8; U.r2 = 0; U.NT = 4; }
        const size_t row0 = (size_t)b * RB, qrow = row0 + 256 * j;
        U.Q = P + qrow * LDO + O_Q + 64 * head; U.K = P + row0 * LDO + O_K + 64 * (head >> 3); U.V = P + row0 * LDO + O_V + 64 * (head >> 3);
        U.O = MIXp + qrow * 1024 + 64 * head; U.q0 = 256 * j; U.sink2 = A->in[I_SINK][i * 16 + head] * LOG2E;
#ifndef NO_ATTC
        { int t_ = tid; asm volatile("" : "+v"(t_)); ab::attn_unit<LDO, 1, 8>(U, lds, t_); }
#endif
    }
}

__global__ void __launch_bounds__(NWAVES * 64, 2) fwd(Args A_) {
    extern __shared__ __attribute__((aligned(16))) unsigned char lds[];
    LAS unsigned char* ldsl = (LAS unsigned char*)lds;
    volatile LAS unsigned* MISC = (volatile LAS unsigned*)(ldsl + MISC_OFF);
    for (int u = threadIdx.x; u < (LDS_BYTES - RING_BYTES) / 4; u += NWAVES * 64) ((LAS unsigned*)(ldsl + RING_BYTES))[u] = 0u;
    __syncthreads();
    const int wave_s = __builtin_amdgcn_readfirstlane(threadIdx.x >> 6);
    const int ph_lo = A_.ph_lo, ph_hi = A_.ph_hi;
    gu32* ctl = (gu32*)(A_.ws + WS_CTL);
    XcdBarrier bar; bar.bar = (unsigned*)(ctl + CW_BAR); bar.x = 0; bar.st = nullptr;
    const bool multi = (ph_hi - ph_lo) > 1;
    if (multi) bar = xcd_barrier_post((unsigned*)(ctl + CW_BAR), MISC + 8);
#pragma nounroll
    for (int ph = ph_lo; ph < ph_hi; ++ph) {
        ArgP A = (ArgP)__builtin_amdgcn_kernarg_segment_ptr(); asm volatile("" : "+s"(A));
        const int lane = olane(), wave = wave_s, tid = wave * 64 + lane;
        const int G = ogrid(), bx = obid(), vcu = (G % 8 == 0) ? (bx % 8) * (G / 8) + bx / 8 : bx;
        const int gw = vcu * NWAVES + wave, NGW = G * NWAVES;
        if (ph == 0) {
#ifndef NO_P0M
            p0_mods(A, ldsl, vcu, G, tid, lane, wave);
#endif
            __syncthreads();
#ifndef NO_P0W
            p0_weights(A, ldsl, vcu, G, lane, wave);
#endif
#ifndef NO_P0T
            if (vcu == G - 1) p0_tab(A, tid);
#endif
        } else if (ph == N_PHASES - 1) {
            final_phase(A, gw, NGW, lane);
        } else {
            const int l = (ph - 1) >> 3, s = (ph - 1) & 7, i = l >> 1; const bool odd = l & 1, with_ctx = l < DEPTH - 1;
            unsigned char* wl = A->ws + WS_W + w_layer_off(l); const size_t w_in_b = odd ? W_IN_O : W_IN_E;
            const float* mod = (const float*)(A->ws + WS_MOD) + (size_t)l * 9 * 6144;
            if (s == 0) norm_phase(A, l, 0, true, gw, NGW, lane);
            else if (s == 1) {
                pg8::Gemm g{(const pg8::bf16_t*)(A->ws + WS_HN), (const pg8::bf16_t*)wl, M, odd ? LDO : LDE, D};
                pg8::RowSched S; S.init(M / 256, odd ? LDO : LDE, G, bx, false);
                pg8::EpiProj E{(pg8::bf16_t*)(A->ws + WS_PROJ), odd ? LDO : LDE, (float*)(A->ws + WS_LR), odd ? -1 : 9};
#ifndef NO_G1
                pg8::gemm_phase<pg8::EpiProj, pg8::RowSched, true, true>(ldsl, g, S, E, tid);
#endif
            } else if (s == 2) {
#ifndef NO_PREP
                if (odd) prep_odd(A, gw, NGW, lane); else prep_even(A, i, ldsl, gw, NGW, tid, lane);
#endif
            }
            else if (s == 3) { if (odd) mixer_odd(A, l, with_ctx, (char*)lds, MISC, tid); else mixer_even(A, l, ldsl, (char*)lds, MISC, tid); }
            else if (s == 4 || s == 7) {
                const bool down = s == 7;
                pg8::Gemm g{(const pg8::bf16_t*)(A->ws + (down ? WS_H : WS_MIX)), (const pg8::bf16_t*)(wl + w_in_b + (down ? W_OUT + W_13 : 0)), M, D, down ? FFH : D};
                pg8::RowSched S; S.init(with_ctx ? 72 : 64, D, G, bx, !with_ctx);
                const bool first = (l == 0 && !down);
                pg8::EpiResid E{first ? A->in[I_X] : A->out, first ? A->in[I_CTX] : (const float*)(A->ws + WS_XC), A->out, (float*)(A->ws + WS_XC), mod + (down ? 5 : 2) * D};
#ifndef NO_G2
                pg8::gemm_phase<pg8::EpiResid, pg8::RowSched, true, true>(ldsl, g, S, E, tid);
#endif
            } else if (s == 5) norm_phase(A, l, 1, with_ctx, gw, NGW, lane);
            else {
                pg8::Gemm g{(const pg8::bf16_t*)(A->ws + WS_HN), (const pg8::bf16_t*)(wl + w_in_b + W_OUT), M, 2 * FFH, D};
                pg8::RowSched S; S.init(with_ctx ? 72 : 64, 2 * FFH, G, bx, !with_ctx);
                pg8::EpiSwiglu E{(pg8::bf16_t*)(A->ws + WS_H), FFH};
#ifndef NO_G3
                pg8::gemm_phase<pg8::EpiSwiglu, pg8::RowSched, true, true>(ldsl, g, S, E, tid);
#endif
            }
        }
        if (ph + 1 < ph_hi) xcd_barrier(bar, tid == 0);
    }
}

inline int grid_size() {
    static int grid = 0;
    if (grid == 0) {
        int dev = 0, cus = 0, per_cu = 0;
        if (hipGetDevice(&dev) != hipSuccess || hipDeviceGetAttribute(&cus, hipDeviceAttributeMultiprocessorCount, dev) != hipSuccess) { grid = -1; return grid; }
        if (hipFuncSetAttribute((const void*)fwd, hipFuncAttributeMaxDynamicSharedMemorySize, LDS_BYTES) != hipSuccess) { grid = -1; return grid; }
        if (hipOccupancyMaxActiveBlocksPerMultiprocessor(&per_cu, (const void*)fwd, NWAVES * 64, LDS_BYTES) != hipSuccess || per_cu < 1) per_cu = 1;
        (void)hipGetLastError();
        grid = cus;
    }
    return grid;
}
inline void launch_phases(hipStream_t st, const Args& a0, int lo, int hi) { Args a = a0; a.ph_lo = lo; a.ph_hi = hi; hipLaunchKernelGGL(fwd, dim3(grid_size()), dim3(NWAVES * 64), LDS_BYTES, st, a); }
inline Args make_args(void* const* d_in, void* d_out, void* d_ws) { Args a{}; for (int i = 0; i < 22; ++i) a.in[i] = (const float*)d_in[i]; a.out = (float*)d_out; a.ws = (unsigned char*)d_ws; return a; }
}
#ifndef MK_PER_PHASE
#define MK_PER_PHASE 1
#endif
extern "C" void kernel_launch(void* const* d_in, const int* in_sizes, int n_in, void* d_out, int out_size, void* d_ws, size_t ws_size, hipStream_t stream) {
    if (fw::grid_size() <= 0 || ws_size < fw::WS_END) return;
    (void)hipMemsetAsync((char*)d_ws + fw::WS_CTL, 0, fw::CTL_ZERO_BYTES, stream);
    const fw::Args a = fw::make_args(d_in, d_out, d_ws);
#if MK_PER_PHASE
    for (int ph = 0; ph < fw::N_PHASES; ++ph) fw::launch_phases(stream, a, ph, ph + 1);
#else
    fw::launch_phases(stream, a, 0, fw::N_PHASES);
#endif
}
```

```cpp
#define GLAC_GATE_EARLY 1
#define RESID_VIA_LDS 1
#define MK_PER_PHASE 0
#define KSPLIT_DOWN 4
#include <hip/hip_runtime.h>
#include <hip/hip_bf16.h>
#include <cstdio>
#include <cstdint>
#include <cmath>
namespace cfg {
constexpr int D = 1024, NB = 8, SEQ = 2048, CTX = 256, RB = SEQ + CTX  , M = NB * RB  , FFH = 2816;
constexpr int LDE = 2560  , LDO = 1280, DEPTH = 4;
constexpr float EPS = 1e-6f, LOG2E = 1.4426950408889634f, C2 = 0.125f * 1.4426950408889634f;
constexpr int E_GQ = 0, E_GK = 256, E_GV = 512, E_GG = 1024, E_BQ = 1536, E_BK = 2048, E_BV = 2176, E_LR = 2304;
constexpr int O_Q = 0, O_K = 1024, O_V = 1152;
}
__device__ __forceinline__ int olane() { int l; asm volatile("v_mbcnt_lo_u32_b32 %0, -1, 0\n\tv_mbcnt_hi_u32_b32 %0, -1, %0" : "=v"(l)); return l; }
__device__ __forceinline__ int obid() { int b = blockIdx.x; asm volatile("" : "+s"(b)); return b; }
__device__ __forceinline__ int ogrid() { int g = gridDim.x; asm volatile("" : "+s"(g)); return g; }
namespace xl {
template <int CTRL> __device__ __forceinline__ float dpp_mov(float v) { return __builtin_bit_cast(float, __builtin_amdgcn_update_dpp(0, __builtin_bit_cast(int, v), CTRL, 0xf, 0xf, false)); }
__device__ __forceinline__ float xor1(float v) { return dpp_mov<0xB1>(v); }
__device__ __forceinline__ float xor2(float v) { return dpp_mov<0x4E>(v); }
__device__ __forceinline__ float xor16(float v) { return __builtin_bit_cast(float, __builtin_amdgcn_ds_swizzle(__builtin_bit_cast(int, v), 0x401F)); }
__device__ __forceinline__ float add_xor32(float v) { const unsigned u = __builtin_bit_cast(unsigned, v); auto r = __builtin_amdgcn_permlane32_swap(u, u, false, false); return __builtin_bit_cast(float, (unsigned)r[0]) + __builtin_bit_cast(float, (unsigned)r[1]); }
__device__ __forceinline__ float sum8(float v) { v += xor1(v); v += xor2(v); v += dpp_mov<0x141>(v); return v; }
__device__ __forceinline__ float sum16(float v) { v = sum8(v); v += dpp_mov<0x140>(v); return v; }
__device__ __forceinline__ float sum64(float v) { v = sum16(v);
    const int i = __builtin_bit_cast(int, v);
    return (__builtin_bit_cast(float, __builtin_amdgcn_readlane(i, 0)) + __builtin_bit_cast(float, __builtin_amdgcn_readlane(i, 16))) + (__builtin_bit_cast(float, __builtin_amdgcn_readlane(i, 32)) + __builtin_bit_cast(float, __builtin_amdgcn_readlane(i, 48))); }
}
namespace fwpost { struct Ctx; __device__ __forceinline__ void run(const Ctx& c, int pm, int pn, int tid); }
namespace pg8 {
#define PG8_LAS __attribute__((address_space(3)))
typedef unsigned short bf16_t;
typedef short bf16x8 __attribute__((ext_vector_type(8)));
typedef float f32x4 __attribute__((ext_vector_type(4)));
typedef unsigned u32x4 __attribute__((ext_vector_type(4)));
constexpr int BM = 256, BK = 64, HALF = 128, HTB = HALF * BK * 2  , STAGE_BYTES = 8 * HTB, NXCD = 8, WGM = 8;

__host__ __device__ __forceinline__ int lds_byte(int r, int c) { const int st = (r >> 4) * 2 + (c >> 5), rr = r & 15, cc = c & 31, ob = rr * 64 + cc * 2; return st * 1024 + (ob ^ (((ob >> 9) & 1) << 5)); }
__host__ __device__ __forceinline__ void stage_rc(int b, int& R, int& C) { const int st = b / 1024, sb = b % 1024, swz = sb ^ (((sb >> 9) & 1) << 5); R = (st >> 1) * 16 + swz / 64; C = (st & 1) * 32 + (swz % 64) / 2; }
__host__ __device__ __forceinline__ int perm32(int rho) { const int n = rho >> 4, i = rho & 15; return 8 * (i >> 2) + 4 * n + (i & 3); }

struct Unit { int pm, pn; int kt0, nkt, sp, sl, ul, ord; int rl; };
struct Gemm { const bf16_t* A; const bf16_t* Bt; int M, N, K; float* slab; unsigned* cnt; };

struct StaticOrder {
    int nM, nN, nwg, G, c;
    __host__ __device__ void init(int M, int N, int G_, int c_) { nM = M / BM; nN = N / BM; nwg = nM * nN; G = G_; c = c_; }
    __host__ __device__ bool next(int i, Unit& u) const { return at((long)i * G + c, u); }
    __host__ __device__ bool at(const long L, Unit& u) const {
        if (L >= nwg) return false;
        int wgid = (int)L; { const int q = nwg / NXCD, r = nwg % NXCD, xcd = wgid % NXCD, off = wgid / NXCD; wgid = (xcd < r ? xcd * (q + 1) : r * (q + 1) + (xcd - r) * q) + off; }
        const int nig = WGM * nN, gid = wgid / nig, fm = gid * WGM, gsz = (nM - fm) < WGM ? (nM - fm) : WGM;
        u.pm = fm + ((wgid % nig) % gsz); u.pn = (wgid % nig) / gsz; return true;
    }
    __device__ __forceinline__ void a_ready(const Unit&) const {}
    __device__ __forceinline__ void done(const Unit&) const {}
};

__device__ __forceinline__ unsigned cvt_pk_bf16(float lo, float hi) { unsigned r; asm volatile("v_cvt_pk_bf16_f32 %0, %1, %2" : "=v"(r) : "v"(lo), "v"(hi)); return r; }
__device__ __forceinline__ int batch_kind(int pm) { const int b = pm / 9; return (pm - 9 * b) < 8 ? b : 8; }
struct EpiProj {
    static constexpr bool PERM = true, AFTER_DRAIN = false, PAIR = false, CAN_SPLIT = false, RESID_LDS = false; static constexpr int SLAB_W = 256;
    bf16_t* O; int ldc; float* LR; int lr_pn; const PG8_LAS float* rtab; const float* cb; int ncb;
    const fwpost::Ctx* pc; int post_lo, post_hi;
    static constexpr bool HAS_POST = true;
    __device__ __forceinline__ bool needs_post(const Unit& u) const { return u.pn >= post_lo && u.pn <= post_hi; }
    __device__ __forceinline__ void post(const Unit& u, int tid) const { fwpost::run(*pc, u.pm, u.pn, tid); }
    __device__ __forceinline__ void operator()(const f32x4 (&acc)[2][2][4][2], const Unit& u, int wr, int wc, int fr_in, int fq_in) const {
        int fr = fr_in, fq = fq_in; asm volatile("" : "+v"(fr), "+v"(fq));
        const int row0 = u.pm * BM + wr * 64 + fr; const PG8_LAS float* rt = rtab + u.ord * 256 + wr * 64 + fr;
        const int col0 = u.pn * BM + wc * 32 + 8 * fq; const float* cbv = cb + (size_t)batch_kind(u.pm) * ncb + col0;
        if (u.pn == lr_pn) {
            if (wc == 0) { const f32x4 c0 = *(const f32x4*)cbv, c1 = *(const f32x4*)(cbv + 4);
#pragma unroll
                for (int ai = 0; ai < 2; ++ai)
#pragma unroll
                    for (int m = 0; m < 4; ++m) { const float r = rt[ai * HALF + m * 16]; float* p = LR + (size_t)(row0 + ai * HALF + m * 16) * 32 + 8 * fq; *(f32x4*)p = acc[ai][0][m][0] * r + c0; *(f32x4*)(p + 4) = acc[ai][0][m][1] * r + c1; }
            }
            return;
        }
        f32x4 cv[2][2];
#pragma unroll
        for (int bj = 0; bj < 2; ++bj)
#pragma unroll
            for (int n = 0; n < 2; ++n) cv[bj][n] = *(const f32x4*)(cbv + bj * HALF + 4 * n);
#pragma unroll
        for (int ai = 0; ai < 2; ++ai)
#pragma unroll
            for (int m = 0; m < 4; ++m) { bf16_t* rowp = O + (size_t)(row0 + ai * HALF + m * 16) * ldc + col0; const float r = rt[ai * HALF + m * 16];
#pragma unroll
                for (int bj = 0; bj < 2; ++bj) { const f32x4 v0 = acc[ai][bj][m][0] * r + cv[bj][0], v1 = acc[ai][bj][m][1] * r + cv[bj][1];
                    u32x4 w; w.x = cvt_pk_bf16(v0[0], v0[1]); w.y = cvt_pk_bf16(v0[2], v0[3]); w.z = cvt_pk_bf16(v1[0], v1[1]); w.w = cvt_pk_bf16(v1[2], v1[3]);
                    *(u32x4*)(rowp + bj * HALF) = w; } }
    }
};
__device__ __forceinline__ float silu_mul(float a, float b) { return a * __builtin_amdgcn_rcpf(1.f + __builtin_amdgcn_exp2f(-1.4426950408889634f * a)) * b; }
__device__ __forceinline__ f32x4 silu_mul4(const f32x4 a, const f32x4 b) {
    const f32x4 t = a * -1.4426950408889634f; f32x4 e;
    e[0] = __builtin_amdgcn_exp2f(t[0]); e[1] = __builtin_amdgcn_exp2f(t[1]); e[2] = __builtin_amdgcn_exp2f(t[2]); e[3] = __builtin_amdgcn_exp2f(t[3]);
    const f32x4 d = e + 1.f; f32x4 r;
    r[0] = __builtin_amdgcn_rcpf(d[0]); r[1] = __builtin_amdgcn_rcpf(d[1]); r[2] = __builtin_amdgcn_rcpf(d[2]); r[3] = __builtin_amdgcn_rcpf(d[3]);
    return (a * b) * r;
}
struct EpiSwiglu {
    static constexpr bool PERM = true, AFTER_DRAIN = false, PAIR = true, CAN_SPLIT = false, RESID_LDS = false; static constexpr int SLAB_W = 128;
    bf16_t* H; int ldh; const PG8_LAS float* rtab; const float* cb; int ncb;
    static constexpr bool HAS_POST = false;
    __device__ __forceinline__ void operator()(const f32x4 (&acc)[2][2][4][2], const Unit& u, int wr, int wc, int fr_in, int fq_in) const {
        int fr = fr_in, fq = fq_in; asm volatile("" : "+v"(fr), "+v"(fq));
        const int row0 = u.pm * BM + wr * 64 + fr, col0 = u.pn * HALF + wc * 32 + 8 * fq; const PG8_LAS float* rt = rtab + u.ord * 256 + wr * 64 + fr;
        const float* cbv = cb + (size_t)batch_kind(u.pm) * ncb + u.pn * BM + wc * 32 + 8 * fq;
        const f32x4 ca0 = *(const f32x4*)cbv, ca1 = *(const f32x4*)(cbv + 4), cb0 = *(const f32x4*)(cbv + HALF), cb1 = *(const f32x4*)(cbv + HALF + 4);
#pragma unroll
        for (int ai = 0; ai < 2; ++ai)
#pragma unroll
            for (int m = 0; m < 4; ++m) { const float r = rt[ai * HALF + m * 16];
                const f32x4 a0 = acc[ai][0][m][0] * r + ca0, a1 = acc[ai][0][m][1] * r + ca1, b0 = acc[ai][1][m][0] * r + cb0, b1 = acc[ai][1][m][1] * r + cb1;
                const f32x4 s0 = silu_mul4(a0, b0), s1 = silu_mul4(a1, b1);
                u32x4 w; w.x = cvt_pk_bf16(s0[0], s0[1]); w.y = cvt_pk_bf16(s0[2], s0[3]); w.z = cvt_pk_bf16(s1[0], s1[1]); w.w = cvt_pk_bf16(s1[2], s1[3]);
                *(u32x4*)(H + (size_t)(row0 + ai * HALF + m * 16) * ldh + col0) = w; }
    }
};
#ifndef RESID_GRP
#define RESID_GRP 2
#endif
struct EpiResid {
#ifdef RESID_VIA_LDS
    static constexpr bool PERM = true, AFTER_DRAIN = false, PAIR = false, CAN_SPLIT = true, RESID_LDS = true; static constexpr int SLAB_W = 256;
#else
    static constexpr bool PERM = true, AFTER_DRAIN = false, PAIR = false, CAN_SPLIT = true, RESID_LDS = false; static constexpr int SLAB_W = 256;
#endif
    const bf16_t* xin_b; bf16_t* xout_b; const float* gate_base;
    bool emit; bf16_t* XG; float* SQ; const float* ngain; const float* nscale_base;
    const PG8_LAS unsigned char* ring;
    __device__ __forceinline__ const char* res_base(const Unit& u) const { return (const char*)(xin_b + (size_t)u.pm * BM * 1024 + u.pn * BM); }
    __device__ __forceinline__ static constexpr int rbuf(int g) { return (g == 0 ? 4 : g == 1 ? 5 : g == 2 ? 0 : g == 3 ? 1 : g == 4 ? 6 : g == 5 ? 7 : 2) * HTB; }
    static constexpr bool HAS_POST = false;
    typedef unsigned u32x2 __attribute__((ext_vector_type(2)));
    __device__ __forceinline__ static f32x4 up4(unsigned a, unsigned b) { return (f32x4){__builtin_bit_cast(float, a << 16), __builtin_bit_cast(float, a & 0xffff0000u), __builtin_bit_cast(float, b << 16), __builtin_bit_cast(float, b & 0xffff0000u)}; }
    __device__ __forceinline__ void slab(const Unit& u, int row, int c, const f32x4 v, const f32x4) const {
        const int bk = batch_kind(u.pm); const int col = u.pn * BM + c; const size_t m = (size_t)u.pm * BM + row;
        const u32x2 w = *(const u32x2*)(xin_b + m * 1024 + col);
        const f32x4 xn = up4(w[0], w[1]) + *(const f32x4*)(gate_base + 6144 * bk + col) * v;
        *(u32x2*)(xout_b + m * 1024 + col) = (u32x2){cvt_pk_bf16(xn[0], xn[1]), cvt_pk_bf16(xn[2], xn[3])};
        if (emit) {
            const f32x4 gv = *(const f32x4*)(ngain + col) * (*(const f32x4*)(nscale_base + 6144 * bk + col) + 1.f), xg = xn * gv;
            *(u32x2*)(XG + m * 1024 + col) = (u32x2){cvt_pk_bf16(xg[0], xg[1]), cvt_pk_bf16(xg[2], xg[3])};
            float ss = (xn[0] * xn[0] + xn[1] * xn[1]) + (xn[2] * xn[2] + xn[3] * xn[3]);
            ss = xl::sum64(ss);
            if (c < 16) SQ[m * 16 + u.pn * 4 + (c >> 2)] = (c == 0) ? ss : 0.f;
        }
    }
    __device__ __forceinline__ void operator()(const f32x4 (&acc)[2][2][4][2], const Unit& u, int wr, int wc, int fr_in, int fq_in) const {
        int fr = fr_in, fq = fq_in; asm volatile("" : "+v"(fr), "+v"(fq));
        const int bk = batch_kind(u.pm);
        const int col0 = u.pn * BM + wc * 32 + 8 * fq;
        const bf16_t* xib = xin_b + (size_t)u.pm * BM * 1024 + col0; bf16_t* xob = xout_b + (size_t)u.pm * BM * 1024 + col0;
        const float* gate = gate_base + 6144 * bk + col0;
        f32x4 gv[2][2], nv[2][2];
#pragma unroll
        for (int bj = 0; bj < 2; ++bj)
#pragma unroll
            for (int n = 0; n < 2; ++n) { gv[bj][n] = *(const f32x4*)(gate + bj * HALF + n * 4);
                if (emit) nv[bj][n] = *(const f32x4*)(ngain + col0 + bj * HALF + n * 4) * (*(const f32x4*)(nscale_base + 6144 * bk + col0 + bj * HALF + n * 4) + 1.f); }
        bf16_t* xg = XG + (size_t)u.pm * BM * 1024 + col0; float* sq = SQ + (size_t)u.pm * BM * 16 + u.pn * 4 + wc;
        u32x4 x7[2]; x7[0] = (u32x4){0u, 0u, 0u, 0u}; x7[1] = x7[0];
        if (RESID_LDS && u.rl) {
#pragma unroll
            for (int bj = 0; bj < 2; ++bj) x7[bj] = *(const u32x4*)(xib + (size_t)(HALF + wr * 64 + 48 + fr) * 1024 + bj * HALF); }
#pragma unroll
        for (int q0 = 0; q0 < 8; q0 += RESID_GRP) {
            u32x4 xv[RESID_GRP][2];
#pragma unroll
            for (int q = 0; q < RESID_GRP; ++q) { const int ai = (q0 + q) >> 2, m = (q0 + q) & 3; const size_t ro = (size_t)(ai * HALF + wr * 64 + m * 16 + fr) * 1024;
                if (RESID_LDS && u.rl) {
#pragma unroll
                    for (int bj = 0; bj < 2; ++bj) xv[q][bj] = q0 + q < 7 ? *(const PG8_LAS u32x4*)(ring + rbuf(q0 + q < 7 ? q0 + q : 0) + (wr * 16 + fr) * 512 + (((wc * 4 + fq + bj * 16) ^ fr) * 16)) : x7[bj];
                } else {
#pragma unroll
                    for (int bj = 0; bj < 2; ++bj) xv[q][bj] = *(const u32x4*)(xib + ro + bj * HALF); } }
#pragma unroll
            for (int q = 0; q < RESID_GRP; ++q) { const int ai = (q0 + q) >> 2, m = (q0 + q) & 3; const int rt = ai * HALF + wr * 64 + m * 16 + fr; const size_t ro = (size_t)rt * 1024; float ss = 0.f;
#pragma unroll
                for (int bj = 0; bj < 2; ++bj) { const f32x4 x0 = up4(xv[q][bj][0], xv[q][bj][1]) + gv[bj][0] * acc[ai][bj][m][0], x1 = up4(xv[q][bj][2], xv[q][bj][3]) + gv[bj][1] * acc[ai][bj][m][1];
                    *(u32x4*)(xob + ro + bj * HALF) = (u32x4){cvt_pk_bf16(x0[0], x0[1]), cvt_pk_bf16(x0[2], x0[3]), cvt_pk_bf16(x1[0], x1[1]), cvt_pk_bf16(x1[2], x1[3])};
                    if (emit) { const f32x4 y0 = x0 * nv[bj][0], y1 = x1 * nv[bj][1];
                        *(u32x4*)(xg + ro + bj * HALF) = (u32x4){cvt_pk_bf16(y0[0], y0[1]), cvt_pk_bf16(y0[2], y0[3]), cvt_pk_bf16(y1[0], y1[1]), cvt_pk_bf16(y1[2], y1[3])};
                        ss += ((x0[0] * x0[0] + x0[1] * x0[1]) + (x0[2] * x0[2] + x0[3] * x0[3])) + ((x1[0] * x1[0] + x1[1] * x1[1]) + (x1[2] * x1[2] + x1[3] * x1[3])); } }
                if (emit) { ss += xl::xor16(ss); ss = xl::add_xor32(ss); if (fq == 0) sq[(size_t)rt * 16] = ss; } }
            asm volatile("" ::: "memory");
        }
    }
};
struct RowSched {
    StaticOrder so; int mode; int G, c, R, rem, sp, npairs, skew, lead, a;
    __device__ void init(int mode_, int N, int G_, int c_, int K, int max_sp = 1, int skew_ = 0) {
        mode = mode_; so.init((mode_ == 0 ? 72 : (mode_ == 1 ? 64 : 8)) * BM, N, G_, c_); G = G_; c = c_; npairs = K / (2 * BK); skew = skew_;
        R = (so.nwg + G - 1) / G; rem = so.nwg - (R - 1) * G; sp = rem < G ? G / rem : 1; if (sp > max_sp) sp = max_sp; if (sp > npairs) sp = npairs; if (sp < 2) sp = 1;
        a = R; lead = 0; if (skew > 0) { const int left = so.nwg - a * (G - skew); lead = left > 0 ? (left + skew - 1) / skew : 0; sp = 1; }
#ifdef NO_KSPLIT
        sp = 1;
#endif
    }
    __device__ __forceinline__ bool next(int i, Unit& u) const {
        u.kt0 = 0; u.nkt = 2 * npairs; u.sp = 1; u.sl = 0; u.ul = 0; u.ord = i; u.rl = 0;
        if (skew > 0) {
            long L;
            if (c >= skew) { if (i >= a) return false; L = (long)i * (G - skew) + (c - skew); if (L >= (long)a * (G - skew)) return false; }
            else { if (i >= lead) return false; L = (long)a * (G - skew) + (long)c * lead + i; }
            if (!so.at(L, u)) return false;
        } else if (i < R - 1 || sp == 1) { if (!so.next(i, u)) return false; }
        else { if (i > R - 1 || c >= rem * sp) return false;
            const int sl = c / rem, ul = c - sl * rem; if (!so.at((long)(R - 1) * G + ul, u)) return false;
            const int base = npairs / sp, extra = npairs - base * sp;
            u.sp = sp; u.sl = sl; u.ul = ul; u.kt0 = 2 * (sl * base + (sl < extra ? sl : extra)); u.nkt = 2 * (base + (sl < extra ? 1 : 0)); }
        if (mode == 1) u.pm += u.pm >> 3; else if (mode == 2) u.pm = 9 * u.pm + 8;
        return true; }
    __device__ __forceinline__ void a_ready(const Unit&) const {}
    __device__ __forceinline__ void done(const Unit&) const {}
};
__device__ __forceinline__ void st_sc1(float* p, const f32x4 v) { asm volatile("global_store_dwordx4 %0, %1, off sc1\n\ts_nop 1" :: "v"(p), "v"(v) : "memory"); }
template <class Epi, int SP> __device__ __forceinline__ void split_reduce(const Unit& u, const Epi& E, const float* s0, int tid) {
    const int r0 = (256 * u.sl) / SP, r1 = (256 * (u.sl + 1)) / SP; constexpr int CW = Epi::SLAB_W / 4;
    for (int idx = tid; idx < (r1 - r0) * CW; idx += 512) {
        const int row = r0 + idx / CW, c = (idx % CW) * 4; const float* p = s0 + (size_t)row * 256 + c;
        f32x4 a = (f32x4){0.f, 0.f, 0.f, 0.f}, b = (f32x4){0.f, 0.f, 0.f, 0.f};
#pragma unroll
        for (int s = 0; s < SP; ++s) { a += *(const f32x4*)(p + (size_t)s * 65536); if (Epi::PAIR) b += *(const f32x4*)(p + (size_t)s * 65536 + 128); }
        E.slab(u, row, c, a, b);
    }
}
template <class Epi> __device__ __forceinline__ void split_epilogue(const f32x4 (&acc)[2][2][4][2], const Unit& u, const Epi& E, const Gemm& g, int tid, int wr, int wc, int fr, int fq) {
    float* s0 = g.slab + (size_t)u.ul * u.sp * 65536; float* my = s0 + (size_t)u.sl * 65536;
#pragma unroll
    for (int ai = 0; ai < 2; ++ai)
#pragma unroll
        for (int m = 0; m < 4; ++m) { float* rp = my + (size_t)(ai * HALF + wr * 64 + m * 16 + fr) * 256 + wc * 32;
#pragma unroll
            for (int bj = 0; bj < 2; ++bj)
#pragma unroll
                for (int n = 0; n < 2; ++n) st_sc1(rp + bj * HALF + (Epi::PERM ? 8 * fq + 4 * n : 16 * n + 4 * fq), acc[ai][bj][m][n]); }
    asm volatile("s_waitcnt vmcnt(0)" ::: "memory");
    __syncthreads();
    if (tid == 0) {
        unsigned* cw = g.cnt + 16 * u.ul;
        __hip_atomic_fetch_add(cw, 1u, __ATOMIC_RELAXED, __HIP_MEMORY_SCOPE_AGENT);
        unsigned spin = 0;
        while (__hip_atomic_load(cw, __ATOMIC_RELAXED, __HIP_MEMORY_SCOPE_AGENT) < (unsigned)u.sp) { __builtin_amdgcn_s_sleep(2); if (++spin > (1u << 22)) break; }
        __builtin_amdgcn_fence(__ATOMIC_ACQUIRE, "agent");
        asm volatile("s_waitcnt vmcnt(0)" ::: "memory");
    }
    __syncthreads();
    switch (u.sp) {
        case 2: split_reduce<Epi, 2>(u, E, s0, tid); break; case 3: split_reduce<Epi, 3>(u, E, s0, tid); break; case 4: split_reduce<Epi, 4>(u, E, s0, tid); break; case 5: split_reduce<Epi, 5>(u, E, s0, tid); break;
        case 6: split_reduce<Epi, 6>(u, E, s0, tid); break; case 7: split_reduce<Epi, 7>(u, E, s0, tid); break; default: split_reduce<Epi, 8>(u, E, s0, tid); break; }
}
template <class Epi, class Sched, bool ALIGN_EPI = false, bool SP2 = false>
__device__ __forceinline__ void gemm_phase(PG8_LAS unsigned char* lds, const Gemm g, const Sched& S, const Epi& E, const int tid) {
    const int wid = __builtin_amdgcn_readfirstlane(tid >> 6), lane = tid & 63, wr = wid >> 2, wc = wid & 3, fr = lane & 15, fq = lane >> 4;
    const int K = g.K;
    unsigned voffA[2], voffB[2];
#pragma unroll
    for (int i = 0; i < 2; ++i) { int R, C; stage_rc(tid * 16 + i * 8192, R, C); const int Rb = Epi::PERM ? ((R & ~31) + perm32(R & 31)) : R;
        voffA[i] = (unsigned)(R * K + C) * 2u; voffB[i] = (unsigned)(Rb * K + C) * 2u; }
    unsigned voffR[2]; { const int frl = wid * 2 + (lane >> 5), Lc = (lane & 31) ^ frl; voffR[0] = (unsigned)(frl * 2048 + Lc * 16); voffR[1] = (unsigned)((frl + 64) * 2048 + Lc * 16); }
    static_assert(!Epi::RESID_LDS || SP2, "the residual staging is written for the SP2 loop");
    const size_t kstep = (size_t)(BK * 2);
    const size_t hstep = (size_t)HALF * K * 2;
    const size_t tstep = 2 * hstep;
    const unsigned ldsw = (unsigned)wid * 1024u;
    const int aoff = lds_byte(wr * 64 + fr, fq * 8), boff = lds_byte(wc * 32 + fr, fq * 8);
#define PG8_SA(b, h) (((b) * 2 + (h)) * HTB)
#define PG8_SB(b, h) ((4 + (b) * 2 + (h)) * HTB)
#define PG8_STAGE(bufoff, gbase, voff) do { _Pragma("unroll") for (int _i = 0; _i < 2; ++_i) \
        __builtin_amdgcn_global_load_lds((const unsigned*)((const char*)(gbase) + (voff)[_i]), (PG8_LAS unsigned*)(lds + (bufoff) + ldsw + _i * 8192), 16, 0, 0); } while (0)
#define PG8_LDA(dst, b, h) do { _Pragma("unroll") for (int m = 0; m < 4; ++m) _Pragma("unroll") for (int k = 0; k < 2; ++k) dst[m][k] = *(const PG8_LAS bf16x8*)(lds + PG8_SA(b, h) + aoff + m * 2048 + k * 1024); } while (0)
#define PG8_LDB(dst, b, h) do { _Pragma("unroll") for (int n = 0; n < 2; ++n) _Pragma("unroll") for (int k = 0; k < 2; ++k) dst[n][k] = *(const PG8_LAS bf16x8*)(lds + PG8_SB(b, h) + boff + n * 2048 + k * 1024); } while (0)
#define PG8_MMA(ai, bj, At, Bt) do { __builtin_amdgcn_s_setprio(1); _Pragma("unroll") for (int m = 0; m < 4; ++m) _Pragma("unroll") for (int n = 0; n < 2; ++n) _Pragma("unroll") for (int k = 0; k < 2; ++k) \
        acc[ai][bj][m][n] = __builtin_amdgcn_mfma_f32_16x16x32_bf16(Bt[n][k], At[m][k], acc[ai][bj][m][n], 0, 0, 0); __builtin_amdgcn_s_setprio(0); } while (0)
#define PG8_WAIT_V(n) asm volatile("s_waitcnt vmcnt(" #n ")" ::: "memory")
#define PG8_WAIT_L(n) asm volatile("s_waitcnt lgkmcnt(" #n ")" ::: "memory")
#define PG8_BAR __builtin_amdgcn_s_barrier()
#define PG8_SCHED __builtin_amdgcn_sched_barrier(0)
    Unit cur, nxt; int ui = 0;
    if (!S.next(0, cur)) return;
    f32x4 acc[2][2][4][2];
#pragma unroll
    for (int a = 0; a < 2; ++a)
#pragma unroll
        for (int b = 0; b < 2; ++b)
#pragma unroll
            for (int m = 0; m < 4; ++m)
#pragma unroll
                for (int n = 0; n < 2; ++n) acc[a][b][m][n] = (f32x4){0.f, 0.f, 0.f, 0.f};
    bf16x8 At[4][2], B0[2][2], B1[2][2];
    const char* cA = (const char*)g.A + (size_t)cur.pm * tstep + (size_t)cur.kt0 * kstep; const char* cB = (const char*)g.Bt + (size_t)cur.pn * tstep + (size_t)cur.kt0 * kstep;
    S.a_ready(cur);
    if constexpr (SP2) {
        PG8_STAGE(PG8_SB(0, 0), cB, voffB); PG8_STAGE(PG8_SB(0, 1), cB + hstep, voffB); PG8_STAGE(PG8_SA(0, 0), cA, voffA); PG8_STAGE(PG8_SA(0, 1), cA + hstep, voffA);
        if (wr == 1) PG8_BAR;
        PG8_WAIT_V(2); PG8_BAR;
        PG8_STAGE(PG8_SB(1, 0), cB + kstep, voffB); PG8_STAGE(PG8_SA(1, 0), cA + kstep, voffA); PG8_STAGE(PG8_SB(1, 1), cB + hstep + kstep, voffB);
        PG8_WAIT_V(6); PG8_BAR;
    } else {
        PG8_STAGE(PG8_SB(0, 0), cB, voffB); PG8_STAGE(PG8_SA(0, 0), cA, voffA); PG8_STAGE(PG8_SB(0, 1), cB + hstep, voffB); PG8_STAGE(PG8_SA(0, 1), cA + hstep, voffA);
        if (wr == 1) PG8_BAR;
        PG8_WAIT_V(4); PG8_BAR;
        PG8_STAGE(PG8_SB(1, 0), cB + kstep, voffB); PG8_STAGE(PG8_SA(1, 0), cA + kstep, voffA); PG8_STAGE(PG8_SB(1, 1), cB + hstep + kstep, voffB);
        PG8_WAIT_V(6); PG8_BAR;
    }
    for (;;) {
        const bool has_next = S.next(ui + 1, nxt);
        const char* nA = has_next ? (const char*)g.A + (size_t)nxt.pm * tstep + (size_t)nxt.kt0 * kstep : cA; const char* nB = has_next ? (const char*)g.Bt + (size_t)nxt.pn * tstep + (size_t)nxt.kt0 * kstep : cB;
        const int nt = cur.nkt;
        const bool rlu = Epi::RESID_LDS && !has_next && cur.sp == 1;
        const char* rbase = nullptr; if constexpr (Epi::RESID_LDS) { rbase = E.res_base(cur); }
        for (int t = 0; t < nt; t += 2) {
            const bool last = (t == nt - 2);
            const char* a1 = cA + (size_t)(t + 1) * kstep;
            const char* a2 = last ? nA : cA + (size_t)(t + 2) * kstep; const char* b2 = last ? nB : cB + (size_t)(t + 2) * kstep;
            const char* a3 = a2 + kstep; const char* b3 = b2 + kstep;
            if (last && has_next) S.a_ready(nxt);
            const bool rll = Epi::RESID_LDS && last && rlu;
            const char* p_b00 = rll ? rbase : b2;                         const char* p_b01 = rll ? rbase + (size_t)16 * 2048 : b2 + hstep;
            const char* p_a00 = rll ? rbase + (size_t)32 * 2048 : a2;     const char* p_a01 = rll ? rbase + (size_t)48 * 2048 : a2 + hstep;
            const char* p_b10 = rll ? rbase + (size_t)128 * 2048 : b3;    const char* p_b11 = rll ? rbase + (size_t)144 * 2048 : b3 + hstep;
            const char* p_a10 = rll ? rbase + (size_t)160 * 2048 : a3;
            unsigned vA2[2] = {rll ? voffR[0] : voffA[0], rll ? voffR[1] : voffA[1]}, vB2[2] = {rll ? voffR[0] : voffB[0], rll ? voffR[1] : voffB[1]};
            if constexpr (SP2) {
            PG8_LDB(B0, 0, 0); PG8_LDB(B1, 0, 1); PG8_SCHED; PG8_LDA(At, 0, 0); PG8_STAGE(PG8_SA(1, 1), a1 + hstep, voffA);
            PG8_WAIT_V(8); PG8_WAIT_L(0); PG8_BAR; PG8_MMA(0, 0, At, B0); PG8_MMA(0, 1, At, B1); PG8_BAR; PG8_SCHED;
            PG8_LDA(At, 0, 1); PG8_STAGE(PG8_SB(0, 0), p_b00, vB2); PG8_STAGE(PG8_SB(0, 1), p_b01, vB2); PG8_STAGE(PG8_SA(0, 0), p_a00, vA2);
            PG8_WAIT_V(8); PG8_WAIT_L(0); PG8_BAR; PG8_MMA(1, 0, At, B0); PG8_MMA(1, 1, At, B1); PG8_BAR; PG8_SCHED;
            PG8_LDB(B0, 1, 0); PG8_LDB(B1, 1, 1); PG8_SCHED; PG8_LDA(At, 1, 0); PG8_STAGE(PG8_SA(0, 1), p_a01, vA2);
            PG8_WAIT_V(8); PG8_WAIT_L(0); PG8_BAR; PG8_MMA(0, 0, At, B0); PG8_MMA(0, 1, At, B1); PG8_BAR; PG8_SCHED;
            PG8_LDA(At, 1, 1); PG8_STAGE(PG8_SB(1, 0), p_b10, vB2); PG8_STAGE(PG8_SB(1, 1), p_b11, vB2); PG8_STAGE(PG8_SA(1, 0), p_a10, vA2);
            PG8_WAIT_V(8); PG8_WAIT_L(0); PG8_BAR; PG8_MMA(1, 0, At, B0); PG8_MMA(1, 1, At, B1); PG8_BAR; PG8_SCHED;
            } else {
            PG8_LDB(B0, 0, 0); PG8_SCHED; PG8_LDA(At, 0, 0); PG8_STAGE(PG8_SA(1, 1), a1 + hstep, voffA);
            PG8_WAIT_L(8); PG8_BAR; PG8_WAIT_L(0); PG8_MMA(0, 0, At, B0); PG8_BAR; PG8_SCHED;
            PG8_LDB(B1, 0, 1); PG8_STAGE(PG8_SB(0, 0), b2, voffB);
            PG8_BAR; PG8_WAIT_L(0); PG8_MMA(0, 1, At, B1); PG8_BAR;
            PG8_LDA(At, 0, 1); PG8_STAGE(PG8_SA(0, 0), a2, voffA);
            PG8_BAR; PG8_WAIT_L(0); PG8_MMA(1, 0, At, B0); PG8_BAR; PG8_SCHED;
            PG8_STAGE(PG8_SB(0, 1), b2 + hstep, voffB);
            PG8_WAIT_V(6); PG8_BAR; PG8_MMA(1, 1, At, B1); PG8_BAR;
            PG8_LDB(B0, 1, 0); PG8_SCHED; PG8_LDA(At, 1, 0); PG8_STAGE(PG8_SA(0, 1), a2 + hstep, voffA);
            PG8_WAIT_L(8); PG8_BAR; PG8_WAIT_L(0); PG8_MMA(0, 0, At, B0); PG8_BAR; PG8_SCHED;
            PG8_LDB(B1, 1, 1); PG8_STAGE(PG8_SB(1, 0), b3, voffB);
            PG8_BAR; PG8_WAIT_L(0); PG8_MMA(0, 1, At, B1); PG8_BAR;
            PG8_LDA(At, 1, 1); PG8_STAGE(PG8_SA(1, 0), a3, voffA);
            PG8_BAR; PG8_WAIT_L(0); PG8_MMA(1, 0, At, B0); PG8_BAR; PG8_SCHED;
            PG8_STAGE(PG8_SB(1, 1), b3 + hstep, voffB);
            PG8_WAIT_V(6); PG8_BAR; PG8_MMA(1, 1, At, B1); PG8_BAR;
            }
        }
        if constexpr (ALIGN_EPI) { if (wr == 0) PG8_BAR; }
        if constexpr (Epi::RESID_LDS) { static_assert(!Epi::RESID_LDS || ALIGN_EPI, "both halves must be aligned here"); if (rlu) { PG8_WAIT_V(0); PG8_BAR; } cur.rl = rlu ? 1 : 0; }
        if constexpr (!Epi::AFTER_DRAIN) { if (!Epi::CAN_SPLIT || cur.sp == 1) { E(acc, cur, wr, wc, fr, fq);
            if constexpr (Epi::HAS_POST) { if (E.needs_post(cur)) { asm volatile("s_waitcnt vmcnt(0)" ::: "memory"); PG8_BAR; asm volatile("" ::: "memory"); E.post(cur, wid * 64 + olane()); } }
            S.done(cur); } }
        if (!has_next) break;
#pragma unroll
        for (int a = 0; a < 2; ++a)
#pragma unroll
            for (int b = 0; b < 2; ++b)
#pragma unroll
                for (int m = 0; m < 4; ++m)
#pragma unroll
                    for (int n = 0; n < 2; ++n) acc[a][b][m][n] = (f32x4){0.f, 0.f, 0.f, 0.f};
        cur = nxt; cA = nA; cB = nB; ++ui;
        if constexpr (ALIGN_EPI) { if (wr == 1) PG8_BAR; }
    }
    PG8_WAIT_V(0);
    if constexpr (!ALIGN_EPI) { if (wr == 0) PG8_BAR; }
    PG8_BAR;
    if constexpr (Epi::AFTER_DRAIN) { E.fused(acc, cur, wr, wc, fr, fq, lds, wid, lane); S.done(cur); }
    else if constexpr (Epi::CAN_SPLIT) { if (cur.sp > 1) { split_epilogue<Epi>(acc, cur, E, g, wid * 64 + olane(), wr, wc, fr, fq); S.done(cur); } }
#undef PG8_SA
#undef PG8_SB
#undef PG8_STAGE
#undef PG8_LDA
#undef PG8_LDB
#undef PG8_MMA
#undef PG8_WAIT_V
#undef PG8_WAIT_L
#undef PG8_BAR
#undef PG8_SCHED
}
}
namespace ab {
using bf16=__hip_bfloat16;
using bf16x8=__attribute__((ext_vector_type(8)))short;
using s16x4=__attribute__((ext_vector_type(4)))short;
using f32x16=__attribute__((ext_vector_type(16)))float;
using u32x4=__attribute__((ext_vector_type(4)))unsigned;
constexpr int D=64;
constexpr int NW=8,QBLK=32,QB=QBLK*NW,KVBLK=64;
__device__ __forceinline__ int crow(int r,int hi){return (r&3)+8*(r>>2)+4*hi;}
#define SBAR() __builtin_amdgcn_sched_barrier(0)
constexpr int NSLOT=3, SLOTB=8192;
constexpr int LDS_K=0, LDS_V=NSLOT*SLOTB, LDS_WS=2*NSLOT*SLOTB, LDS_OST=LDS_WS+NW*64*4, LDS_BYTES=LDS_OST+NW*4096;
constexpr float C2=0.125f*1.4426950408889634f;
__device__ __forceinline__ void glds16(const void*gsrc,unsigned lds_dst){unsigned keep;
  asm volatile("s_mov_b32 %0, m0\n\ts_mov_b32 m0, %2\n\ts_nop 0\n\tglobal_load_lds_dwordx4 %1, off\n\ts_mov_b32 m0, %0":"=&s"(keep):"v"(gsrc),"s"(lds_dst):"memory");}
__device__ __forceinline__ float max3f(float a,float b,float c){float r;asm("v_max3_f32 %0, %1, %2, %3":"=v"(r):"v"(a),"v"(b),"v"(c));return r;}
__device__ __forceinline__ float max2f(float a,float b){float r;asm("v_max_f32_e32 %0, %1, %2":"=v"(r):"v"(a),"v"(b));return r;}
__device__ __forceinline__ float fadd_s(float a,float b){float r;asm("v_add_f32_e32 %0, %1, %2":"=v"(r):"v"(a),"v"(b));return r;}
__device__ __forceinline__ float fsub_s(float a,float b){float r;asm("v_sub_f32_e32 %0, %1, %2":"=v"(r):"v"(a),"v"(b));return r;}
typedef float f32x2_t __attribute__((ext_vector_type(2))); typedef __bf16 bf16x2_t __attribute__((ext_vector_type(2)));
__device__ __forceinline__ unsigned cvtpk_s(float lo,float hi){f32x2_t v={lo,hi};bf16x2_t b=__builtin_convertvector(v,bf16x2_t);return __builtin_bit_cast(unsigned,b);}
#define WAIT_BAR(N) asm volatile("s_waitcnt vmcnt(" #N ") lgkmcnt(0)\n\ts_barrier":::"memory")

__device__ __forceinline__ void qkt(f32x16&p0,f32x16&p1,const char*Kslot,const bf16x8*qr,const f32x16&negm,int r32,int hi){
  const char*kb=Kslot+hi*1024+r32*16;
  #pragma unroll
  for(int d0=0;d0<4;++d0){
    const bf16x8 b0=*reinterpret_cast<const bf16x8*>(kb+d0*2048);
    const bf16x8 b1=*reinterpret_cast<const bf16x8*>(kb+d0*2048+512);
    if(d0==0){p0=__builtin_amdgcn_mfma_f32_32x32x16_bf16(b0,qr[0],negm,0,0,0);p1=__builtin_amdgcn_mfma_f32_32x32x16_bf16(b1,qr[0],negm,0,0,0);}
    else{p0=__builtin_amdgcn_mfma_f32_32x32x16_bf16(b0,qr[d0],p0,0,0,0);p1=__builtin_amdgcn_mfma_f32_32x32x16_bf16(b1,qr[d0],p1,0,0,0);}}
}
typedef __attribute__((address_space(3))) const char* lds_cptr;
typedef short v4i16_t __attribute__((ext_vector_type(4)));
__device__ __forceinline__ void kload8(bf16x8*kf,lds_cptr kp){
  kf[0]=*(const __attribute__((address_space(3))) bf16x8*)(kp);      kf[1]=*(const __attribute__((address_space(3))) bf16x8*)(kp+512);
  kf[2]=*(const __attribute__((address_space(3))) bf16x8*)(kp+2048); kf[3]=*(const __attribute__((address_space(3))) bf16x8*)(kp+2560);
  kf[4]=*(const __attribute__((address_space(3))) bf16x8*)(kp+4096); kf[5]=*(const __attribute__((address_space(3))) bf16x8*)(kp+4608);
  kf[6]=*(const __attribute__((address_space(3))) bf16x8*)(kp+6144); kf[7]=*(const __attribute__((address_space(3))) bf16x8*)(kp+6656);
}
__device__ __forceinline__ void kload2(bf16x8*kf,lds_cptr kp,int j){ kf[2*j]=*(const __attribute__((address_space(3))) bf16x8*)(kp+j*2048); kf[2*j+1]=*(const __attribute__((address_space(3))) bf16x8*)(kp+j*2048+512); }
__device__ __forceinline__ s16x4 vtr(lds_cptr p){ return __builtin_bit_cast(s16x4,__builtin_amdgcn_ds_read_tr16_b64_v4i16((__attribute__((address_space(3))) v4i16_t*)p)); }
__device__ __forceinline__ float rowmax(const f32x16&p0,const f32x16&p1){
  float a=max3f(p0[0],p0[1],p1[0]),b=max3f(p0[2],p0[3],p1[1]);a=max3f(a,p1[2],p1[3]);
  #pragma unroll
  for(int r=4;r<16;r+=4){a=max3f(a,p0[r],p0[r+1]);b=max3f(b,p0[r+2],p0[r+3]);a=max3f(a,p1[r],p1[r+1]);b=max3f(b,p1[r+2],p1[r+3]);}
  const float m=max2f(a,b);
  auto rr=__builtin_amdgcn_permlane32_swap(__float_as_uint(m),__float_as_uint(m),false,false);
  return max2f(__uint_as_float(rr[0]),__uint_as_float(rr[1]));
}
__device__ __forceinline__ void pv(f32x16*o,int vb,bf16x8 pa0,bf16x8 pa1,bf16x8 pa2,bf16x8 pa3){
  #pragma unroll
  for(int d0=0;d0<2;++d0){s16x4 lo[4],hi[4];
    #pragma unroll
    for(int ks=0;ks<4;++ks){
      asm volatile("ds_read_b64_tr_b16 %0,%1 offset:%c2":"=&v"(lo[ks]):"v"(vb),"i"(d0*4096+ks*1024):"memory");
      asm volatile("ds_read_b64_tr_b16 %0,%1 offset:%c2":"=&v"(hi[ks]):"v"(vb),"i"(d0*4096+ks*1024+512):"memory");}
    asm volatile("s_waitcnt lgkmcnt(0)":::"memory");SBAR();
    #define PK(k) (bf16x8){lo[k][0],lo[k][1],lo[k][2],lo[k][3],hi[k][0],hi[k][1],hi[k][2],hi[k][3]}
    o[d0]=__builtin_amdgcn_mfma_f32_32x32x16_bf16(pa0,PK(0),o[d0],0,0,0);
    o[d0]=__builtin_amdgcn_mfma_f32_32x32x16_bf16(pa1,PK(1),o[d0],0,0,0);
    o[d0]=__builtin_amdgcn_mfma_f32_32x32x16_bf16(pa2,PK(2),o[d0],0,0,0);
    o[d0]=__builtin_amdgcn_mfma_f32_32x32x16_bf16(pa3,PK(3),o[d0],0,0,0);
    #undef PK
  }
}

#ifndef ATTN_STORE16
#define ATTN_STORE16(p,v) (*(u32x4*)(p)=(v))
#endif
struct AUnit { const bf16* Q; const bf16* K; const bf16* V; bf16* O; int r1, r2, NT, q0; float sink2; const float* qgain; const float2* tab; const float* sinkv; };
template<int LD,int MODE,int THRL,bool HW> __device__ __forceinline__ void attn_unit(const AUnit& U,char*shm,const int tid){
  const int lane=tid&63,r32=lane&31,hi=lane>>5; const int wid=__builtin_amdgcn_readfirstlane(tid>>6);
  constexpr int n1=4; const int r1=U.r1,r2=U.r2;
  #define TROW(t) (MODE==0?r1+64*(t):((t)<n1?r1+64*(t):r2+64*((t)-n1)))
  const bf16*Qw=HW?U.Q+wid*64:U.Q+(long)(wid*QBLK)*LD; const int qrow0=HW?U.q0:U.q0+wid*QBLK;
  const bf16*Kh=U.K,*Vh=U.V;
  const unsigned lds0=(unsigned)(uintptr_t)shm;
  float*wsf=(float*)(shm+LDS_WS)+wid*64;
  const bf16*ksrc=Kh+(long)lane*LD+wid*8;
  const bf16*vsrc=Vh+(long)(16*(wid&3)+(lane>>2))*LD+(wid>>2)*32+(lane&3)*8;
  const unsigned kdst=lds0+LDS_K+wid*1024, vdst=lds0+LDS_V+wid*1024;
  #define DMA_K(t,slot) glds16(ksrc+(long)TROW(t)*LD,(unsigned)__builtin_amdgcn_readfirstlane(kdst+(slot)))
  #define DMA_V(t,slot) glds16(vsrc+(long)TROW(t)*LD,(unsigned)__builtin_amdgcn_readfirstlane(vdst+(slot)))
  const int vb0=(int)(lds0+LDS_V)+((lane>>4)&1)*32+(lane&3)*8+(4*hi+((lane&15)>>2))*64;
  const char*Kbase=shm+LDS_K; bf16x8 kf[8];
  const lds_cptr shm3=(lds_cptr)shm; const lds_cptr kp0=shm3+LDS_K+hi*1024+r32*16; const lds_cptr vp0=shm3+LDS_V+((lane>>4)&1)*32+(lane&3)*8+(4*hi+((lane&15)>>2))*64;
  const int NT=U.NT;
  DMA_K(0,0);DMA_V(0,0);DMA_K(1,SLOTB);
  float4 gq[8],tv[8];
  #pragma unroll
  for(int j=0;j<8;++j){gq[j]=make_float4(0.f,0.f,0.f,0.f);tv[j]=make_float4(0.f,0.f,0.f,0.f);}
  if(U.qgain){ _Pragma("unroll") for(int d0=0;d0<4;++d0){ gq[2*d0]=*(const float4*)(U.qgain+16*d0+8*hi); gq[2*d0+1]=*(const float4*)(U.qgain+16*d0+8*hi+4); } }
  if(U.tab){ const int t=qrow0+r32; const float4*tr=(const float4*)(U.tab+(t>>6)*16+8*hi),*tc=(const float4*)(U.tab+(t&63)*16+8*hi);
    _Pragma("unroll") for(int j=0;j<4;++j){ tv[j]=tr[j]; tv[4+j]=tc[j]; } }
  bf16x8 qr[4];
  #pragma unroll
  for(int d0=0;d0<4;++d0)qr[d0]=*reinterpret_cast<const bf16x8*>(&Qw[(long)r32*LD+d0*16+hi*8]);
  {
    float x[4][8];
    #pragma unroll
    for(int d0=0;d0<4;++d0){ _Pragma("unroll") for(int j=0;j<8;++j) x[d0][j]=__builtin_bit_cast(float,(unsigned)(unsigned short)qr[d0][j]<<16); }
    if(U.qgain){ float ss=0.f;
      #pragma unroll
      for(int d0=0;d0<4;++d0){ _Pragma("unroll") for(int j=0;j<8;++j) ss+=x[d0][j]*x[d0][j]; }
      ss=xl::add_xor32(ss); const float rs=__builtin_amdgcn_rsqf(ss*(1.f/64.f)+1e-6f);
      #pragma unroll
      for(int d0=0;d0<4;++d0){ const float4 g0=gq[2*d0], g1=gq[2*d0+1];
        x[d0][0]*=rs*g0.x;x[d0][1]*=rs*g0.y;x[d0][2]*=rs*g0.z;x[d0][3]*=rs*g0.w;x[d0][4]*=rs*g1.x;x[d0][5]*=rs*g1.y;x[d0][6]*=rs*g1.z;x[d0][7]*=rs*g1.w; } }
    if(U.tab){
      #pragma unroll
      for(int j=0;j<8;++j){ const float4 r4=tv[j>>1],c4=tv[4+(j>>1)]; const float crx=(j&1)?r4.z:r4.x,cry=(j&1)?r4.w:r4.y,ccx=(j&1)?c4.z:c4.x,ccy=(j&1)?c4.w:c4.y;
        const float a0=x[0][j],a1=x[1][j],a2=x[2][j],a3=x[3][j];
        x[0][j]=a0*crx-a1*cry; x[1][j]=a1*crx+a0*cry; x[2][j]=a2*ccx-a3*ccy; x[3][j]=a3*ccx+a2*ccy; } }
    #pragma unroll
    for(int d0=0;d0<4;++d0){ u32x4 w; _Pragma("unroll") for(int j=0;j<4;++j) w[j]=cvtpk_s(x[d0][2*j]*C2,x[d0][2*j+1]*C2); qr[d0]=__builtin_bit_cast(bf16x8,w); }
  }
  float mhat=0.f,l_reg=0.f;f32x16 o[2];o[0]=f32x16{};o[1]=f32x16{};f32x16 negm=f32x16{};asm volatile("":"+v"(negm));
  const int qpos=qrow0+r32;
  #define CMASK(P0,P1,t) do{ if(MODE==1){ if((t)>=n1){ const int tlo_=TROW(t), qw_=qrow0; \
      if(!(tlo_-qw_-31>=-128 && tlo_+63-qw_<=128)){ const int db_=tlo_-qpos+4*hi+128; \
        _Pragma("unroll") for(int r=0;r<16;++r){ const int c_=(r&3)+8*(r>>2); if((unsigned)(db_+c_)>256u)P0[r]=-INFINITY; if((unsigned)(db_+c_+32)>256u)P1[r]=-INFINITY; } } } } }while(0)
  bool resc=false;
  #define START(P0,P1) do{ const float rm=rowmax(P0,P1); resc=false; \
    { const float dl=rm; mhat=fadd_s(mhat,dl); \
      _Pragma("unroll") for(int r=0;r<16;++r){P0[r]=fsub_s(P0[r],dl);P1[r]=fsub_s(P1[r],dl);} \
      _Pragma("unroll") for(int r=0;r<16;++r)negm[r]=-mhat; asm volatile("":"+v"(negm)); } \
    _Pragma("unroll") for(int r=0;r<16;++r)P0[r]=__builtin_amdgcn_exp2f(P0[r]); }while(0)
  #define RESC() do{ if(resc){ asm volatile("s_waitcnt lgkmcnt(0)":::"memory"); \
      _Pragma("unroll") for(int d_=0;d_<2;++d_) _Pragma("unroll") for(int r=0;r<16;++r)o[d_][r]*=wsf[crow(r,hi)]; } }while(0)
  f32x16 pA0,pA1,pB0,pB1;
  int sl_prev=0,sl_cur=0,sl_next=SLOTB;
  #define ROT() do{sl_prev=sl_cur;sl_cur=sl_next;sl_next=(sl_next==(NSLOT-1)*SLOTB)?0:sl_next+SLOTB;}while(0)
  DMA_K(2,2*SLOTB);
  WAIT_BAR(3);
  qkt(pA0,pA1,Kbase,qr,negm,r32,hi);asm volatile("s_nop 15\n\ts_nop 7":"+v"(pA0),"+v"(pA1));CMASK(pA0,pA1,0);
  START(pA0,pA1);
  _Pragma("unroll") for(int r=0;r<16;++r)pA1[r]=__builtin_amdgcn_exp2f(pA1[r]);
  WAIT_BAR(0);
  DMA_K(3,0);DMA_V(1,SLOTB);
  ROT();
  kload8(kf,kp0+sl_cur);
  WAIT_BAR(2);
  s16x4 vlo[8],vhi[8]; u32x4 pw0,pw1,pw2,pw3;
  #define PKW(P,B) cvtpk_s(P[B],P[B+1])
  #define PAF(k) __builtin_bit_cast(bf16x8,pw##k)
  #define VFR(i) (bf16x8){vlo[i][0],vlo[i][1],vlo[i][2],vlo[i][3],vhi[i][0],vhi[i][1],vhi[i][2],vhi[i][3]}
  #define PIN(x) asm volatile("":"+v"(x))
  #define MX3(a,b,c) __builtin_fmaxf(__builtin_fmaxf((a),(b)),(c))
  #define GAPA(MF,A0,A1,A2,A3,W0,W1,PW) do{ MF; sacc+=A0; sacc+=A1; sacc+=A2; sacc+=A3; PIN(sacc); W0; W1; PIN(PW); SBAR(); }while(0)
  #define EX(v) __builtin_amdgcn_exp2f(v)
  #define GAPB(MF,X,B) do{ MF; X[B]=EX(X[B]); X[B+1]=EX(X[B+1]); X[B+2]=EX(X[B+2]); X[B+3]=EX(X[B+3]); PIN(X); SBAR(); }while(0)
  #define VRD(i) do{ vlo[i]=vtr(vp_+(((i)>>2)*4096+((i)&3)*1024)); vhi[i]=vtr(vp_+(((i)>>2)*4096+((i)&3)*1024+512)); }while(0)
  #define KRD(G,j) do{ if(G){ kload2(kf,kp0+sl_next,j); SBAR(); } }while(0)
  #define STEP(C0,C1,P0,P1,t,GK,GV,GL) do{ SBAR(); \
    const lds_cptr vp_=vp0+sl_prev; \
    VRD(0); SBAR(); float sacc=(P0[0]+P0[1]); \
    GAPA(C0=__builtin_amdgcn_mfma_f32_32x32x16_bf16(kf[0],qr[0],negm,0,0,0), P0[2],P0[3],P0[4],P0[5],     pw0[0]=PKW(P0,0), pw0[1]=PKW(P0,2), pw0); \
    VRD(4); SBAR(); GAPA(C1=__builtin_amdgcn_mfma_f32_32x32x16_bf16(kf[1],qr[0],negm,0,0,0), P0[6],P0[7],P0[8],P0[9],     pw0[2]=PKW(P0,4), pw0[3]=PKW(P0,6), pw0); \
    VRD(1); SBAR(); GAPA(C0=__builtin_amdgcn_mfma_f32_32x32x16_bf16(kf[2],qr[1],C0,0,0,0),   P0[10],P0[11],P0[12],P0[13], pw1[0]=PKW(P0,8), pw1[1]=PKW(P0,10), pw1); \
    VRD(5); SBAR(); GAPA(C1=__builtin_amdgcn_mfma_f32_32x32x16_bf16(kf[3],qr[1],C1,0,0,0),   P0[14],P0[15],P1[0],P1[1],   pw1[2]=PKW(P0,12),pw1[3]=PKW(P0,14), pw1); \
    VRD(2); SBAR(); GAPA(C0=__builtin_amdgcn_mfma_f32_32x32x16_bf16(kf[4],qr[2],C0,0,0,0),   P1[2],P1[3],P1[4],P1[5],     pw2[0]=PKW(P1,0), pw2[1]=PKW(P1,2), pw2); \
    VRD(6); SBAR(); GAPA(C1=__builtin_amdgcn_mfma_f32_32x32x16_bf16(kf[5],qr[2],C1,0,0,0),   P1[6],P1[7],P1[8],P1[9],     pw2[2]=PKW(P1,4), pw2[3]=PKW(P1,6), pw2); \
    VRD(3); SBAR(); GAPA(C0=__builtin_amdgcn_mfma_f32_32x32x16_bf16(kf[6],qr[3],C0,0,0,0),   P1[10],P1[11],P1[12],P1[13], pw3[0]=PKW(P1,8), pw3[1]=PKW(P1,10), pw3); \
    VRD(7); SBAR(); GAPA(C1=__builtin_amdgcn_mfma_f32_32x32x16_bf16(kf[7],qr[3],C1,0,0,0),   P1[14],P1[15],0.f,0.f,       pw3[2]=PKW(P1,12),pw3[3]=PKW(P1,14), pw3); \
    l_reg+=sacc; \
    if(GK){DMA_K((t)+3,sl_cur);} if(GV){DMA_V((t)+1,sl_next);} \
    CMASK(C0,C1,t); \
    { float a=MX3(C0[0],C0[1],C1[0]),b=MX3(C0[2],C0[3],C1[1]); a=MX3(a,C1[2],C1[3]); \
      _Pragma("unroll") for(int r=4;r<16;r+=4){a=MX3(a,C0[r],C0[r+1]);b=MX3(b,C0[r+2],C0[r+3]);a=MX3(a,C1[r],C1[r+1]);b=MX3(b,C1[r+2],C1[r+3]);} \
      float rm=__builtin_fmaxf(a,b); { auto rr=__builtin_amdgcn_permlane32_swap(__float_as_uint(rm),__float_as_uint(rm),false,false); rm=__builtin_fmaxf(__uint_as_float(rr[0]),__uint_as_float(rr[1])); } \
      resc=false; \
      if(__builtin_expect(__any(rm>(float)THRL),0)){ const float dl=__builtin_fmaxf(rm,0.f); mhat+=dl; \
        _Pragma("unroll") for(int r=0;r<16;++r){C0[r]-=dl;C1[r]-=dl;} \
        _Pragma("unroll") for(int r=0;r<16;++r)negm[r]=-mhat; asm volatile("":"+v"(negm)); \
        const float f=__builtin_amdgcn_exp2f(-dl); l_reg*=f; if(hi==0)wsf[r32]=f; resc=true; } } \
    SBAR(); \
    GAPB(o[0]=__builtin_amdgcn_mfma_f32_32x32x16_bf16(PAF(0),VFR(0),o[0],0,0,0), C0,0); \
    GAPB(o[1]=__builtin_amdgcn_mfma_f32_32x32x16_bf16(PAF(0),VFR(4),o[1],0,0,0), C0,4); \
    KRD(GL,0); GAPB(o[0]=__builtin_amdgcn_mfma_f32_32x32x16_bf16(PAF(1),VFR(1),o[0],0,0,0), C0,8); \
    KRD(GL,1); GAPB(o[1]=__builtin_amdgcn_mfma_f32_32x32x16_bf16(PAF(1),VFR(5),o[1],0,0,0), C0,12); \
    KRD(GL,2); GAPB(o[0]=__builtin_amdgcn_mfma_f32_32x32x16_bf16(PAF(2),VFR(2),o[0],0,0,0), C1,0); \
    KRD(GL,3); GAPB(o[1]=__builtin_amdgcn_mfma_f32_32x32x16_bf16(PAF(2),VFR(6),o[1],0,0,0), C1,4); \
    GAPB(o[0]=__builtin_amdgcn_mfma_f32_32x32x16_bf16(PAF(3),VFR(3),o[0],0,0,0), C1,8); \
    GAPB(o[1]=__builtin_amdgcn_mfma_f32_32x32x16_bf16(PAF(3),VFR(7),o[1],0,0,0), C1,12); \
    }while(0)
  int t=1;
  for(;t+5<NT;t+=2){
    STEP(pB0,pB1,pA0,pA1,t,true,true,true);     WAIT_BAR(2); RESC(); ROT();
    STEP(pA0,pA1,pB0,pB1,t+1,true,true,true);   WAIT_BAR(2); RESC(); ROT();
  }
  #define ENDW(tt) do{ if((tt)+3<NT){WAIT_BAR(2);} else if((tt)+2<NT){WAIT_BAR(1);} else {WAIT_BAR(0);} }while(0)
  for(;t+1<NT;t+=2){
    STEP(pB0,pB1,pA0,pA1,t,(t+3<NT),(t+1<NT),(t+1<NT));       ENDW(t);   RESC(); ROT();
    STEP(pA0,pA1,pB0,pB1,t+1,(t+4<NT),(t+2<NT),(t+2<NT));     ENDW(t+1); RESC(); ROT();
  }
  #define DRAIN(P0,P1,SL) do{ float sacc=P0[0]+P0[1]; _Pragma("unroll") for(int r=2;r<16;++r)sacc+=P0[r]; _Pragma("unroll") for(int r=0;r<16;++r)sacc+=P1[r]; l_reg+=sacc; \
    pw0=(u32x4){PKW(P0,0),PKW(P0,2),PKW(P0,4),PKW(P0,6)};pw1=(u32x4){PKW(P0,8),PKW(P0,10),PKW(P0,12),PKW(P0,14)};pw2=(u32x4){PKW(P1,0),PKW(P1,2),PKW(P1,4),PKW(P1,6)};pw3=(u32x4){PKW(P1,8),PKW(P1,10),PKW(P1,12),PKW(P1,14)}; \
    SBAR(); pv(o,vb0+(SL),PAF(0),PAF(1),PAF(2),PAF(3)); }while(0)
  if(t<NT){ STEP(pB0,pB1,pA0,pA1,NT-1,false,false,false); RESC(); DRAIN(pB0,pB1,sl_cur); }
  else { DRAIN(pA0,pA1,sl_prev); }
  #undef DRAIN
  #undef PKW
  #undef PAF
  #undef VFR
  #undef PIN
  #undef MX3
  #undef GAPA
  #undef GAPB
  #undef EX
  #undef VRD
  #undef KRD
  #undef STEP
  #undef ENDW
  if(hi==0)l_reg+=__builtin_amdgcn_exp2f((HW?U.sinkv[wid]*1.4426950408889634f:U.sink2)-mhat);
  {auto rr=__builtin_amdgcn_permlane32_swap(__float_as_uint(l_reg),__float_as_uint(l_reg),false,false);l_reg=__uint_as_float(rr[0])+__uint_as_float(rr[1]);}
  if(hi==0)wsf[32+r32]=l_reg;asm volatile("s_waitcnt lgkmcnt(0)":::"memory");
  float rli[16];
  #pragma unroll
  for(int r=0;r<16;++r)rli[r]=__builtin_amdgcn_rcpf(wsf[32+crow(r,hi)]);
  bf16*Ow=HW?U.O+wid*64:U.O+(long)(wid*QBLK)*1024;
  { bf16*stg=(bf16*)(shm+LDS_OST)+wid*2048;
    #pragma unroll
    for(int r=0;r<16;++r){const int orow=crow(r,hi);
      #pragma unroll
      for(int d0=0;d0<2;++d0)stg[orow*64+d0*32+r32]=__float2bfloat16(o[d0][r]*rli[r]);}
    asm volatile("s_waitcnt lgkmcnt(0)":::"memory");
    #pragma unroll
    for(int i=0;i<4;++i){const int row=i*8+(lane>>3),ch=lane&7; const u32x4 v=*(const u32x4*)(stg+row*64+ch*8); ATTN_STORE16(Ow+(long)row*1024+ch*8,v);} }
  asm volatile("s_waitcnt lgkmcnt(0)\n\ts_barrier":::"memory");
  #undef TROW
  #undef DMA_K
  #undef DMA_V
  #undef CMASK
  #undef START
  #undef RESC
  #undef ROT
}
constexpr int ATTN_LDS_BYTES=LDS_BYTES;
#undef SBAR
#undef WAIT_BAR
}
namespace gla {
using bf16 = unsigned short;
using bf16x8 = __attribute__((ext_vector_type(8))) short;
using s16x4 = __attribute__((ext_vector_type(4))) short;
using f32x16 = __attribute__((ext_vector_type(16))) float;
using f32x4 = __attribute__((ext_vector_type(4))) float;
using u32x4 = __attribute__((ext_vector_type(4))) unsigned;
using u32x2 = __attribute__((ext_vector_type(2))) unsigned;
typedef short v4i16_t __attribute__((ext_vector_type(4)));
#define GLAS __attribute__((address_space(3)))
constexpr int LD = cfg::LDE, M = cfg::M;
constexpr float QS = 0.17677669529663687f;
constexpr int KT_STRIDE = 80, KH_STRIDE = 144;
constexpr int WAVE_LDS = 18432;
__device__ __forceinline__ float ex(float x) { return __builtin_amdgcn_exp2f(x * 1.4426950408889634f); }
__device__ __forceinline__ float bf2f(unsigned short v) { return __builtin_bit_cast(float, (unsigned)v << 16); }
__device__ __forceinline__ unsigned short f2bf(float f) { unsigned u = __builtin_bit_cast(unsigned, f); return (unsigned short)((u + 0x7fffu + ((u >> 16) & 1u)) >> 16); }
__device__ __forceinline__ unsigned pk2(float lo, float hi) { return (unsigned)f2bf(lo) | ((unsigned)f2bf(hi) << 16); }
__device__ __forceinline__ int crow(int r, int hi) { return (r & 3) + 8 * (r >> 2) + 4 * hi; }
__device__ __forceinline__ s16x4 vtr(const GLAS char* p) { return __builtin_bit_cast(s16x4, __builtin_amdgcn_ds_read_tr16_b64_v4i16((GLAS v4i16_t*)p)); }
#define GLA_MFMA(a, b, c) __builtin_amdgcn_mfma_f32_32x32x16_bf16(a, b, c, 0, 0, 0)
#define GLA_LDSWAIT() asm volatile("s_waitcnt lgkmcnt(0)" ::: "memory")

struct Ctx {
    const bf16* P;
    float* DEC;
    const float* LR; const float* gkw; const float* gkb;
    size_t mbase;
    int h, bh;
    bf16* US; bf16* SB; float* DD;
    bf16* MIX; const float* gg;
};

template <int CTRL, int ROWMASK> __device__ __forceinline__ float dpp_add(float v) {
    return v + __builtin_bit_cast(float, __builtin_amdgcn_update_dpp(0, __builtin_bit_cast(int, v), CTRL, ROWMASK, 0xf, false)); }
__device__ __forceinline__ float scan64(float v) {
    v = dpp_add<0x111, 0xf>(v); v = dpp_add<0x112, 0xf>(v); v = dpp_add<0x114, 0xf>(v); v = dpp_add<0x118, 0xf>(v);
    v = dpp_add<0x142, 0xa>(v); v = dpp_add<0x143, 0xc>(v); return v; }
__device__ __forceinline__ float sum32(float v) {
    v = dpp_add<0xB1, 0xf>(v); v = dpp_add<0x4E, 0xf>(v); v = dpp_add<0x141, 0xf>(v); v = dpp_add<0x140, 0xf>(v); return v + xl::xor16(v); }
__device__ __forceinline__ void load_g(const float* gp, float (&g)[32]) {
#pragma unroll
    for (int j = 0; j < 8; ++j) { const f32x4 v = *(const f32x4*)(gp + 4 * j); g[4 * j] = v[0]; g[4 * j + 1] = v[1]; g[4 * j + 2] = v[2]; g[4 * j + 3] = v[3]; } }
__device__ __forceinline__ void load_row32(const bf16* p, float (&x)[32]) {
#pragma unroll
    for (int j = 0; j < 4; ++j) { const u32x4 w = *(const u32x4*)(p + 8 * j);
#pragma unroll
        for (int q = 0; q < 4; ++q) { x[8 * j + 2 * q] = __builtin_bit_cast(float, w[q] << 16); x[8 * j + 2 * q + 1] = __builtin_bit_cast(float, w[q] & 0xffff0000u); } } }
__device__ __forceinline__ void load_vtile(const bf16* vp  , GLAS char* vt, int lane) {
#pragma unroll
    for (int p = 0; p < 8; ++p) {
        const u32x4 v = *(const u32x4*)(vp + (size_t)(16 * (p & 3) + (lane >> 2)) * LD + (p >> 2) * 32 + (lane & 3) * 8);
        *(GLAS u32x4*)(vt + p * 1024 + lane * 16) = v;
    }
}
template <int DIR> __device__ __forceinline__ void stage_a(const Ctx& X, int c, GLAS char* wl, int lane_in) {
    int lane = lane_in; asm volatile("" : "+v"(lane));
    const int r32 = lane & 31, hi = lane >> 5;
    GLAS char* khT = wl; GLAS char* vt = wl + 32 * KH_STRIDE;
    const size_t row = X.mbase + 64 * c + lane;
    float g[32], kk[32];
    load_row32(X.P + (size_t)(64 * c + lane) * LD + cfg::E_GK + X.h * 32, kk);
    {
        GLAS float* wsl = (GLAS float*)(wl + 32 * KH_STRIDE + 8192);
        { const int r = lane >> 2, q = (lane & 3) * 8; const float* src = X.gkw + (size_t)(DIR * 16 + r) * 256 + X.h * 32 + q;
          *(GLAS f32x4*)(wsl + r * 32 + q) = *(const f32x4*)src; *(GLAS f32x4*)(wsl + r * 32 + q + 4) = *(const f32x4*)(src + 4);
          if (lane < 8) *(GLAS f32x4*)(wsl + 512 + lane * 4) = *(const f32x4*)(X.gkb + DIR * 256 + X.h * 32 + lane * 4); }
        float lr[16];
#pragma unroll
        for (int j = 0; j < 4; ++j) { const f32x4 v = *(const f32x4*)(X.LR + row * 32 + DIR * 16 + 4 * j); lr[4 * j] = v[0]; lr[4 * j + 1] = v[1]; lr[4 * j + 2] = v[2]; lr[4 * j + 3] = v[3]; }
        GLA_LDSWAIT();
#pragma unroll
        for (int k4 = 0; k4 < 8; ++k4) {
            f32x4 x = *(const GLAS f32x4*)(wsl + 512 + 4 * k4);
#pragma unroll
            for (int r = 0; r < 16; ++r) x += lr[r] * *(const GLAS f32x4*)(wsl + r * 32 + 4 * k4);
#pragma unroll
            for (int q = 0; q < 4; ++q) g[4 * k4 + q] = (fminf(x[q], 0.f) - __logf(1.f + __expf(-fabsf(x[q])))) * (1.f / 16.f);
            *(f32x4*)(X.DEC + ((size_t)DIR * M + row) * 256 + X.h * 32 + 4 * k4) = (f32x4){g[4 * k4], g[4 * k4 + 1], g[4 * k4 + 2], g[4 * k4 + 3]};
        }
    }
    load_vtile(X.P + (size_t)(64 * c) * LD + cfg::E_GV + X.h * 64, vt, lane);
    const size_t slot = ((size_t)(X.bh * 2 + DIR) * 36 + c);
    float dd[32];
#pragma unroll
    for (int i = 0; i < 32; ++i) {
        const float b = scan64(g[i]);
        const float T = __builtin_bit_cast(float, __builtin_amdgcn_readlane(__builtin_bit_cast(int, b), 63));
        const float w = ex(DIR == 0 ? T - b : b - g[i]);
        dd[i] = ex(T);
        *(GLAS unsigned short*)(khT + i * KH_STRIDE + lane * 2) = f2bf(kk[i] * w);
    }
    if (lane == 0) {
#pragma unroll
        for (int j = 0; j < 8; ++j) *(f32x4*)(X.DD + slot * 32 + 4 * j) = (f32x4){dd[4 * j], dd[4 * j + 1], dd[4 * j + 2], dd[4 * j + 3]};
    }
    GLA_LDSWAIT();
    f32x16 u0 = f32x16{}, u1 = f32x16{};
    const GLAS char* vb = vt + ((lane >> 4) & 1) * 32 + (lane & 3) * 8 + (8 * hi + ((lane & 15) >> 2)) * 64;
#pragma unroll
    for (int s = 0; s < 4; ++s) {
        const bf16x8 a = *(const GLAS bf16x8*)(khT + r32 * KH_STRIDE + (16 * s + 8 * hi) * 2);
        const s16x4 l0 = vtr(vb + s * 1024), h0 = vtr(vb + s * 1024 + 256), l1 = vtr(vb + 4096 + s * 1024), h1 = vtr(vb + 4096 + s * 1024 + 256);
        u0 = GLA_MFMA(a, ((bf16x8){l0[0], l0[1], l0[2], l0[3], h0[0], h0[1], h0[2], h0[3]}), u0);
        u1 = GLA_MFMA(a, ((bf16x8){l1[0], l1[1], l1[2], l1[3], h1[0], h1[1], h1[2], h1[3]}), u1);
    }
    bf16* up = X.US + slot * 2048;
#pragma unroll
    for (int g4 = 0; g4 < 4; ++g4) {
        *(u32x2*)(up + (r32) * 32 + 8 * g4 + 4 * hi) = (u32x2){pk2(u0[4 * g4], u0[4 * g4 + 1]), pk2(u0[4 * g4 + 2], u0[4 * g4 + 3])};
        *(u32x2*)(up + (r32 + 32) * 32 + 8 * g4 + 4 * hi) = (u32x2){pk2(u1[4 * g4], u1[4 * g4 + 1]), pk2(u1[4 * g4 + 2], u1[4 * g4 + 3])};
    }
    GLA_LDSWAIT();
}
constexpr int C_KT = 0, C_QT = 64 * KT_STRIDE, C_VT = 128 * KT_STRIDE, C_WAVE = C_VT + 8192;
__device__ __forceinline__ void unpack_row32(const u32x4 (&w4)[4], float (&x)[32]) {
#pragma unroll
    for (int j = 0; j < 4; ++j)
#pragma unroll
        for (int q = 0; q < 4; ++q) { x[8 * j + 2 * q] = __builtin_bit_cast(float, w4[j][q] << 16); x[8 * j + 2 * q + 1] = __builtin_bit_cast(float, w4[j][q] & 0xffff0000u); } }
template <int DIR, bool PF> __device__ __forceinline__ void stage_c_dir(const Ctx& X, int c, GLAS char* wl, int lane_in, f32x16 (&o)[2][2], float (&g)[32], const u32x4 (&kraw)[4], const u32x4 (&qraw)[4], const float* gnp, float (&gn)[32]) {
    int lane = lane_in; asm volatile("" : "+v"(lane));
    const int r32 = lane & 31, hi = lane >> 5;
    GLAS char* kt = wl + C_KT; GLAS char* qt = wl + C_QT; GLAS char* vt = wl + C_VT;
    {
        float x[32];
        unpack_row32(kraw, x);
#pragma unroll
        for (int i = 0; i < 32; ++i) {
            float b = scan64(g[i]);
            if (DIR == 1) { const float T = __builtin_bit_cast(float, __builtin_amdgcn_readlane(__builtin_bit_cast(int, b), 63)); b = T - b + g[i]; }
            const float e = ex(b);
            x[i] *= __builtin_amdgcn_rcpf(e);
            g[i] = e * QS;
        }
#pragma unroll
        for (int j = 0; j < 4; ++j) *(GLAS u32x4*)(kt + lane * KT_STRIDE + 16 * j) = (u32x4){pk2(x[8 * j], x[8 * j + 1]), pk2(x[8 * j + 2], x[8 * j + 3]), pk2(x[8 * j + 4], x[8 * j + 5]), pk2(x[8 * j + 6], x[8 * j + 7])};
        unpack_row32(qraw, x);
#pragma unroll
        for (int j = 0; j < 4; ++j) *(GLAS u32x4*)(qt + lane * KT_STRIDE + 16 * j) = (u32x4){pk2(x[8 * j] * g[8 * j], x[8 * j + 1] * g[8 * j + 1]), pk2(x[8 * j + 2] * g[8 * j + 2], x[8 * j + 3] * g[8 * j + 3]),
                                                                                           pk2(x[8 * j + 4] * g[8 * j + 4], x[8 * j + 5] * g[8 * j + 5]), pk2(x[8 * j + 6] * g[8 * j + 6], x[8 * j + 7] * g[8 * j + 7])};
    }
    if (PF) load_g(gnp, gn);
    GLA_LDSWAIT();
    const bf16* sp = X.SB + ((size_t)(X.bh * 2 + DIR) * 36 + c) * 2048;
    bf16x8 sf[2][2];
#pragma unroll
    for (int s = 0; s < 2; ++s) { sf[s][0] = *(const bf16x8*)(sp + (r32) * 32 + 16 * s + 8 * hi); sf[s][1] = *(const bf16x8*)(sp + (r32 + 32) * 32 + 16 * s + 8 * hi); }
    const GLAS char* vb = vt + ((lane >> 4) & 1) * 32 + (lane & 3) * 8 + (4 * hi + ((lane & 15) >> 2)) * 64;
#pragma unroll
    for (int qh = 0; qh < 2; ++qh) {
        constexpr bool dummy = false; (void)dummy;
        const bool use0 = !(DIR == 1 && qh == 1), use1 = !(DIR == 0 && qh == 0);
        f32x16 p0 = f32x16{}, p1 = f32x16{};
        bf16x8 bq[2];
#pragma unroll
        for (int s = 0; s < 2; ++s) {
            bq[s] = *(const GLAS bf16x8*)(qt + (32 * qh + r32) * KT_STRIDE + (16 * s + 8 * hi) * 2);
            if (use0) { const bf16x8 a0 = *(const GLAS bf16x8*)(kt + r32 * KT_STRIDE + (16 * s + 8 * hi) * 2); p0 = GLA_MFMA(a0, bq[s], p0); }
            if (use1) { const bf16x8 a1 = *(const GLAS bf16x8*)(kt + (32 + r32) * KT_STRIDE + (16 * s + 8 * hi) * 2); p1 = GLA_MFMA(a1, bq[s], p1); }
        }
        const int iq = 32 * qh + r32;
#pragma unroll
        for (int r = 0; r < 16; ++r) { const int j0 = crow(r, hi), j1 = 32 + j0;
            if (DIR == 0) { if (use0 && j0 > iq) p0[r] = 0.f; if (use1 && j1 > iq) p1[r] = 0.f; } else { if (use0 && j0 < iq) p0[r] = 0.f; if (use1 && j1 < iq) p1[r] = 0.f; } }
#pragma unroll
        for (int ks = 0; ks < 4; ++ks) {
            if ((ks < 2) ? !use0 : !use1) continue;
            const f32x16& p = (ks < 2) ? p0 : p1; const int r0 = (ks & 1) * 8;
            const u32x4 pw = (u32x4){pk2(p[r0], p[r0 + 1]), pk2(p[r0 + 2], p[r0 + 3]), pk2(p[r0 + 4], p[r0 + 5]), pk2(p[r0 + 6], p[r0 + 7])};
            const bf16x8 pa = __builtin_bit_cast(bf16x8, pw);
            const s16x4 l0 = vtr(vb + ks * 1024), h0 = vtr(vb + ks * 1024 + 512), l1 = vtr(vb + 4096 + ks * 1024), h1 = vtr(vb + 4096 + ks * 1024 + 512);
            o[qh][0] = GLA_MFMA(pa, ((bf16x8){l0[0], l0[1], l0[2], l0[3], h0[0], h0[1], h0[2], h0[3]}), o[qh][0]);
            o[qh][1] = GLA_MFMA(pa, ((bf16x8){l1[0], l1[1], l1[2], l1[3], h1[0], h1[1], h1[2], h1[3]}), o[qh][1]);
        }
#pragma unroll
        for (int s = 0; s < 2; ++s) { o[qh][0] = GLA_MFMA(bq[s], sf[s][0], o[qh][0]); o[qh][1] = GLA_MFMA(bq[s], sf[s][1], o[qh][1]); }
    }
    GLA_LDSWAIT();
}
__device__ __forceinline__ void stage_c(const Ctx& X, int c, GLAS char* wl, int lane_in) {
    int lane = lane_in; asm volatile("" : "+v"(lane));
    f32x16 o[2][2]; o[0][0] = f32x16{}; o[0][1] = f32x16{}; o[1][0] = f32x16{}; o[1][1] = f32x16{};
    float g0[32], g1[32]; u32x4 kraw[4], qraw[4];
    { const size_t row = X.mbase + 64 * c + lane; const bf16* pr = X.P + (size_t)(64 * c + lane) * LD + X.h * 32;
      load_g(X.DEC + ((size_t)0 * M + row) * 256 + X.h * 32, g0);
#pragma unroll
      for (int j = 0; j < 4; ++j) { kraw[j] = *(const u32x4*)(pr + cfg::E_GK + 8 * j); qraw[j] = *(const u32x4*)(pr + cfg::E_GQ + 8 * j); } }
    load_vtile(X.P + (size_t)(64 * c) * LD + cfg::E_GV + X.h * 64, wl + C_VT, lane);
    stage_c_dir<0, true>(X, c, wl, lane, o, g0, kraw, qraw, X.DEC + ((size_t)1 * M + X.mbase + 64 * c + lane) * 256 + X.h * 32, g1);
    stage_c_dir<1, false>(X, c, wl, lane, o, g1, kraw, qraw, nullptr, g0);
    asm volatile("" : "+v"(lane));
    const int r32 = lane & 31, hi = lane >> 5;
    const float gn0 = X.gg[r32], gn1 = X.gg[r32 + 32];
#ifdef GLAC_GATE_EARLY
    const bf16* gp = X.P + (size_t)(64 * c + lane) * LD + cfg::E_GG + X.h * 64;
    u32x4 gv[8];
#pragma unroll
    for (int j = 0; j < 8; ++j) gv[j] = *(const u32x4*)(gp + 8 * j);
#endif
    GLAS char* stg = wl;
#pragma unroll
    for (int qh = 0; qh < 2; ++qh)
#pragma unroll
        for (int r = 0; r < 16; ++r) {
            const float ss = sum32(o[qh][0][r] * o[qh][0][r] + o[qh][1][r] * o[qh][1][r]);
            const float rs = __builtin_amdgcn_rsqf(ss * (1.f / 64.f) + cfg::EPS);
            GLAS char* rp = stg + (32 * qh + crow(r, hi)) * KH_STRIDE + r32 * 2;
            *(GLAS unsigned short*)rp = f2bf(o[qh][0][r] * rs * gn0); *(GLAS unsigned short*)(rp + 64) = f2bf(o[qh][1][r] * rs * gn1);
        }
    GLA_LDSWAIT();
    bf16* mp = X.MIX + (X.mbase + 64 * c + lane) * 1024 + X.h * 64;
#ifndef GLAC_GATE_EARLY
    const bf16* gp = X.P + (size_t)(64 * c + lane) * LD + cfg::E_GG + X.h * 64;
    u32x4 gv[8];
#pragma unroll
    for (int j = 0; j < 8; ++j) gv[j] = *(const u32x4*)(gp + 8 * j);
#endif
#pragma unroll
    for (int j = 0; j < 8; ++j) {
        const u32x4 ov = *(const GLAS u32x4*)(stg + lane * KH_STRIDE + 16 * j); u32x4 res;
#pragma unroll
        for (int q = 0; q < 4; ++q) {
            const float a0 = __builtin_bit_cast(float, gv[j][q] << 16), a1 = __builtin_bit_cast(float, gv[j][q] & 0xffff0000u);
            const float v0 = __builtin_bit_cast(float, ov[q] << 16), v1 = __builtin_bit_cast(float, ov[q] & 0xffff0000u);
            res[q] = pk2(v0 * (a0 * __builtin_amdgcn_rcpf(1.f + ex(-a0))), v1 * (a1 * __builtin_amdgcn_rcpf(1.f + ex(-a1))));
        }
        *(u32x4*)(mp + 8 * j) = res;
    }
    GLA_LDSWAIT();
}
__device__ __forceinline__ Ctx ctx_of(const Ctx& B0, int bh) { Ctx X = B0; const int b = bh >> 3; X.h = bh & 7; X.bh = bh; X.mbase = (size_t)b * cfg::RB; X.P = B0.P + (size_t)b * cfg::RB * LD; return X; }
__device__ __forceinline__ int gla_task(int i, int total, int gw, int NGW, int wid) {
    const int full = total / NGW, left = total - full * NGW, G = NGW >> 3;
    if (i < full) return i * NGW + gw;
    if (i == full) { const int e = wid * G + (gw >> 3); return e < left ? full * NGW + e : -1; }
    return -1;
}
__device__ __forceinline__ void phase_a(const Ctx& B0, GLAS char* lds, int gw, int NGW, int wid, int lane) {
    GLAS char* wl = lds + wid * WAVE_LDS;
    for (int i = 0;; ++i) { const int t = gla_task(i, 64 * 72, gw, NGW, wid); if (t < 0) break; const int bh = t / 72, r = t - bh * 72; const Ctx X = ctx_of(B0, bh); if (r & 1) stage_a<1>(X, r >> 1, wl, lane); else stage_a<0>(X, r >> 1, wl, lane); }
}
__device__ __forceinline__ void phase_c(const Ctx& B0, GLAS char* lds, int gw, int NGW, int wid, int lane) {
    GLAS char* wl = lds + wid * WAVE_LDS;
    for (int i = 0;; ++i) { const int t = gla_task(i, 64 * 36, gw, NGW, wid); if (t < 0) break; const int bh = t / 36, c = t - bh * 36; const Ctx X = ctx_of(B0, bh); stage_c(X, c, wl, lane); }
}
#ifndef UB_BATCH
#define UB_BATCH 18
#endif
__device__ __forceinline__ void unit_b(const Ctx& X, GLAS char* lds, const int tid) {
    const int dir = tid >> 8, dv = (tid >> 2) & 63, k8 = (tid & 3) * 8;
    float S[8];
#pragma unroll
    for (int i = 0; i < 8; ++i) S[i] = 0.f;
    const size_t base = (size_t)(X.bh * 2 + dir) * 36;
    const bf16* __restrict__ USp = X.US + base * 2048 + dv * 32 + k8; bf16* __restrict__ SBp = X.SB + base * 2048 + dv * 32 + k8;
    GLAS float* dl = (GLAS float*)lds;
    { const float* __restrict__ src = X.DD + (size_t)X.bh * 2 * 36 * 32;
      const f32x4 a = *(const f32x4*)(src + 4 * tid); f32x4 b = (f32x4){0.f, 0.f, 0.f, 0.f}; if (tid < 64) b = *(const f32x4*)(src + 2048 + 4 * tid);
      *(GLAS f32x4*)(dl + 4 * tid) = a; if (tid < 64) *(GLAS f32x4*)(dl + 2048 + 4 * tid) = b; }
    const GLAS float* dk = dl + dir * 36 * 32 + k8;
#pragma unroll
    for (int s0 = 0; s0 < 36; s0 += UB_BATCH) {
        u32x4 uw[UB_BATCH];
#pragma unroll
        for (int j = 0; j < UB_BATCH; ++j) { const int s = s0 + j, cc = dir == 0 ? (s < 4 ? 32 + s : s - 4) : 35 - s; uw[j] = *(const u32x4*)(USp + (size_t)cc * 2048); }
        if (s0 == 0) { GLA_LDSWAIT(); __syncthreads(); }
#pragma unroll
        for (int j = 0; j < UB_BATCH; ++j) {
            const int s = s0 + j, cc = dir == 0 ? (s < 4 ? 32 + s : s - 4) : 35 - s;
            *(u32x4*)(SBp + (size_t)cc * 2048) = (u32x4){pk2(S[0], S[1]), pk2(S[2], S[3]), pk2(S[4], S[5]), pk2(S[6], S[7])};
            const f32x4 d0 = *(const GLAS f32x4*)(dk + cc * 32), d1 = *(const GLAS f32x4*)(dk + cc * 32 + 4);
            const unsigned uu[4] = {uw[j].x, uw[j].y, uw[j].z, uw[j].w};
#pragma unroll
            for (int i = 0; i < 4; ++i) {
                S[2 * i] = (i < 2 ? d0[2 * i] : d1[2 * i - 4]) * S[2 * i] + __builtin_bit_cast(float, uu[i] << 16);
                S[2 * i + 1] = (i < 2 ? d0[2 * i + 1] : d1[2 * i - 3]) * S[2 * i + 1] + __builtin_bit_cast(float, uu[i] & 0xffff0000u);
            }
        }
    }
}
#undef GLAS
}
namespace fw {
using namespace cfg;
constexpr int NWAVES = 8;
constexpr size_t MiB = 1u << 20;
constexpr size_t WS_CTL = 0, CTL_ZERO_BYTES = 512 * 1024;
constexpr size_t WS_MOD = 1 * MiB;
constexpr size_t WS_TAB = 1 * MiB + 896 * 1024;
constexpr size_t WS_DD = 2 * MiB;
constexpr size_t WS_CB = 640 * 1024;
constexpr size_t WS_SQ = 2 * MiB + 576 * 1024;
constexpr size_t WS_LR = 3 * MiB + 768 * 1024;
constexpr size_t WS_XC = 6 * MiB;
constexpr size_t WS_W = 14 * MiB;
constexpr size_t W_IN_E = (size_t)LDE * D * 2, W_IN_O = (size_t)LDO * D * 2, W_OUT = (size_t)D * D * 2, W_13 = (size_t)2 * FFH * D * 2, W_2 = (size_t)D * FFH * 2;
constexpr size_t W_LAYER_E = W_IN_E + W_OUT + W_13 + W_2, W_LAYER_O = W_IN_O + W_OUT + W_13 + W_2;
constexpr size_t WS_HN = 103 * MiB;
constexpr size_t WS_PROJ = 139 * MiB;
constexpr size_t WS_MIX = 238 * MiB;
constexpr size_t WS_H = 139 * MiB;
constexpr size_t WS_US = 274 * MiB, WS_SB = 292 * MiB;
constexpr size_t WS_XMID = WS_US;
constexpr size_t WS_SLAB = 310 * MiB;
constexpr size_t WS_DEC = WS_SLAB;
constexpr size_t WS_END = 374 * MiB;
static_assert(WS_W + 2 * W_LAYER_E + 2 * W_LAYER_O <= WS_HN && WS_HN + (size_t)M * D * 2 <= WS_PROJ && WS_PROJ + (size_t)M * LDE * 2 <= WS_MIX && WS_MIX + (size_t)M * D * 2 <= WS_US, "ws map");
static_assert(WS_CB >= CTL_ZERO_BYTES && WS_CB + (size_t)9 * (LDE + 2 * FFH) * 4 <= WS_MOD && WS_DD + (size_t)64 * 72 * 32 * 4 <= WS_SQ && WS_SQ + (size_t)M * 16 * 4 <= WS_LR && WS_LR + (size_t)M * 32 * 4 <= WS_XC, "ws map 3");
static_assert((size_t)2 * M * 256 * 4 <= (size_t)M * D * 2 && WS_H + (size_t)M * FFH * 2 <= WS_MIX && WS_SB + 18 * MiB <= WS_SLAB && WS_SLAB + 64 * MiB <= WS_END && (size_t)64 * 72 * 4096 <= 18 * MiB, "ws map 2");
__host__ __device__ constexpr size_t w_layer_off(int l) { return (size_t)(l >> 1) * (W_LAYER_E + W_LAYER_O) + ((l & 1) ? W_LAYER_E : 0); }
constexpr int CW_TMO = 0, CW_BAR = 1024, CW_Q = 8192;
constexpr int CW_SPLIT = 16384;
constexpr int RTAB_OFF = 131072;
constexpr int RING_BYTES = 131072, GLA_LDS_BYTES = 8 * 18432, MISC_OFF = GLA_LDS_BYTES + 320, LDS_BYTES = GLA_LDS_BYTES + 1024;

#define GAS __attribute__((address_space(1)))
#define LAS __attribute__((address_space(3)))
typedef unsigned short bf16;
typedef unsigned v4u __attribute__((ext_vector_type(4)));
typedef float f32x4 __attribute__((ext_vector_type(4)));
typedef GAS unsigned gu32;
#define RLX_AGENT __ATOMIC_RELAXED, __HIP_MEMORY_SCOPE_AGENT
#define LDS_WAIT() asm volatile("s_waitcnt lgkmcnt(0)" ::: "memory")
#define VM_WAIT() asm volatile("s_waitcnt vmcnt(0)" ::: "memory")
__device__ __forceinline__ unsigned f2bf(float f) { unsigned u = __builtin_bit_cast(unsigned, f); return (u + 0x7fffu + ((u >> 16) & 1u)) >> 16; }
__device__ __forceinline__ unsigned pk2(float lo, float hi) { return f2bf(lo) | (f2bf(hi) << 16); }
__device__ __forceinline__ float bf2f(unsigned short v) { return __builtin_bit_cast(float, (unsigned)v << 16); }
__device__ __forceinline__ float wave_sum(float v) { return xl::sum64(v); }

#define XB_TMO      128
#define XB_XCNT(j)  (256  + 64 * (j))
#define XB_XSUB(j)  (1280 + 64 * (j))
#define XB_XGEN(j)  (2304 + 64 * (j))
#define XB_TOP      3328
#define XB_TOPGEN   3392
#define XCD_BAR_WORDS 3456
#define XB_SPIN_CAP (1u << 18)
__device__ __forceinline__ unsigned xb_ld(unsigned* p)              { return __hip_atomic_load(p, __ATOMIC_RELAXED, __HIP_MEMORY_SCOPE_AGENT); }
__device__ __forceinline__ unsigned xb_add(unsigned* p, unsigned v) { return __hip_atomic_fetch_add(p, v, __ATOMIC_RELAXED, __HIP_MEMORY_SCOPE_AGENT); }
__device__ __forceinline__ unsigned xb_xcc_id() { return (unsigned)__builtin_amdgcn_s_getreg((3 << 11) | 20) & 0xFu; }
#define XB_SPIN(cond, bar) do { unsigned _sp = 0; while (cond) { __builtin_amdgcn_s_sleep(1); \
    if ((++_sp & 255u) == 0u) { if (xb_ld(&(bar)[XB_TMO])) break; if (_sp > XB_SPIN_CAP) { atomicAdd(&(bar)[XB_TMO], 1u); break; } } } } while (0)
struct XcdBarrier { unsigned* bar; unsigned x; volatile LAS unsigned* st; };
__device__ __forceinline__ XcdBarrier xcd_barrier_post(unsigned* bar, volatile LAS unsigned* st) {
    XcdBarrier b; b.bar = bar; b.x = xb_xcc_id(); b.st = st;
    if (threadIdx.x == 0) (void)xb_add(&bar[XB_XCNT(b.x)], 1u);
    return b;
}
__device__ __forceinline__ void xcd_barrier_complete(unsigned* bar, unsigned x, unsigned& nloc, unsigned& nx) {
    const unsigned G = gridDim.x * gridDim.y * gridDim.z;
    unsigned sum, cnt, mine, sp = 0u;
    for (;;) {
        sum = 0u; cnt = 0u; mine = 0u;
#pragma unroll
        for (unsigned j = 0; j < 16; ++j) { const unsigned c = xb_ld(&bar[XB_XCNT(j)]); sum += c; cnt += (c > 0u) ? 1u : 0u; mine = (j == x) ? c : mine; }
        if (sum == G) break;
        __builtin_amdgcn_s_sleep(1);
        if ((++sp & 255u) == 0u) { if (xb_ld(&bar[XB_TMO])) break; if (sp > XB_SPIN_CAP) { atomicAdd(&bar[XB_TMO], 1u); break; } }
    }
    nloc = mine > 0u ? mine : 1u; nx = cnt > 0u ? cnt : 1u;
}
__device__ __forceinline__ void xcd_barrier(const XcdBarrier& b, const bool t0) {
    asm volatile("s_waitcnt vmcnt(0)" ::: "memory");
    __syncthreads();
    if (t0) {
        unsigned* bar = b.bar;
        __builtin_amdgcn_s_waitcnt(0);
        unsigned nloc = b.st[0], nx = b.st[1];
        if (nloc == 0u) { xcd_barrier_complete(bar, b.x, nloc, nx); b.st[0] = nloc; b.st[1] = nx; }
        const unsigned old = xb_add(&bar[XB_XSUB(b.x)], 1u);
        const unsigned gen = old / nloc;
        if (old + 1u == (gen + 1u) * nloc) {
            __builtin_amdgcn_fence(__ATOMIC_RELEASE, "agent");
            asm volatile("s_waitcnt vmcnt(0)" ::: "memory");
            const unsigned og = xb_add(&bar[XB_TOP], 1u);
            const unsigned tg = og / nx;
            if (og + 1u == (tg + 1u) * nx) xb_add(&bar[XB_TOPGEN], 1u);
            else XB_SPIN(xb_ld(&bar[XB_TOPGEN]) == tg, bar);
            __builtin_amdgcn_fence(__ATOMIC_ACQUIRE, "agent");
            xb_add(&bar[XB_XGEN(b.x)], 1u);
            asm volatile("s_waitcnt vmcnt(0)" ::: "memory");
        } else {
            XB_SPIN(xb_ld(&bar[XB_XGEN(b.x)]) == gen, bar);
            __builtin_amdgcn_fence(__ATOMIC_ACQUIRE, "agent");
            asm volatile("s_waitcnt vmcnt(0)" ::: "memory");
        }
    }
    __syncthreads();
}

struct Args { const float* in[22]; float* out; unsigned char* ws; int ph_lo, ph_hi; };
typedef const __attribute__((address_space(4))) Args* ArgP;
enum { I_X = 0, I_C, I_CTX, I_CCTX, I_ADAW, I_ADAB, I_N1G, I_N2G, I_W1, I_W3, I_W2, I_EIN, I_EOUT, I_GKW, I_GKB, I_GLAG, I_QNG, I_KNG, I_OIN, I_OOUT, I_SINK, I_FG };
enum { S_NORM1 = 0, S_G1, S_PREP, S_GLAA, S_MIX, S_GLAC, S_G2, S_NORM2, S_G3, S_G3B, S_G4, PH_PER_LAYER };
constexpr int N_PHASES = 2 + PH_PER_LAYER * DEPTH;
__host__ __device__ constexpr bool phase_active(int ph) {
    if (ph == 0 || ph == N_PHASES - 1) return true;
    const int l = (ph - 1) / PH_PER_LAYER, s = (ph - 1) % PH_PER_LAYER;
    if (s == S_NORM2 || s == S_PREP || (s == S_NORM1 && l > 0)) return false;
    if (s == S_G3B && l == DEPTH - 1) return false;
    return !((l & 1) && (s == S_GLAA || s == S_GLAC));
}

__device__ __forceinline__ void p0_mods(ArgP A, LAS unsigned char* lds, int l0, int nl, int slot, int nslots, int tid, int lane, int wave) {
    LAS float* sc = (LAS float*)lds;
    LAS float* part = (LAS float*)(lds + 40960);
    if (slot >= 96 * nl) return;
    for (int i = tid; i < 9 * 1024; i += 512) { const int j = i >> 10, k = i & 1023; const float v = j < 8 ? A->in[I_C][j * 1024 + k] : A->in[I_CCTX][k]; sc[i] = v * __builtin_amdgcn_rcpf(1.f + __builtin_amdgcn_exp2f(-LOG2E * v)); }
    __syncthreads();
    float* mod = (float*)(A->ws + WS_MOD);
    for (int t = slot; t < 96 * nl; t += nslots) {
        const int l = l0 + t / 96, cg = t % 96, n = cg * 64 + lane;
        const float* w = A->in[I_ADAW] + ((size_t)l * 1024 + wave * 128) * 6144 + n;
        float acc[9];
#pragma unroll
        for (int j = 0; j < 9; ++j) acc[j] = 0.f;
#pragma nounroll
        for (int k0 = 0; k0 < 128; k0 += 32) { float wv[32];
#pragma unroll
            for (int k = 0; k < 32; ++k) wv[k] = __builtin_nontemporal_load(w + (size_t)(k0 + k) * 6144);
#pragma unroll
            for (int k = 0; k < 32; ++k)
#pragma unroll
                for (int j = 0; j < 9; ++j) acc[j] += sc[j * 1024 + wave * 128 + k0 + k] * wv[k]; }
#pragma unroll
        for (int j = 0; j < 9; ++j) part[(wave * 9 + j) * 64 + lane] = acc[j];
        __syncthreads();
        for (int o = tid; o < 576; o += 512) { const int j = o >> 6, c = o & 63; float s = 0.f;
#pragma unroll
            for (int w8 = 0; w8 < 8; ++w8) s += part[(w8 * 9 + j) * 64 + c];
            mod[((size_t)l * 9 + j) * 6144 + cg * 64 + c] = s + A->in[I_ADAB][l * 6144 + cg * 64 + c]; }
        __syncthreads();
    }
}
__device__ __forceinline__ void p0_item(const float* W, int Nsrc, int srccol, int k0, bf16* WT, int K, int dstrow, LAS float* scr, int lane) {
    if (srccol >= 0) {
        float v[32]; const float* wp = W + (size_t)(k0 + (lane >> 5)) * Nsrc + srccol + (lane & 31);
#pragma unroll
        for (int i = 0; i < 32; ++i) v[i] = __builtin_nontemporal_load(wp + (size_t)(2 * i) * Nsrc);
#pragma unroll
        for (int i = 0; i < 32; ++i) scr[(2 * i + (lane >> 5)) * 33 + (lane & 31)] = v[i];
    } else {
#pragma unroll 8
        for (int i = 0; i < 32; ++i) { const int kk = 2 * i + (lane >> 5); scr[kk * 33 + (lane & 31)] = 0.f; }
    }
    LDS_WAIT(); asm volatile("" ::: "memory");
    const int c = lane & 7;
#pragma unroll
    for (int j = 0; j < 4; ++j) { const int n = (lane >> 3) + 8 * j; const LAS float* s = scr + (8 * c) * 33 + n;
        v4u o; o.x = pk2(s[0 * 33], s[1 * 33]); o.y = pk2(s[2 * 33], s[3 * 33]); o.z = pk2(s[4 * 33], s[5 * 33]); o.w = pk2(s[6 * 33], s[7 * 33]);
        *(GAS v4u*)(WT + (size_t)(dstrow + n) * K + k0 + 8 * c) = o; }
    LDS_WAIT(); asm volatile("" ::: "memory");
}
__device__ __forceinline__ void conv_layer(ArgP A, int l, LAS unsigned char* lds, int wslot, int nslots, int lane, int wave) {
    LAS float* scr = (LAS float*)(lds + wave * 16384);
    constexpr int IT_E = 16 * 80, IT_O = 16 * 40, IT_OUT = 16 * 32, IT_13 = 16 * 176, IT_2 = 44 * 32;
    const int odd = l & 1, i = l >> 1;
    const int it_in = odd ? IT_O : IT_E, total = it_in + IT_OUT + IT_13 + IT_2; const size_t w_in_b = odd ? W_IN_O : W_IN_E;
    bf16* wl = (bf16*)(A->ws + WS_W + w_layer_off(l));
    for (int it = wslot; it < total; it += nslots) {
        int r = it;
        if (r < it_in) {
            const int nblk = odd ? 40 : 80, kb = r / nblk, nb = r % nblk, d0 = 32 * nb;
            if (odd) p0_item(A->in[I_OIN] + (size_t)i * D * LDO, LDO, d0, 64 * kb, wl, D, d0, scr, lane);
            else { const int sc = d0 < 1536 ? d0 : (d0 < 2304 ? d0 + 32 : (d0 == 2304 ? 1536 : -1)); p0_item(A->in[I_EIN] + (size_t)i * D * 2336, 2336, sc, 64 * kb, wl, D, d0, scr, lane); }
            continue; }
        r -= it_in;
        if (r < IT_OUT) { const int kb = r / 32, nb = r % 32; p0_item((odd ? A->in[I_OOUT] : A->in[I_EOUT]) + (size_t)i * D * D, D, 32 * nb, 64 * kb, (bf16*)((unsigned char*)wl + w_in_b), D, 32 * nb, scr, lane); continue; }
        r -= IT_OUT;
        if (r < IT_13) { const int kb = r / 176, nb = r % 176, d0 = 32 * nb, tile = d0 >> 8, within = d0 & 255;
            const float* src = (within < 128 ? A->in[I_W1] : A->in[I_W3]) + (size_t)l * D * FFH;
            p0_item(src, FFH, 128 * tile + (within & 127), 64 * kb, (bf16*)((unsigned char*)wl + w_in_b + W_OUT), D, d0, scr, lane); continue; }
        r -= IT_13;
        { const int kb = r / 32, nb = r % 32; p0_item(A->in[I_W2] + (size_t)l * FFH * D, D, 32 * nb, 64 * kb, (bf16*)((unsigned char*)wl + w_in_b + W_OUT + W_13), FFH, 32 * nb, scr, lane); }
    }
}
__device__ __forceinline__ void p0_tab(ArgP A, int tid) {
    float2* tab = (float2*)(A->ws + WS_TAB);
    for (int e = tid; e < 1024; e += 512) {
        const int p = e >> 4, i = e & 15;
        const float inv = __builtin_amdgcn_exp2f(-(float)(2 * i) * (1.f / 32.f) * 13.287712379549449f);
        const float x = (float)p * inv;
        const float q = __builtin_rintf(x * 0.63661977236758f);
        float r = __builtin_fmaf(-q, 1.5703125f, x); r = __builtin_fmaf(-q, 4.837512969970703125e-4f, r); r = __builtin_fmaf(-q, 7.549789954891882e-8f, r);
        const int qi = ((int)q) & 3; const float r2 = r * r;
        const float s = r + r * r2 * (-1.6666654611e-1f + r2 * (8.3321608736e-3f + r2 * (-1.9515295891e-4f)));
        const float c = 1.f - 0.5f * r2 + r2 * r2 * (4.166664568298827e-2f + r2 * (-1.388731625493765e-3f + r2 * 2.443315711809948e-5f));
        float cs, sn;
        if (qi == 0) { cs = c; sn = s; } else if (qi == 1) { cs = -s; sn = c; } else if (qi == 2) { cs = -c; sn = -s; } else { cs = s; sn = -c; }
        tab[e] = make_float2(cs, sn);
    }
}

__device__ __forceinline__ const float* x_row(const float* lat, const float* ctx, int b, int t) { return t < SEQ ? lat + ((size_t)b * SEQ + t) * D : ctx + ((size_t)b * CTX + (t - SEQ)) * D; }

__device__ __forceinline__ void xg_phase(ArgP A, int gw, int NGW, int lane) {
    const float* g = A->in[I_N1G]; const float* mod = (const float*)(A->ws + WS_MOD);
    bf16* HN = (bf16*)(A->ws + WS_HN); float* SQ = (float*)(A->ws + WS_SQ); bf16* XB = (bf16*)A->out;
    f32x4 gv[4];
#pragma unroll
    for (int j = 0; j < 4; ++j) gv[j] = *(const f32x4*)(g + lane * 4 + 256 * j);
    for (int m = gw; m < M; m += NGW) {
        const int b = m / RB, t = m - b * RB;
        const float* xr = x_row(A->in[I_X], A->in[I_CTX], b, t) + lane * 4; const float* mp = mod + (size_t)(t < SEQ ? b : 8) * 6144 + D + lane * 4;
        f32x4 v[4]; float s = 0.f;
#pragma unroll
        for (int j = 0; j < 4; ++j) { v[j] = *(const f32x4*)(xr + 256 * j); s += (v[j].x * v[j].x + v[j].y * v[j].y) + (v[j].z * v[j].z + v[j].w * v[j].w); }
        s = wave_sum(s);
        if (lane < 16) SQ[(size_t)m * 16 + lane] = lane == 0 ? s : 0.f;
        unsigned long long* o8 = (unsigned long long*)(HN + (size_t)m * D) + lane; unsigned long long* x8 = (unsigned long long*)(XB + (size_t)m * D) + lane;
#pragma unroll
        for (int j = 0; j < 4; ++j) { const f32x4 sc = *(const f32x4*)(mp + 256 * j); const f32x4 y = v[j] * gv[j] * (sc + 1.f);
            o8[64 * j] = (unsigned long long)pk2(y.x, y.y) | ((unsigned long long)pk2(y.z, y.w) << 32);
            x8[64 * j] = (unsigned long long)pk2(v[j].x, v[j].y) | ((unsigned long long)pk2(v[j].z, v[j].w) << 32); }
    }
}
__device__ __forceinline__ void cb_layer(ArgP A, int l, LAS unsigned char* lds, int wslot, int nslots, int tid, int lane) {
    LAS float* sh = (LAS float*)lds;
    const float* mod = (const float*)(A->ws + WS_MOD) + (size_t)l * 9 * 6144;
    for (int e = tid; e < 2 * 9 * 1024; e += 512) { const int w2 = e / 9216, r = e - w2 * 9216, j = r >> 10, k = r & 1023; sh[e] = mod[(size_t)j * 6144 + (w2 ? 3 * D : 0) + k]; }
    __syncthreads();
    if (wslot >= 0) {
        const int odd = l & 1, nin = odd ? LDO : LDE, total = nin + 2 * FFH;
        const bf16* wl = (const bf16*)(A->ws + WS_W + w_layer_off(l)); const bf16* w13 = (const bf16*)((const unsigned char*)wl + (odd ? W_IN_O : W_IN_E) + W_OUT);
        float* cb = (float*)(A->ws + WS_CB);
        for (int n = wslot; n < total; n += nslots) {
            const bool up = n >= nin; const bf16* wr = up ? w13 + (size_t)(n - nin) * D : wl + (size_t)n * D;
            const v4u w0 = *(const v4u*)(wr + lane * 16), w1 = *(const v4u*)(wr + lane * 16 + 8);
            float wv[16];
#pragma unroll
            for (int q = 0; q < 4; ++q) { wv[2 * q] = __builtin_bit_cast(float, w0[q] << 16); wv[2 * q + 1] = __builtin_bit_cast(float, w0[q] & 0xffff0000u); wv[8 + 2 * q] = __builtin_bit_cast(float, w1[q] << 16); wv[8 + 2 * q + 1] = __builtin_bit_cast(float, w1[q] & 0xffff0000u); }
            const LAS float* sp = sh + (up ? 9216 : 0) + lane * 16;
            float acc[9];
#pragma unroll
            for (int j = 0; j < 9; ++j) { float a = 0.f;
#pragma unroll
                for (int q = 0; q < 4; ++q) { const f32x4 s4 = *(const LAS f32x4*)(sp + j * 1024 + 4 * q); a += (wv[4 * q] * s4[0] + wv[4 * q + 1] * s4[1]) + (wv[4 * q + 2] * s4[2] + wv[4 * q + 3] * s4[3]); }
                acc[j] = wave_sum(a); }
            if (lane < 9) { float v = acc[0];
#pragma unroll
                for (int j = 1; j < 9; ++j) v = lane == j ? acc[j] : v;
                cb[up ? (size_t)9 * LDE + (size_t)lane * 2 * FFH + (n - nin) : (size_t)lane * LDE + n] = v; }
        }
    }
    __syncthreads();
}
template <class Sched> __device__ __forceinline__ void rtab_build(const Sched& S, const float* SQ, LAS float* rtab, int tid) {
    f32x4 v[4][4]; bool ok[4];
#pragma unroll
    for (int it = 0; it < 4; ++it) { const int e = tid + 512 * it; pg8::Unit u; ok[it] = (e < 7 * 256) && S.next(e >> 8, u);
        const f32x4* p = (const f32x4*)(SQ + ((size_t)(ok[it] ? u.pm : 0) * 256 + (e & 255)) * 16);
#pragma unroll
        for (int q = 0; q < 4; ++q) v[it][q] = p[q]; }
#pragma unroll
    for (int it = 0; it < 4; ++it) { const f32x4 a = v[it][0], b = v[it][1], c = v[it][2], d = v[it][3];
        const float s = ((a[0] + a[1]) + (a[2] + a[3])) + ((b[0] + b[1]) + (b[2] + b[3])) + ((c[0] + c[1]) + (c[2] + c[3])) + ((d[0] + d[1]) + (d[2] + d[3]));
        if (ok[it]) rtab[tid + 512 * it] = __builtin_amdgcn_rsqf(s * (1.f / D) + EPS); }
    __syncthreads();
}
__device__ __forceinline__ void final_phase(ArgP A, int gw, int NGW, int lane) {
    const bf16* X = (const bf16*)(A->ws + WS_HN);
    f32x4 gv[4];
#pragma unroll
    for (int j = 0; j < 4; ++j) gv[j] = *(const f32x4*)(A->in[I_FG] + lane * 4 + 256 * j);
    constexpr int FIN_U = 4;
    for (int r0 = gw; r0 < NB * SEQ; r0 += NGW * FIN_U) {
        unsigned long long w[FIN_U][4];
#pragma unroll
        for (int q = 0; q < FIN_U; ++q) { const int r = r0 + q * NGW; const int rc = r < NB * SEQ ? r : gw; const int b = rc >> 11, t = rc & 2047;
            const unsigned long long* xr = (const unsigned long long*)(X + ((size_t)b * RB + t) * D) + lane;
#pragma unroll
            for (int j = 0; j < 4; ++j) w[q][j] = xr[64 * j]; }
#pragma unroll
        for (int q = 0; q < FIN_U; ++q) { const int r = r0 + q * NGW; if (r >= NB * SEQ) break;
            f32x4 v[4]; float s = 0.f;
#pragma unroll
            for (int j = 0; j < 4; ++j) { const unsigned lo = (unsigned)w[q][j], hi = (unsigned)(w[q][j] >> 32);
                v[j] = (f32x4){__builtin_bit_cast(float, lo << 16), __builtin_bit_cast(float, lo & 0xffff0000u), __builtin_bit_cast(float, hi << 16), __builtin_bit_cast(float, hi & 0xffff0000u)};
                s += (v[j].x * v[j].x + v[j].y * v[j].y) + (v[j].z * v[j].z + v[j].w * v[j].w); }
            const float rr = __builtin_amdgcn_rsqf(wave_sum(s) * (1.f / D) + EPS);
            float* orow = A->out + (size_t)r * D + lane * 4;
#pragma unroll
            for (int j = 0; j < 4; ++j) *(f32x4*)(orow + 256 * j) = v[j] * rr * gv[j]; }
    }
}
typedef unsigned u32x4v __attribute__((ext_vector_type(4)));
__device__ __forceinline__ float xor_sum8(float v) { return xl::sum8(v); }
__device__ __forceinline__ void head8(float (&x)[8], int lane, bool norm, const float (&gain)[8], bool latent, const float2* tab, int t, float outscale) {
    if (norm) { float ss = 0.f;
#pragma unroll
        for (int j = 0; j < 8; ++j) ss += x[j] * x[j];
        const float rs = __builtin_amdgcn_rsqf(xor_sum8(ss) * (1.f / 64.f) + EPS);
#pragma unroll
        for (int j = 0; j < 8; ++j) x[j] *= rs * gain[j]; }
    if (latent) {
        const int pos = (lane & 4) ? (t & 63) : (t >> 6); const f32x4* tp = (const f32x4*)(tab + pos * 16 + 8 * (lane & 1));
        const bool second = lane & 2;
#pragma unroll
        for (int j4 = 0; j4 < 4; ++j4) { const f32x4 cs = tp[j4];
            const float p0 = xl::xor2(x[2 * j4]), p1 = xl::xor2(x[2 * j4 + 1]);
            x[2 * j4] = x[2 * j4] * cs[0] + (second ? p0 : -p0) * cs[1]; x[2 * j4 + 1] = x[2 * j4 + 1] * cs[2] + (second ? p1 : -p1) * cs[3]; }
    }
#pragma unroll
    for (int j = 0; j < 8; ++j) x[j] *= outscale;
}
__device__ __forceinline__ void unpack8(const u32x4v w, float (&x)[8]) {
#pragma unroll
    for (int j = 0; j < 4; ++j) { x[2 * j] = __builtin_bit_cast(float, w[j] << 16); x[2 * j + 1] = __builtin_bit_cast(float, w[j] & 0xffff0000u); } }
__device__ __forceinline__ u32x4v pack8(const float (&x)[8]) { u32x4v w; w[0] = pk2(x[0], x[1]); w[1] = pk2(x[2], x[3]); w[2] = pk2(x[4], x[5]); w[3] = pk2(x[6], x[7]); return w; }
}
namespace fwpost {
struct Ctx { unsigned short* P; int ld; int even; const float* qn; const float* kn; const float2* tab; const float* LR; float* DEC; const float* gkw; const float* gkb; };
__device__ __forceinline__ void run(const Ctx& c, int pm, int pn, int tid_in) {
    using namespace fw;
    int tid = tid_in; asm volatile("" : "+v"(tid));
    const int lane = tid & 63, wave = __builtin_amdgcn_readfirstlane(tid >> 6); const int b = pm / 9, j = pm - 9 * b; const bool latent = j < 8; const int t0 = 256 * j;
    const size_t m0 = (size_t)pm * 256;
    const bool ktile = c.even ? pn == 8 : pn == 4;
    float gain[8];
#pragma unroll
    for (int q = 0; q < 8; ++q) gain[q] = c.even ? (ktile ? c.kn : c.qn)[8 * (lane & 7) + q] : 1.f;
    if (!ktile) return;
    if (c.even || latent) {
        unsigned short* p0 = c.P + (m0 + wave * 32 + (lane >> 4)) * c.ld + pn * 256 + 8 * (lane & 15);
#pragma nounroll
        for (int h4 = 0; h4 < 2; ++h4) {
            u32x4v raw[4];
#pragma unroll
            for (int s = 0; s < 4; ++s) raw[s] = *(const u32x4v*)(p0 + (size_t)(16 * h4 + 4 * s) * c.ld);
#pragma unroll
            for (int s = 0; s < 4; ++s) { float x[8]; unpack8(raw[s], x); head8(x, lane, c.even, gain, latent, c.tab, t0 + wave * 32 + 16 * h4 + 4 * s + (lane >> 4), 1.f); raw[s] = pack8(x); }
#pragma unroll
            for (int s = 0; s < 4; ++s) *(u32x4v*)(p0 + (size_t)(16 * h4 + 4 * s) * c.ld) = raw[s];
        }
    }
}
}
namespace fw {
__device__ __forceinline__ gla::Ctx gla_base(ArgP A, int i) {
    gla::Ctx X; X.P = (const gla::bf16*)(A->ws + WS_PROJ); X.DEC = (float*)(A->ws + WS_DEC); X.LR = (const float*)(A->ws + WS_LR); X.gkw = A->in[I_GKW] + (size_t)i * 2 * 16 * 256; X.gkb = A->in[I_GKB] + (size_t)i * 512; X.mbase = 0; X.h = 0; X.bh = 0;
    X.US = (gla::bf16*)(A->ws + WS_US); X.SB = (gla::bf16*)(A->ws + WS_SB); X.DD = (float*)(A->ws + WS_DD); X.MIX = (gla::bf16*)(A->ws + WS_MIX); X.gg = A->in[I_GLAG] + i * 64; return X;
}
__device__ __forceinline__ int q_next(gu32* ctr, volatile LAS unsigned* slot, int tid) {
    __syncthreads();
    if (tid == 0) slot[0] = __hip_atomic_fetch_add(ctr, 1u, RLX_AGENT);
    __syncthreads();
    return (int)slot[0];
}
__device__ __forceinline__ void mixer_even(ArgP A, int l, LAS unsigned char* ldsl, char* lds, volatile LAS unsigned* MISC, int tid, int rep) {
    const int i = l >> 1; gu32* ctr = (gu32*)(A->ws + WS_CTL) + CW_Q + 64 * l + 16 * rep;
    const ab::bf16* P = (const ab::bf16*)(A->ws + WS_PROJ); ab::bf16* MIXp = (ab::bf16*)(A->ws + WS_MIX);
    constexpr int NSCAN = 64;
    const int total = NSCAN + 512 + 64;
    int qi = q_next(ctr, MISC + 16, tid);
    while (qi < total) {
        const int idx = qi - NSCAN;
        if (idx < 0) {
#ifndef NO_GLA
            { int t_ = tid; asm volatile("" : "+v"(t_)); const int sidx = idx + NSCAN;
              const gla::Ctx X = gla::ctx_of(gla_base(A, i), sidx); gla::unit_b(X, (__attribute__((address_space(3))) char*)ldsl, t_);
            }
#endif
        } else {
            ab::AUnit U; int b, head, j;
            if (idx < 512) { const int r = idx; b = r >> 6; head = (r >> 3) & 7; j = r & 7; U.r1 = 0; U.NT = 36; }
            else { const int r = idx - 512; b = r >> 3; head = r & 7; j = 8; U.r1 = SEQ; U.NT = 4; }
            const size_t row0 = (size_t)b * RB, qrow = row0 + 256 * j;
            U.Q = P + qrow * LDE + E_BQ + 64 * head; U.K = P + row0 * LDE + E_BK + 64 * (head >> 2); U.V = P + row0 * LDE + E_BV + 64 * (head >> 2);
            U.O = MIXp + qrow * 1024 + 512 + 64 * head; U.r2 = 0; U.q0 = 256 * j; U.sink2 = -INFINITY; U.sinkv = nullptr; U.qgain = A->in[I_QNG] + i * 64; U.tab = j < 8 ? (const float2*)(A->ws + WS_TAB) : nullptr;
#ifndef NO_ATTB
            { int t_ = tid; asm volatile("" : "+v"(t_)); ab::attn_unit<LDE, 0, 8, false>(U, lds, t_); }
#endif
        }
        qi = q_next(ctr, MISC + 16, tid);
    }
}
__device__ __forceinline__ void mixer_odd(ArgP A, int l, bool with_ctx, char* lds, volatile LAS unsigned* MISC, int tid, int rep, int vcu, int G) {
    const int i = l >> 1; (void)MISC; (void)rep;
    const ab::bf16* P = (const ab::bf16*)(A->ws + WS_PROJ); ab::bf16* MIXp = (ab::bf16*)(A->ws + WS_MIX);
    const int total = 1024 + (with_ctx ? 128 : 0);
    int idx = vcu; bool in_ctx = false;
    if (idx >= 1024) { idx = 1024 + vcu; in_ctx = true; }
    while (idx < total) {
        ab::AUnit U; int b, kvh, q0; bool latent;
        U.r1 = SEQ;
        if (idx < 1024) { b = idx >> 7; kvh = (idx >> 6) & 1; q0 = 32 * (idx & 63); latent = true;
            int lo = max(0, (q0 - 128) & ~63), hi = min(SEQ, ((q0 + 159) | 63) + 1);
            U.r2 = lo; U.NT = 4 + (hi - lo) / 64; }
        else { const int r = idx - 1024; b = r >> 4; kvh = (r >> 3) & 1; q0 = SEQ + 32 * (r & 7); latent = false; U.r2 = 0; U.NT = 4; }
        const size_t row0 = (size_t)b * RB, qrow = row0 + q0;
        U.Q = P + qrow * LDO + O_Q + 512 * kvh; U.K = P + row0 * LDO + O_K + 64 * kvh; U.V = P + row0 * LDO + O_V + 64 * kvh;
        U.O = MIXp + qrow * 1024 + 512 * kvh; U.q0 = q0; U.sink2 = 0.f; U.sinkv = A->in[I_SINK] + i * 16 + 8 * kvh; U.qgain = nullptr; U.tab = latent ? (const float2*)(A->ws + WS_TAB) : nullptr;
#ifndef NO_ATTC
        { int t_ = tid; asm volatile("" : "+v"(t_)); ab::attn_unit<LDO, 1, 8, true>(U, lds, t_); }
#endif
        if (!in_ctx) { idx += G; if (idx >= 1024) { idx = 1024 + vcu; in_ctx = true; } } else idx += G;
    }
}

#ifndef REPEAT_N
#define REPEAT_N 1
#endif
#ifndef REPEAT_PARITY
#define REPEAT_OK(ph) true
#else
#define REPEAT_OK(ph) ((ph) == 0 || (ph) == N_PHASES - 1 || (((((ph) - 1) / PH_PER_LAYER) & 1) == REPEAT_PARITY))
#endif
#ifndef KSPLIT_DOWN
#define KSPLIT_DOWN 8
#endif
__global__ void __launch_bounds__(NWAVES * 64, 2) fwd(Args A_) {
    extern __shared__ __attribute__((aligned(16))) unsigned char lds[];
    LAS unsigned char* ldsl = (LAS unsigned char*)lds;
    volatile LAS unsigned* MISC = (volatile LAS unsigned*)(ldsl + MISC_OFF);
    for (int u = threadIdx.x; u < (LDS_BYTES - GLA_LDS_BYTES) / 4; u += NWAVES * 64) ((LAS unsigned*)(ldsl + GLA_LDS_BYTES))[u] = 0u;
    __syncthreads();
    const int wave_s = __builtin_amdgcn_readfirstlane(threadIdx.x >> 6);
    const int ph_lo = A_.ph_lo, ph_hi = A_.ph_hi;
    gu32* ctl = (gu32*)(A_.ws + WS_CTL);
    XcdBarrier bar; bar.bar = (unsigned*)(ctl + CW_BAR); bar.x = 0; bar.st = nullptr;
    const bool multi = (ph_hi - ph_lo) > 1;
    if (multi) bar = xcd_barrier_post((unsigned*)(ctl + CW_BAR), MISC + 8);
    int rep_ = 0;
#pragma nounroll
    for (int ph = ph_lo; ph < ph_hi; ++ph) {
        if (!phase_active(ph)) continue;
        ArgP A = (ArgP)__builtin_amdgcn_kernarg_segment_ptr(); asm volatile("" : "+s"(A));
        const int lane = olane(), wave = wave_s, tid = wave * 64 + lane;
        const int G = ogrid(), bx = obid(), vcu = (G % 8 == 0) ? (bx % 8) * (G / 8) + bx / 8 : bx;
        const int gw = vcu * NWAVES + wave, NGW = G * NWAVES;
        if (ph == 0) {
#ifndef NO_P0M
            p0_mods(A, ldsl, 0, 1, vcu, G, tid, lane, wave);
#endif
            __syncthreads();
#ifndef NO_P0W
            conv_layer(A, 0, ldsl, gw, NGW, lane, wave);
#endif
#ifndef NO_P0T
            if (vcu == G - 1) p0_tab(A, tid);
#endif
        } else if (ph == N_PHASES - 1) {
            final_phase(A, gw, NGW, lane);
        } else {
            const int l = (ph - 1) / PH_PER_LAYER, s = (ph - 1) - l * PH_PER_LAYER, i = l >> 1; const bool odd = l & 1, with_ctx = l < DEPTH - 1;
            unsigned char* wl = A->ws + WS_W + w_layer_off(l); const size_t w_in_b = odd ? W_IN_O : W_IN_E;
            const float* mod = (const float*)(A->ws + WS_MOD) + (size_t)l * 9 * 6144;
            if (s == S_NORM1) { cb_layer(A, 0, ldsl, gw, NGW, tid, lane); xg_phase(A, gw, NGW, lane); }
            else if (s == S_G1) {
                pg8::Gemm g{(const pg8::bf16_t*)(A->ws + WS_HN), (const pg8::bf16_t*)wl, M, odd ? LDO : LDE, D, (float*)(A->ws + WS_SLAB), (unsigned*)(A->ws + WS_CTL) + CW_SPLIT + (4 * l + 0) * 2048};
                pg8::RowSched S; S.init(0, odd ? LDO : LDE, G, bx, D);
                rtab_build(S, (const float*)(A->ws + WS_SQ), (LAS float*)(ldsl + RTAB_OFF), tid);
                const fwpost::Ctx pc{(unsigned short*)(A->ws + WS_PROJ), odd ? LDO : LDE, odd ? 0 : 1, A->in[I_QNG] + i * 64, A->in[I_KNG] + i * 64, (const float2*)(A->ws + WS_TAB), (const float*)(A->ws + WS_LR),
                                     (float*)(A->ws + WS_DEC), A->in[I_GKW] + (size_t)i * 2 * 16 * 256, A->in[I_GKB] + (size_t)i * 512};
                pg8::EpiProj E{(pg8::bf16_t*)(A->ws + WS_PROJ), odd ? LDO : LDE, (float*)(A->ws + WS_LR), odd ? -1 : 9, (const LAS float*)(ldsl + RTAB_OFF), (const float*)(A->ws + WS_CB), LDE, &pc, odd ? 4 : 8, odd ? 4 : 8};
#ifndef NO_G1
                pg8::gemm_phase<pg8::EpiProj, pg8::RowSched, true, true>(ldsl, g, S, E, tid);
#endif
            }
            else if (s == S_GLAA) { gla::phase_a(gla_base(A, i), (__attribute__((address_space(3))) char*)ldsl, gw, NGW, wave, lane); }
            else if (s == S_GLAC) { gla::phase_c(gla_base(A, i), (__attribute__((address_space(3))) char*)ldsl, gw, NGW, wave, lane); }
            else if (s == S_MIX) { if (odd) mixer_odd(A, l, with_ctx, (char*)lds, MISC, tid, rep_, vcu, G); else mixer_even(A, l, ldsl, (char*)lds, MISC, tid, rep_); }
            else {
                const bool do_resid = s == S_G2 || s == S_G4 || (s == S_G3 && with_ctx && rep_ == 0), do_up = s == S_G3 || s == S_G3B;
                {
                    const bool down = s == S_G4; const int rows = s == S_G2 ? 1 : (s == S_G3 ? 2 : (with_ctx ? 0 : 1));
                    int t_ = tid; asm volatile("" : "+v"(t_));
                    if (do_resid) {
                        pg8::Gemm g{(const pg8::bf16_t*)(A->ws + (down ? WS_H : WS_MIX)), (const pg8::bf16_t*)(wl + w_in_b + (down ? W_OUT + W_13 : 0)), M, D, down ? FFH : D, (float*)(A->ws + WS_SLAB), (unsigned*)(A->ws + WS_CTL) + CW_SPLIT + (4 * l + (down ? 3 : 1)) * 2048};
                        pg8::RowSched S; S.init(rows, D, G, bx, down ? FFH : D, down ? KSPLIT_DOWN : 1);
#ifdef REPEAT_MASK
                        const bool dry_ = ((REPEAT_MASK >> s) & 1) && rep_ < REPEAT_N && REPEAT_OK(ph) && s != S_G3;
#endif
                        const bool emit = !(down && l + 1 == DEPTH); const int nl = down ? l + 1 : l;
                        const bool last = down && l + 1 == DEPTH;
                        pg8::bf16_t* XB = (pg8::bf16_t*)A->out; pg8::bf16_t* XM = (pg8::bf16_t*)(A->ws + WS_XMID);
                        pg8::bf16_t* xo = last ? (pg8::bf16_t*)(A->ws + WS_HN) : (down ? XB : XM);
#ifdef REPEAT_MASK
                        if (dry_) xo = (pg8::bf16_t*)(A->ws + WS_SLAB);
#endif
                        pg8::EpiResid E{down ? XM : XB, xo, mod + (down ? 5 : 2) * D,
                                        emit, (pg8::bf16_t*)(A->ws + WS_HN), (float*)(A->ws + WS_SQ), (down ? A->in[I_N1G] : A->in[I_N2G]) + (size_t)(emit ? nl : 0) * D,
                                        (const float*)(A->ws + WS_MOD) + (size_t)(emit ? nl : 0) * 9 * 6144 + (down ? 1 : 4) * D, ldsl};
#ifndef NO_G2
                        pg8::gemm_phase<pg8::EpiResid, pg8::RowSched, true, true>(ldsl, g, S, E, t_);
#endif
                        if (down && l + 1 < DEPTH && rep_ == 0) {
                            const int busy = S.sp > 1 ? S.rem * S.sp : (S.rem < G ? S.rem : 0);
                            const bool all = busy >= G || busy == 0, mine = all || bx >= busy;
                            const int ln2 = olane();
                            cb_layer(A, l + 1, ldsl, mine ? (all ? gw : (bx - busy) * NWAVES + wave) : -1, all ? NGW : (G - busy) * NWAVES, wave * 64 + ln2, ln2);
                        }
                    }
                }
                {
                    const int rows = s == S_G3 ? 1 : 2, skew = (s == S_G3 && with_ctx) ? 32 : 0;
                    int t_ = tid; asm volatile("" : "+v"(t_));
                    if (do_up) {
                        pg8::Gemm g{(const pg8::bf16_t*)(A->ws + WS_HN), (const pg8::bf16_t*)(wl + w_in_b + W_OUT), M, 2 * FFH, D, (float*)(A->ws + WS_SLAB), (unsigned*)(A->ws + WS_CTL) + CW_SPLIT + (4 * l + 2) * 2048};
                        pg8::RowSched S; S.init(rows, 2 * FFH, G, bx, D, 1, skew);
                        rtab_build(S, (const float*)(A->ws + WS_SQ), (LAS float*)(ldsl + RTAB_OFF), t_);
                        pg8::EpiSwiglu E{(pg8::bf16_t*)(A->ws + WS_H), FFH, (const LAS float*)(ldsl + RTAB_OFF), (const float*)(A->ws + WS_CB) + (size_t)9 * LDE, 2 * FFH};
#ifndef NO_G3
                        pg8::gemm_phase<pg8::EpiSwiglu, pg8::RowSched, true, true>(ldsl, g, S, E, t_);
#endif
                        if (s == S_G3 && skew > 0 && l + 1 < DEPTH && rep_ == 0 && bx < skew) { const int ln2 = olane(); p0_mods(A, ldsl, l + 1, 1, bx, skew, wave * 64 + ln2, ln2, wave); }
                        if (s == S_G3B && rep_ == 0) {
                            const int busy = S.so.nwg < G ? S.so.nwg : G;
                            const int ln2 = olane();
                            if (busy >= G) conv_layer(A, l + 1, ldsl, gw, NGW, ln2, wave); else if (bx >= busy) conv_layer(A, l + 1, ldsl, (bx - busy) * NWAVES + wave, (G - busy) * NWAVES, ln2, wave);
                        }
                    }
                }
            }
        }
#ifdef REPEAT_BAR
        if (ph + 1 < ph_hi) xcd_barrier(bar, tid == 0);
#endif
#ifdef REPEAT_MASK
        { const int s_ = (ph == 0) ? 12 : (ph == N_PHASES - 1 ? 13 : ((ph - 1) % PH_PER_LAYER)); if (((REPEAT_MASK >> s_) & 1) && rep_ < REPEAT_N && REPEAT_OK(ph)) { ++rep_; --ph; xcd_barrier(bar, tid == 0); continue; } rep_ = 0; }
#endif
        if (ph + 1 < ph_hi) xcd_barrier(bar, tid == 0);
    }
}

inline int grid_size() {
    static int grid = 0;
    if (grid == 0) {
        int dev = 0, cus = 0, per_cu = 0;
        if (hipGetDevice(&dev) != hipSuccess || hipDeviceGetAttribute(&cus, hipDeviceAttributeMultiprocessorCount, dev) != hipSuccess) { grid = -1; return grid; }
        if (hipFuncSetAttribute((const void*)fwd, hipFuncAttributeMaxDynamicSharedMemorySize, LDS_BYTES) != hipSuccess) { grid = -1; return grid; }
        if (hipOccupancyMaxActiveBlocksPerMultiprocessor(&per_cu, (const void*)fwd, NWAVES * 64, LDS_BYTES) != hipSuccess || per_cu < 1) per_cu = 1;
        (void)hipGetLastError();
        grid = cus;
    }
    return grid;
}
inline void launch_phases(hipStream_t st, const Args& a0, int lo, int hi) { Args a = a0; a.ph_lo = lo; a.ph_hi = hi; hipLaunchKernelGGL(fwd, dim3(grid_size()), dim3(NWAVES * 64), LDS_BYTES, st, a); }
inline Args make_args(void* const* d_in, void* d_out, void* d_ws) { Args a{}; for (int i = 0; i < 22; ++i) a.in[i] = (const float*)d_in[i]; a.out = (float*)d_out; a.ws = (unsigned char*)d_ws; return a; }
}
#ifndef MK_PER_PHASE
#define MK_PER_PHASE 1
#endif
extern "C" void kernel_launch(void* const* d_in, const int* in_sizes, int n_in, void* d_out, int out_size, void* d_ws, size_t ws_size, hipStream_t stream) {
    if (fw::grid_size() <= 0 || ws_size < fw::WS_END) return;
    (void)hipMemsetAsync((char*)d_ws + fw::WS_CTL, 0, fw::CTL_ZERO_BYTES, stream);
    const fw::Args a = fw::make_args(d_in, d_out, d_ws);
#if MK_PER_PHASE
    for (int ph = 0; ph < fw::N_PHASES; ++ph) if (fw::phase_active(ph)) fw::launch_phases(stream, a, ph, ph + 1);
#else
    fw::launch_phases(stream, a, 0, fw::N_PHASES);
#endif
}
```

```cpp
#define DOWN_TWO_PASS 1
#define RESID_VIA_LDS 1
#define MK_PER_PHASE 0
#define KSPLIT_DOWN 4
#include <hip/hip_runtime.h>
#include <hip/hip_bf16.h>
#include <cstdio>
#include <cstdint>
#include <cmath>
namespace cfg {
constexpr int D = 1024, NB = 8, SEQ = 2048, CTX = 256, RB = SEQ + CTX  , M = NB * RB  , FFH = 2816;
constexpr int LDE = 2560  , LDO = 1280, DEPTH = 4;
constexpr float EPS = 1e-6f, LOG2E = 1.4426950408889634f, C2 = 0.125f * 1.4426950408889634f;
constexpr int E_GQ = 0, E_GK = 256, E_GV = 512, E_GG = 1024, E_BQ = 1536, E_BK = 2048, E_BV = 2176, E_LR = 2304;
constexpr int O_Q = 0, O_K = 1024, O_V = 1152;
}
__device__ __forceinline__ int olane() { int l; asm volatile("v_mbcnt_lo_u32_b32 %0, -1, 0\n\tv_mbcnt_hi_u32_b32 %0, -1, %0" : "=v"(l)); return l; }
__device__ __forceinline__ int obid() { int b = blockIdx.x; asm volatile("" : "+s"(b)); return b; }
__device__ __forceinline__ int ogrid() { int g = gridDim.x; asm volatile("" : "+s"(g)); return g; }
namespace xl {
template <int CTRL> __device__ __forceinline__ float dpp_mov(float v) { return __builtin_bit_cast(float, __builtin_amdgcn_update_dpp(0, __builtin_bit_cast(int, v), CTRL, 0xf, 0xf, false)); }
__device__ __forceinline__ float xor1(float v) { return dpp_mov<0xB1>(v); }
__device__ __forceinline__ float xor2(float v) { return dpp_mov<0x4E>(v); }
__device__ __forceinline__ float xor16(float v) { return __builtin_bit_cast(float, __builtin_amdgcn_ds_swizzle(__builtin_bit_cast(int, v), 0x401F)); }
__device__ __forceinline__ float add_xor32(float v) { const unsigned u = __builtin_bit_cast(unsigned, v); auto r = __builtin_amdgcn_permlane32_swap(u, u, false, false); return __builtin_bit_cast(float, (unsigned)r[0]) + __builtin_bit_cast(float, (unsigned)r[1]); }
__device__ __forceinline__ float sum8(float v) { v += xor1(v); v += xor2(v); v += dpp_mov<0x141>(v); return v; }
__device__ __forceinline__ float sum16(float v) { v = sum8(v); v += dpp_mov<0x140>(v); return v; }
__device__ __forceinline__ float sum64(float v) { v = sum16(v);
    const int i = __builtin_bit_cast(int, v);
    return (__builtin_bit_cast(float, __builtin_amdgcn_readlane(i, 0)) + __builtin_bit_cast(float, __builtin_amdgcn_readlane(i, 16))) + (__builtin_bit_cast(float, __builtin_amdgcn_readlane(i, 32)) + __builtin_bit_cast(float, __builtin_amdgcn_readlane(i, 48))); }
}
namespace fwpost { struct Ctx; __device__ __forceinline__ void run(const Ctx& c, int pm, int pn, int tid); }
namespace pg8 {
#define PG8_LAS __attribute__((address_space(3)))
typedef unsigned short bf16_t;
typedef short bf16x8 __attribute__((ext_vector_type(8)));
typedef float f32x4 __attribute__((ext_vector_type(4)));
typedef unsigned u32x4 __attribute__((ext_vector_type(4)));
constexpr int BM = 256, BK = 64, HALF = 128, HTB = HALF * BK * 2  , STAGE_BYTES = 8 * HTB, NXCD = 8, WGM = 8;

__host__ __device__ __forceinline__ int lds_byte(int r, int c) { const int st = (r >> 4) * 2 + (c >> 5), rr = r & 15, cc = c & 31, ob = rr * 64 + cc * 2; return st * 1024 + (ob ^ (((ob >> 9) & 1) << 5)); }
__host__ __device__ __forceinline__ void stage_rc(int b, int& R, int& C) { const int st = b / 1024, sb = b % 1024, swz = sb ^ (((sb >> 9) & 1) << 5); R = (st >> 1) * 16 + swz / 64; C = (st & 1) * 32 + (swz % 64) / 2; }
__host__ __device__ __forceinline__ int perm32(int rho) { const int n = rho >> 4, i = rho & 15; return 8 * (i >> 2) + 4 * n + (i & 3); }

struct Unit { int pm, pn; int kt0, nkt, sp, sl, ul, ord; int rl; };
struct Gemm { const bf16_t* A; const bf16_t* Bt; int M, N, K; float* slab; unsigned* cnt; };

struct StaticOrder {
    int nM, nN, nwg, G, c;
    __host__ __device__ void init(int M, int N, int G_, int c_) { nM = M / BM; nN = N / BM; nwg = nM * nN; G = G_; c = c_; }
    __host__ __device__ bool next(int i, Unit& u) const { return at((long)i * G + c, u); }
    __host__ __device__ bool at(const long L, Unit& u) const {
        if (L >= nwg) return false;
        int wgid = (int)L; { const int q = nwg / NXCD, r = nwg % NXCD, xcd = wgid % NXCD, off = wgid / NXCD; wgid = (xcd < r ? xcd * (q + 1) : r * (q + 1) + (xcd - r) * q) + off; }
        const int nig = WGM * nN, gid = wgid / nig, fm = gid * WGM, gsz = (nM - fm) < WGM ? (nM - fm) : WGM;
        u.pm = fm + ((wgid % nig) % gsz); u.pn = (wgid % nig) / gsz; return true;
    }
    __device__ __forceinline__ void a_ready(const Unit&) const {}
    __device__ __forceinline__ void done(const Unit&) const {}
};

__device__ __forceinline__ unsigned cvt_pk_bf16(float lo, float hi) { unsigned r; asm volatile("v_cvt_pk_bf16_f32 %0, %1, %2" : "=v"(r) : "v"(lo), "v"(hi)); return r; }
__device__ __forceinline__ int batch_kind(int pm) { const int b = pm / 9; return (pm - 9 * b) < 8 ? b : 8; }
struct EpiProj {
    static constexpr bool PERM = true, AFTER_DRAIN = false, PAIR = false, CAN_SPLIT = false, RESID_LDS = false; static constexpr int SLAB_W = 256;
    bf16_t* O; int ldc; float* LR; int lr_pn; const PG8_LAS float* rtab; const float* cb; int ncb;
    const fwpost::Ctx* pc; int post_lo, post_hi;
    static constexpr bool HAS_POST = true;
    __device__ __forceinline__ bool needs_post(const Unit& u) const { return u.pn >= post_lo && u.pn <= post_hi; }
    __device__ __forceinline__ void post(const Unit& u, int tid) const { fwpost::run(*pc, u.pm, u.pn, tid); }
    __device__ __forceinline__ void operator()(const f32x4 (&acc)[2][2][4][2], const Unit& u, int wr, int wc, int fr_in, int fq_in) const {
        int fr = fr_in, fq = fq_in; asm volatile("" : "+v"(fr), "+v"(fq));
        const int row0 = u.pm * BM + wr * 64 + fr; const PG8_LAS float* rt = rtab + u.ord * 256 + wr * 64 + fr;
        const int col0 = u.pn * BM + wc * 32 + 8 * fq; const float* cbv = cb + (size_t)batch_kind(u.pm) * ncb + col0;
        if (u.pn == lr_pn) {
            if (wc == 0) { const f32x4 c0 = *(const f32x4*)cbv, c1 = *(const f32x4*)(cbv + 4);
#pragma unroll
                for (int ai = 0; ai < 2; ++ai)
#pragma unroll
                    for (int m = 0; m < 4; ++m) { const float r = rt[ai * HALF + m * 16]; float* p = LR + (size_t)(row0 + ai * HALF + m * 16) * 32 + 8 * fq; *(f32x4*)p = acc[ai][0][m][0] * r + c0; *(f32x4*)(p + 4) = acc[ai][0][m][1] * r + c1; }
            }
            return;
        }
        f32x4 cv[2][2];
#pragma unroll
        for (int bj = 0; bj < 2; ++bj)
#pragma unroll
            for (int n = 0; n < 2; ++n) cv[bj][n] = *(const f32x4*)(cbv + bj * HALF + 4 * n);
#pragma unroll
        for (int ai = 0; ai < 2; ++ai)
#pragma unroll
            for (int m = 0; m < 4; ++m) { bf16_t* rowp = O + (size_t)(row0 + ai * HALF + m * 16) * ldc + col0; const float r = rt[ai * HALF + m * 16];
#pragma unroll
                for (int bj = 0; bj < 2; ++bj) { const f32x4 v0 = acc[ai][bj][m][0] * r + cv[bj][0], v1 = acc[ai][bj][m][1] * r + cv[bj][1];
                    u32x4 w; w.x = cvt_pk_bf16(v0[0], v0[1]); w.y = cvt_pk_bf16(v0[2], v0[3]); w.z = cvt_pk_bf16(v1[0], v1[1]); w.w = cvt_pk_bf16(v1[2], v1[3]);
                    *(u32x4*)(rowp + bj * HALF) = w; } }
    }
};
__device__ __forceinline__ float silu_mul(float a, float b) { return a * __builtin_amdgcn_rcpf(1.f + __builtin_amdgcn_exp2f(-1.4426950408889634f * a)) * b; }
__device__ __forceinline__ f32x4 silu_mul4(const f32x4 a, const f32x4 b) {
    const f32x4 t = a * -1.4426950408889634f; f32x4 e;
    e[0] = __builtin_amdgcn_exp2f(t[0]); e[1] = __builtin_amdgcn_exp2f(t[1]); e[2] = __builtin_amdgcn_exp2f(t[2]); e[3] = __builtin_amdgcn_exp2f(t[3]);
    const f32x4 d = e + 1.f; f32x4 r;
    r[0] = __builtin_amdgcn_rcpf(d[0]); r[1] = __builtin_amdgcn_rcpf(d[1]); r[2] = __builtin_amdgcn_rcpf(d[2]); r[3] = __builtin_amdgcn_rcpf(d[3]);
    return (a * b) * r;
}
struct EpiSwiglu {
    static constexpr bool PERM = true, AFTER_DRAIN = false, PAIR = true, CAN_SPLIT = false, RESID_LDS = false; static constexpr int SLAB_W = 128;
    bf16_t* H; int ldh; const PG8_LAS float* rtab; const float* cb; int ncb;
    static constexpr bool HAS_POST = false;
    __device__ __forceinline__ void operator()(const f32x4 (&acc)[2][2][4][2], const Unit& u, int wr, int wc, int fr_in, int fq_in) const {
        int fr = fr_in, fq = fq_in; asm volatile("" : "+v"(fr), "+v"(fq));
        const int row0 = u.pm * BM + wr * 64 + fr, col0 = u.pn * HALF + wc * 32 + 8 * fq; const PG8_LAS float* rt = rtab + u.ord * 256 + wr * 64 + fr;
        const float* cbv = cb + (size_t)batch_kind(u.pm) * ncb + u.pn * BM + wc * 32 + 8 * fq;
        const f32x4 ca0 = *(const f32x4*)cbv, ca1 = *(const f32x4*)(cbv + 4), cb0 = *(const f32x4*)(cbv + HALF), cb1 = *(const f32x4*)(cbv + HALF + 4);
#pragma unroll
        for (int ai = 0; ai < 2; ++ai)
#pragma unroll
            for (int m = 0; m < 4; ++m) { const float r = rt[ai * HALF + m * 16];
                const f32x4 a0 = acc[ai][0][m][0] * r + ca0, a1 = acc[ai][0][m][1] * r + ca1, b0 = acc[ai][1][m][0] * r + cb0, b1 = acc[ai][1][m][1] * r + cb1;
                const f32x4 s0 = silu_mul4(a0, b0), s1 = silu_mul4(a1, b1);
                u32x4 w; w.x = cvt_pk_bf16(s0[0], s0[1]); w.y = cvt_pk_bf16(s0[2], s0[3]); w.z = cvt_pk_bf16(s1[0], s1[1]); w.w = cvt_pk_bf16(s1[2], s1[3]);
                *(u32x4*)(H + (size_t)(row0 + ai * HALF + m * 16) * ldh + col0) = w; }
    }
};
#ifndef RESID_GRP
#define RESID_GRP 2
#endif
struct EpiResid {
#ifdef RESID_VIA_LDS
    static constexpr bool PERM = true, AFTER_DRAIN = false, PAIR = false, CAN_SPLIT = true, RESID_LDS = true; static constexpr int SLAB_W = 256;
#else
    static constexpr bool PERM = true, AFTER_DRAIN = false, PAIR = false, CAN_SPLIT = true, RESID_LDS = false; static constexpr int SLAB_W = 256;
#endif
    const bf16_t* xin_b; bf16_t* xout_b; const float* gate_base;
    bool emit; bf16_t* XG; float* SQ; const float* ngain; const float* nscale_base;
    const PG8_LAS unsigned char* ring;
    __device__ __forceinline__ const char* res_base(const Unit& u) const { return (const char*)(xin_b + (size_t)u.pm * BM * 1024 + u.pn * BM); }
    __device__ __forceinline__ static constexpr int rbuf(int g) { return (g == 0 ? 4 : g == 1 ? 5 : g == 2 ? 0 : g == 3 ? 1 : g == 4 ? 6 : g == 5 ? 7 : 2) * HTB; }
    static constexpr bool HAS_POST = false;
    typedef unsigned u32x2 __attribute__((ext_vector_type(2)));
    __device__ __forceinline__ static f32x4 up4(unsigned a, unsigned b) { return (f32x4){__builtin_bit_cast(float, a << 16), __builtin_bit_cast(float, a & 0xffff0000u), __builtin_bit_cast(float, b << 16), __builtin_bit_cast(float, b & 0xffff0000u)}; }
    __device__ __forceinline__ void slab(const Unit& u, int row, int c, const f32x4 v, const f32x4) const {
        const int bk = batch_kind(u.pm); const int col = u.pn * BM + c; const size_t m = (size_t)u.pm * BM + row;
        const u32x2 w = *(const u32x2*)(xin_b + m * 1024 + col);
        const f32x4 xn = up4(w[0], w[1]) + *(const f32x4*)(gate_base + 6144 * bk + col) * v;
        *(u32x2*)(xout_b + m * 1024 + col) = (u32x2){cvt_pk_bf16(xn[0], xn[1]), cvt_pk_bf16(xn[2], xn[3])};
        if (emit) {
            const f32x4 gv = *(const f32x4*)(ngain + col) * (*(const f32x4*)(nscale_base + 6144 * bk + col) + 1.f), xg = xn * gv;
            *(u32x2*)(XG + m * 1024 + col) = (u32x2){cvt_pk_bf16(xg[0], xg[1]), cvt_pk_bf16(xg[2], xg[3])};
            float ss = (xn[0] * xn[0] + xn[1] * xn[1]) + (xn[2] * xn[2] + xn[3] * xn[3]);
            ss = xl::sum64(ss);
            if (c < 16) SQ[m * 16 + u.pn * 4 + (c >> 2)] = (c == 0) ? ss : 0.f;
        }
    }
    __device__ __forceinline__ void operator()(const f32x4 (&acc)[2][2][4][2], const Unit& u, int wr, int wc, int fr_in, int fq_in) const {
        int fr = fr_in, fq = fq_in; asm volatile("" : "+v"(fr), "+v"(fq));
        const int bk = batch_kind(u.pm);
        const int col0 = u.pn * BM + wc * 32 + 8 * fq;
        const bf16_t* xib = xin_b + (size_t)u.pm * BM * 1024 + col0; bf16_t* xob = xout_b + (size_t)u.pm * BM * 1024 + col0;
        const float* gate = gate_base + 6144 * bk + col0;
        f32x4 gv[2][2], nv[2][2];
#pragma unroll
        for (int bj = 0; bj < 2; ++bj)
#pragma unroll
            for (int n = 0; n < 2; ++n) { gv[bj][n] = *(const f32x4*)(gate + bj * HALF + n * 4);
                if (emit) nv[bj][n] = *(const f32x4*)(ngain + col0 + bj * HALF + n * 4) * (*(const f32x4*)(nscale_base + 6144 * bk + col0 + bj * HALF + n * 4) + 1.f); }
        bf16_t* xg = XG + (size_t)u.pm * BM * 1024 + col0; float* sq = SQ + (size_t)u.pm * BM * 16 + u.pn * 4 + wc;
        u32x4 x7[2]; x7[0] = (u32x4){0u, 0u, 0u, 0u}; x7[1] = x7[0];
        if (RESID_LDS && u.rl) {
#pragma unroll
            for (int bj = 0; bj < 2; ++bj) x7[bj] = *(const u32x4*)(xib + (size_t)(HALF + wr * 64 + 48 + fr) * 1024 + bj * HALF); }
#pragma unroll
        for (int q0 = 0; q0 < 8; q0 += RESID_GRP) {
            u32x4 xv[RESID_GRP][2];
#pragma unroll
            for (int q = 0; q < RESID_GRP; ++q) { const int ai = (q0 + q) >> 2, m = (q0 + q) & 3; const size_t ro = (size_t)(ai * HALF + wr * 64 + m * 16 + fr) * 1024;
                if (RESID_LDS && u.rl) {
#pragma unroll
                    for (int bj = 0; bj < 2; ++bj) xv[q][bj] = q0 + q < 7 ? *(const PG8_LAS u32x4*)(ring + rbuf(q0 + q < 7 ? q0 + q : 0) + (wr * 16 + fr) * 512 + (((wc * 4 + fq + bj * 16) ^ fr) * 16)) : x7[bj];
                } else {
#pragma unroll
                    for (int bj = 0; bj < 2; ++bj) xv[q][bj] = *(const u32x4*)(xib + ro + bj * HALF); } }
#pragma unroll
            for (int q = 0; q < RESID_GRP; ++q) { const int ai = (q0 + q) >> 2, m = (q0 + q) & 3; const int rt = ai * HALF + wr * 64 + m * 16 + fr; const size_t ro = (size_t)rt * 1024; float ss = 0.f;
#pragma unroll
                for (int bj = 0; bj < 2; ++bj) { const f32x4 x0 = up4(xv[q][bj][0], xv[q][bj][1]) + gv[bj][0] * acc[ai][bj][m][0], x1 = up4(xv[q][bj][2], xv[q][bj][3]) + gv[bj][1] * acc[ai][bj][m][1];
                    *(u32x4*)(xob + ro + bj * HALF) = (u32x4){cvt_pk_bf16(x0[0], x0[1]), cvt_pk_bf16(x0[2], x0[3]), cvt_pk_bf16(x1[0], x1[1]), cvt_pk_bf16(x1[2], x1[3])};
                    if (emit) { const f32x4 y0 = x0 * nv[bj][0], y1 = x1 * nv[bj][1];
                        *(u32x4*)(xg + ro + bj * HALF) = (u32x4){cvt_pk_bf16(y0[0], y0[1]), cvt_pk_bf16(y0[2], y0[3]), cvt_pk_bf16(y1[0], y1[1]), cvt_pk_bf16(y1[2], y1[3])};
                        ss += ((x0[0] * x0[0] + x0[1] * x0[1]) + (x0[2] * x0[2] + x0[3] * x0[3])) + ((x1[0] * x1[0] + x1[1] * x1[1]) + (x1[2] * x1[2] + x1[3] * x1[3])); } }
                if (emit) { ss += xl::xor16(ss); ss = xl::add_xor32(ss); if (fq == 0) sq[(size_t)rt * 16] = ss; } }
            asm volatile("" ::: "memory");
        }
    }
};
struct RowSched {
    StaticOrder so; int mode; int G, c, R, rem, sp, npairs, skew, lead, a; int i_lo = 0, i_hi = 0x7fffffff;
    __device__ void init(int mode_, int N, int G_, int c_, int K, int max_sp = 1, int skew_ = 0) {
        mode = mode_; so.init((mode_ == 0 ? 72 : (mode_ == 1 ? 64 : 8)) * BM, N, G_, c_); G = G_; c = c_; npairs = K / (2 * BK); skew = skew_;
        R = (so.nwg + G - 1) / G; rem = so.nwg - (R - 1) * G; sp = rem < G ? G / rem : 1; if (sp > max_sp) sp = max_sp; if (sp > npairs) sp = npairs; if (sp < 2) sp = 1;
        a = R; lead = 0; if (skew > 0) { const int left = so.nwg - a * (G - skew); lead = left > 0 ? (left + skew - 1) / skew : 0; sp = 1; }
#ifdef NO_KSPLIT
        sp = 1;
#endif
    }
    __device__ __forceinline__ bool next(int i_, Unit& u) const {
        const int i = i_ + i_lo; if (i >= i_hi) return false;
        u.kt0 = 0; u.nkt = 2 * npairs; u.sp = 1; u.sl = 0; u.ul = 0; u.ord = i; u.rl = 0;
        if (skew > 0) {
            long L;
            if (c >= skew) { if (i >= a) return false; L = (long)i * (G - skew) + (c - skew); if (L >= (long)a * (G - skew)) return false; }
            else { if (i >= lead) return false; L = (long)a * (G - skew) + (long)c * lead + i; }
            if (!so.at(L, u)) return false;
        } else if (i < R - 1 || sp == 1) { if (!so.next(i, u)) return false; }
        else { if (i > R - 1 || c >= rem * sp) return false;
            const int sl = c / rem, ul = c - sl * rem; if (!so.at((long)(R - 1) * G + ul, u)) return false;
            const int base = npairs / sp, extra = npairs - base * sp;
            u.sp = sp; u.sl = sl; u.ul = ul; u.kt0 = 2 * (sl * base + (sl < extra ? sl : extra)); u.nkt = 2 * (base + (sl < extra ? 1 : 0)); }
        if (mode == 1) u.pm += u.pm >> 3; else if (mode == 2) u.pm = 9 * u.pm + 8;
        return true; }
    __device__ __forceinline__ void a_ready(const Unit&) const {}
    __device__ __forceinline__ void done(const Unit&) const {}
};
__device__ __forceinline__ void st_sc1(float* p, const f32x4 v) { asm volatile("global_store_dwordx4 %0, %1, off sc1\n\ts_nop 1" :: "v"(p), "v"(v) : "memory"); }
template <class Epi, int SP> __device__ __forceinline__ void split_reduce(const Unit& u, const Epi& E, const float* s0, int tid) {
    const int r0 = (256 * u.sl) / SP, r1 = (256 * (u.sl + 1)) / SP; constexpr int CW = Epi::SLAB_W / 4;
    for (int idx = tid; idx < (r1 - r0) * CW; idx += 512) {
        const int row = r0 + idx / CW, c = (idx % CW) * 4; const float* p = s0 + (size_t)row * 256 + c;
        f32x4 a = (f32x4){0.f, 0.f, 0.f, 0.f}, b = (f32x4){0.f, 0.f, 0.f, 0.f};
#pragma unroll
        for (int s = 0; s < SP; ++s) { a += *(const f32x4*)(p + (size_t)s * 65536); if (Epi::PAIR) b += *(const f32x4*)(p + (size_t)s * 65536 + 128); }
        E.slab(u, row, c, a, b);
    }
}
template <class Epi> __device__ __forceinline__ void split_epilogue(const f32x4 (&acc)[2][2][4][2], const Unit& u, const Epi& E, const Gemm& g, int tid, int wr, int wc, int fr, int fq) {
    float* s0 = g.slab + (size_t)u.ul * u.sp * 65536; float* my = s0 + (size_t)u.sl * 65536;
#pragma unroll
    for (int ai = 0; ai < 2; ++ai)
#pragma unroll
        for (int m = 0; m < 4; ++m) { float* rp = my + (size_t)(ai * HALF + wr * 64 + m * 16 + fr) * 256 + wc * 32;
#pragma unroll
            for (int bj = 0; bj < 2; ++bj)
#pragma unroll
                for (int n = 0; n < 2; ++n) st_sc1(rp + bj * HALF + (Epi::PERM ? 8 * fq + 4 * n : 16 * n + 4 * fq), acc[ai][bj][m][n]); }
    asm volatile("s_waitcnt vmcnt(0)" ::: "memory");
    __syncthreads();
    if (tid == 0) {
        unsigned* cw = g.cnt + 16 * u.ul;
        __hip_atomic_fetch_add(cw, 1u, __ATOMIC_RELAXED, __HIP_MEMORY_SCOPE_AGENT);
        unsigned spin = 0;
        while (__hip_atomic_load(cw, __ATOMIC_RELAXED, __HIP_MEMORY_SCOPE_AGENT) < (unsigned)u.sp) { __builtin_amdgcn_s_sleep(2); if (++spin > (1u << 22)) break; }
        __builtin_amdgcn_fence(__ATOMIC_ACQUIRE, "agent");
        asm volatile("s_waitcnt vmcnt(0)" ::: "memory");
    }
    __syncthreads();
    switch (u.sp) {
        case 2: split_reduce<Epi, 2>(u, E, s0, tid); break; case 3: split_reduce<Epi, 3>(u, E, s0, tid); break; case 4: split_reduce<Epi, 4>(u, E, s0, tid); break; case 5: split_reduce<Epi, 5>(u, E, s0, tid); break;
        case 6: split_reduce<Epi, 6>(u, E, s0, tid); break; case 7: split_reduce<Epi, 7>(u, E, s0, tid); break; default: split_reduce<Epi, 8>(u, E, s0, tid); break; }
}
template <class Epi, class Sched, bool ALIGN_EPI = false, bool SP2 = false>
__device__ __forceinline__ void gemm_phase(PG8_LAS unsigned char* lds, const Gemm g, const Sched& S, const Epi& E, const int tid) {
    const int wid = __builtin_amdgcn_readfirstlane(tid >> 6), lane = tid & 63, wr = wid >> 2, wc = wid & 3, fr = lane & 15, fq = lane >> 4;
    const int K = g.K;
    unsigned voffA[2], voffB[2];
#pragma unroll
    for (int i = 0; i < 2; ++i) { int R, C; stage_rc(tid * 16 + i * 8192, R, C); const int Rb = Epi::PERM ? ((R & ~31) + perm32(R & 31)) : R;
        voffA[i] = (unsigned)(R * K + C) * 2u; voffB[i] = (unsigned)(Rb * K + C) * 2u; }
    unsigned voffR[2]; { const int frl = wid * 2 + (lane >> 5), Lc = (lane & 31) ^ frl; voffR[0] = (unsigned)(frl * 2048 + Lc * 16); voffR[1] = (unsigned)((frl + 64) * 2048 + Lc * 16); }
    static_assert(!Epi::RESID_LDS || SP2, "the residual staging is written for the SP2 loop");
    const size_t kstep = (size_t)(BK * 2);
    const size_t hstep = (size_t)HALF * K * 2;
    const size_t tstep = 2 * hstep;
    const unsigned ldsw = (unsigned)wid * 1024u;
    const int aoff = lds_byte(wr * 64 + fr, fq * 8), boff = lds_byte(wc * 32 + fr, fq * 8);
#define PG8_SA(b, h) (((b) * 2 + (h)) * HTB)
#define PG8_SB(b, h) ((4 + (b) * 2 + (h)) * HTB)
#define PG8_STAGE(bufoff, gbase, voff) do { _Pragma("unroll") for (int _i = 0; _i < 2; ++_i) \
        __builtin_amdgcn_global_load_lds((const unsigned*)((const char*)(gbase) + (voff)[_i]), (PG8_LAS unsigned*)(lds + (bufoff) + ldsw + _i * 8192), 16, 0, 0); } while (0)
#define PG8_LDA(dst, b, h) do { _Pragma("unroll") for (int m = 0; m < 4; ++m) _Pragma("unroll") for (int k = 0; k < 2; ++k) dst[m][k] = *(const PG8_LAS bf16x8*)(lds + PG8_SA(b, h) + aoff + m * 2048 + k * 1024); } while (0)
#define PG8_LDB(dst, b, h) do { _Pragma("unroll") for (int n = 0; n < 2; ++n) _Pragma("unroll") for (int k = 0; k < 2; ++k) dst[n][k] = *(const PG8_LAS bf16x8*)(lds + PG8_SB(b, h) + boff + n * 2048 + k * 1024); } while (0)
#define PG8_MMA(ai, bj, At, Bt) do { __builtin_amdgcn_s_setprio(1); _Pragma("unroll") for (int m = 0; m < 4; ++m) _Pragma("unroll") for (int n = 0; n < 2; ++n) _Pragma("unroll") for (int k = 0; k < 2; ++k) \
        acc[ai][bj][m][n] = __builtin_amdgcn_mfma_f32_16x16x32_bf16(Bt[n][k], At[m][k], acc[ai][bj][m][n], 0, 0, 0); __builtin_amdgcn_s_setprio(0); } while (0)
#define PG8_WAIT_V(n) asm volatile("s_waitcnt vmcnt(" #n ")" ::: "memory")
#define PG8_WAIT_L(n) asm volatile("s_waitcnt lgkmcnt(" #n ")" ::: "memory")
#define PG8_BAR __builtin_amdgcn_s_barrier()
#define PG8_SCHED __builtin_amdgcn_sched_barrier(0)
    Unit cur, nxt; int ui = 0;
    if (!S.next(0, cur)) return;
    f32x4 acc[2][2][4][2];
#pragma unroll
    for (int a = 0; a < 2; ++a)
#pragma unroll
        for (int b = 0; b < 2; ++b)
#pragma unroll
            for (int m = 0; m < 4; ++m)
#pragma unroll
                for (int n = 0; n < 2; ++n) acc[a][b][m][n] = (f32x4){0.f, 0.f, 0.f, 0.f};
    bf16x8 At[4][2], B0[2][2], B1[2][2];
    const char* cA = (const char*)g.A + (size_t)cur.pm * tstep + (size_t)cur.kt0 * kstep; const char* cB = (const char*)g.Bt + (size_t)cur.pn * tstep + (size_t)cur.kt0 * kstep;
    S.a_ready(cur);
    if constexpr (SP2) {
        PG8_STAGE(PG8_SB(0, 0), cB, voffB); PG8_STAGE(PG8_SB(0, 1), cB + hstep, voffB); PG8_STAGE(PG8_SA(0, 0), cA, voffA); PG8_STAGE(PG8_SA(0, 1), cA + hstep, voffA);
        if (wr == 1) PG8_BAR;
        PG8_WAIT_V(2); PG8_BAR;
        PG8_STAGE(PG8_SB(1, 0), cB + kstep, voffB); PG8_STAGE(PG8_SA(1, 0), cA + kstep, voffA); PG8_STAGE(PG8_SB(1, 1), cB + hstep + kstep, voffB);
        PG8_WAIT_V(6); PG8_BAR;
    } else {
        PG8_STAGE(PG8_SB(0, 0), cB, voffB); PG8_STAGE(PG8_SA(0, 0), cA, voffA); PG8_STAGE(PG8_SB(0, 1), cB + hstep, voffB); PG8_STAGE(PG8_SA(0, 1), cA + hstep, voffA);
        if (wr == 1) PG8_BAR;
        PG8_WAIT_V(4); PG8_BAR;
        PG8_STAGE(PG8_SB(1, 0), cB + kstep, voffB); PG8_STAGE(PG8_SA(1, 0), cA + kstep, voffA); PG8_STAGE(PG8_SB(1, 1), cB + hstep + kstep, voffB);
        PG8_WAIT_V(6); PG8_BAR;
    }
    for (;;) {
        const bool has_next = S.next(ui + 1, nxt);
        const char* nA = has_next ? (const char*)g.A + (size_t)nxt.pm * tstep + (size_t)nxt.kt0 * kstep : cA; const char* nB = has_next ? (const char*)g.Bt + (size_t)nxt.pn * tstep + (size_t)nxt.kt0 * kstep : cB;
        const int nt = cur.nkt;
        const bool rlu = Epi::RESID_LDS && !has_next && cur.sp == 1;
        const char* rbase = nullptr; if constexpr (Epi::RESID_LDS) { rbase = E.res_base(cur); }
        for (int t = 0; t < nt; t += 2) {
            const bool last = (t == nt - 2);
            const char* a1 = cA + (size_t)(t + 1) * kstep;
            const char* a2 = last ? nA : cA + (size_t)(t + 2) * kstep; const char* b2 = last ? nB : cB + (size_t)(t + 2) * kstep;
            const char* a3 = a2 + kstep; const char* b3 = b2 + kstep;
            if (last && has_next) S.a_ready(nxt);
            const bool rll = Epi::RESID_LDS && last && rlu;
            const char* p_b00 = rll ? rbase : b2;                         const char* p_b01 = rll ? rbase + (size_t)16 * 2048 : b2 + hstep;
            const char* p_a00 = rll ? rbase + (size_t)32 * 2048 : a2;     const char* p_a01 = rll ? rbase + (size_t)48 * 2048 : a2 + hstep;
            const char* p_b10 = rll ? rbase + (size_t)128 * 2048 : b3;    const char* p_b11 = rll ? rbase + (size_t)144 * 2048 : b3 + hstep;
            const char* p_a10 = rll ? rbase + (size_t)160 * 2048 : a3;
            unsigned vA2[2] = {rll ? voffR[0] : voffA[0], rll ? voffR[1] : voffA[1]}, vB2[2] = {rll ? voffR[0] : voffB[0], rll ? voffR[1] : voffB[1]};
            if constexpr (SP2) {
            PG8_LDB(B0, 0, 0); PG8_LDB(B1, 0, 1); PG8_SCHED; PG8_LDA(At, 0, 0); PG8_STAGE(PG8_SA(1, 1), a1 + hstep, voffA);
            PG8_WAIT_V(8); PG8_WAIT_L(0); PG8_BAR; PG8_MMA(0, 0, At, B0); PG8_MMA(0, 1, At, B1); PG8_BAR; PG8_SCHED;
            PG8_LDA(At, 0, 1); PG8_STAGE(PG8_SB(0, 0), p_b00, vB2); PG8_STAGE(PG8_SB(0, 1), p_b01, vB2); PG8_STAGE(PG8_SA(0, 0), p_a00, vA2);
            PG8_WAIT_V(8); PG8_WAIT_L(0); PG8_BAR; PG8_MMA(1, 0, At, B0); PG8_MMA(1, 1, At, B1); PG8_BAR; PG8_SCHED;
            PG8_LDB(B0, 1, 0); PG8_LDB(B1, 1, 1); PG8_SCHED; PG8_LDA(At, 1, 0); PG8_STAGE(PG8_SA(0, 1), p_a01, vA2);
            PG8_WAIT_V(8); PG8_WAIT_L(0); PG8_BAR; PG8_MMA(0, 0, At, B0); PG8_MMA(0, 1, At, B1); PG8_BAR; PG8_SCHED;
            PG8_LDA(At, 1, 1); PG8_STAGE(PG8_SB(1, 0), p_b10, vB2); PG8_STAGE(PG8_SB(1, 1), p_b11, vB2); PG8_STAGE(PG8_SA(1, 0), p_a10, vA2);
            PG8_WAIT_V(8); PG8_WAIT_L(0); PG8_BAR; PG8_MMA(1, 0, At, B0); PG8_MMA(1, 1, At, B1); PG8_BAR; PG8_SCHED;
            } else {
            PG8_LDB(B0, 0, 0); PG8_SCHED; PG8_LDA(At, 0, 0); PG8_STAGE(PG8_SA(1, 1), a1 + hstep, voffA);
            PG8_WAIT_L(8); PG8_BAR; PG8_WAIT_L(0); PG8_MMA(0, 0, At, B0); PG8_BAR; PG8_SCHED;
            PG8_LDB(B1, 0, 1); PG8_STAGE(PG8_SB(0, 0), b2, voffB);
            PG8_BAR; PG8_WAIT_L(0); PG8_MMA(0, 1, At, B1); PG8_BAR;
            PG8_LDA(At, 0, 1); PG8_STAGE(PG8_SA(0, 0), a2, voffA);
            PG8_BAR; PG8_WAIT_L(0); PG8_MMA(1, 0, At, B0); PG8_BAR; PG8_SCHED;
            PG8_STAGE(PG8_SB(0, 1), b2 + hstep, voffB);
            PG8_WAIT_V(6); PG8_BAR; PG8_MMA(1, 1, At, B1); PG8_BAR;
            PG8_LDB(B0, 1, 0); PG8_SCHED; PG8_LDA(At, 1, 0); PG8_STAGE(PG8_SA(0, 1), a2 + hstep, voffA);
            PG8_WAIT_L(8); PG8_BAR; PG8_WAIT_L(0); PG8_MMA(0, 0, At, B0); PG8_BAR; PG8_SCHED;
            PG8_LDB(B1, 1, 1); PG8_STAGE(PG8_SB(1, 0), b3, voffB);
            PG8_BAR; PG8_WAIT_L(0); PG8_MMA(0, 1, At, B1); PG8_BAR;
            PG8_LDA(At, 1, 1); PG8_STAGE(PG8_SA(1, 0), a3, voffA);
            PG8_BAR; PG8_WAIT_L(0); PG8_MMA(1, 0, At, B0); PG8_BAR; PG8_SCHED;
            PG8_STAGE(PG8_SB(1, 1), b3 + hstep, voffB);
            PG8_WAIT_V(6); PG8_BAR; PG8_MMA(1, 1, At, B1); PG8_BAR;
            }
        }
        if constexpr (ALIGN_EPI) { if (wr == 0) PG8_BAR; }
        if constexpr (Epi::RESID_LDS) { static_assert(!Epi::RESID_LDS || ALIGN_EPI, "both halves must be aligned here"); if (rlu) { PG8_WAIT_V(0); PG8_BAR; } cur.rl = rlu ? 1 : 0; }
        if constexpr (!Epi::AFTER_DRAIN) { if (!Epi::CAN_SPLIT || cur.sp == 1) { E(acc, cur, wr, wc, fr, fq);
            if constexpr (Epi::HAS_POST) { if (E.needs_post(cur)) { asm volatile("s_waitcnt vmcnt(0)" ::: "memory"); PG8_BAR; asm volatile("" ::: "memory"); E.post(cur, wid * 64 + olane()); } }
            S.done(cur); } }
        if (!has_next) break;
#pragma unroll
        for (int a = 0; a < 2; ++a)
#pragma unroll
            for (int b = 0; b < 2; ++b)
#pragma unroll
                for (int m = 0; m < 4; ++m)
#pragma unroll
                    for (int n = 0; n < 2; ++n) acc[a][b][m][n] = (f32x4){0.f, 0.f, 0.f, 0.f};
        cur = nxt; cA = nA; cB = nB; ++ui;
        if constexpr (ALIGN_EPI) { if (wr == 1) PG8_BAR; }
    }
    PG8_WAIT_V(0);
    if constexpr (!ALIGN_EPI) { if (wr == 0) PG8_BAR; }
    PG8_BAR;
    if constexpr (Epi::AFTER_DRAIN) { E.fused(acc, cur, wr, wc, fr, fq, lds, wid, lane); S.done(cur); }
    else if constexpr (Epi::CAN_SPLIT) { if (cur.sp > 1) { split_epilogue<Epi>(acc, cur, E, g, wid * 64 + olane(), wr, wc, fr, fq); S.done(cur); } }
#undef PG8_SA
#undef PG8_SB
#undef PG8_STAGE
#undef PG8_LDA
#undef PG8_LDB
#undef PG8_MMA
#undef PG8_WAIT_V
#undef PG8_WAIT_L
#undef PG8_BAR
#undef PG8_SCHED
}
}
namespace ab {
using bf16=__hip_bfloat16;
using bf16x8=__attribute__((ext_vector_type(8)))short;
using s16x4=__attribute__((ext_vector_type(4)))short;
using f32x16=__attribute__((ext_vector_type(16)))float;
using u32x4=__attribute__((ext_vector_type(4)))unsigned;
constexpr int D=64;
constexpr int NW=8,QBLK=32,QB=QBLK*NW,KVBLK=64;
__device__ __forceinline__ int crow(int r,int hi){return (r&3)+8*(r>>2)+4*hi;}
#define SBAR() __builtin_amdgcn_sched_barrier(0)
constexpr int NSLOT=3, SLOTB=8192;
constexpr int LDS_K=0, LDS_V=NSLOT*SLOTB, LDS_WS=2*NSLOT*SLOTB, LDS_OST=LDS_WS+NW*64*4, LDS_BYTES=LDS_OST+NW*4096;
constexpr float C2=0.125f*1.4426950408889634f;
__device__ __forceinline__ void glds16(const void*gsrc,unsigned lds_dst){unsigned keep;
  asm volatile("s_mov_b32 %0, m0\n\ts_mov_b32 m0, %2\n\ts_nop 0\n\tglobal_load_lds_dwordx4 %1, off\n\ts_mov_b32 m0, %0":"=&s"(keep):"v"(gsrc),"s"(lds_dst):"memory");}
__device__ __forceinline__ float max3f(float a,float b,float c){float r;asm("v_max3_f32 %0, %1, %2, %3":"=v"(r):"v"(a),"v"(b),"v"(c));return r;}
__device__ __forceinline__ float max2f(float a,float b){float r;asm("v_max_f32_e32 %0, %1, %2":"=v"(r):"v"(a),"v"(b));return r;}
__device__ __forceinline__ float fadd_s(float a,float b){float r;asm("v_add_f32_e32 %0, %1, %2":"=v"(r):"v"(a),"v"(b));return r;}
__device__ __forceinline__ float fsub_s(float a,float b){float r;asm("v_sub_f32_e32 %0, %1, %2":"=v"(r):"v"(a),"v"(b));return r;}
typedef float f32x2_t __attribute__((ext_vector_type(2))); typedef __bf16 bf16x2_t __attribute__((ext_vector_type(2)));
__device__ __forceinline__ unsigned cvtpk_s(float lo,float hi){f32x2_t v={lo,hi};bf16x2_t b=__builtin_convertvector(v,bf16x2_t);return __builtin_bit_cast(unsigned,b);}
#define WAIT_BAR(N) asm volatile("s_waitcnt vmcnt(" #N ") lgkmcnt(0)\n\ts_barrier":::"memory")

__device__ __forceinline__ void qkt(f32x16&p0,f32x16&p1,const char*Kslot,const bf16x8*qr,const f32x16&negm,int r32,int hi){
  const char*kb=Kslot+hi*1024+r32*16;
  #pragma unroll
  for(int d0=0;d0<4;++d0){
    const bf16x8 b0=*reinterpret_cast<const bf16x8*>(kb+d0*2048);
    const bf16x8 b1=*reinterpret_cast<const bf16x8*>(kb+d0*2048+512);
    if(d0==0){p0=__builtin_amdgcn_mfma_f32_32x32x16_bf16(b0,qr[0],negm,0,0,0);p1=__builtin_amdgcn_mfma_f32_32x32x16_bf16(b1,qr[0],negm,0,0,0);}
    else{p0=__builtin_amdgcn_mfma_f32_32x32x16_bf16(b0,qr[d0],p0,0,0,0);p1=__builtin_amdgcn_mfma_f32_32x32x16_bf16(b1,qr[d0],p1,0,0,0);}}
}
typedef __attribute__((address_space(3))) const char* lds_cptr;
typedef short v4i16_t __attribute__((ext_vector_type(4)));
__device__ __forceinline__ void kload8(bf16x8*kf,lds_cptr kp){
  kf[0]=*(const __attribute__((address_space(3))) bf16x8*)(kp);      kf[1]=*(const __attribute__((address_space(3))) bf16x8*)(kp+512);
  kf[2]=*(const __attribute__((address_space(3))) bf16x8*)(kp+2048); kf[3]=*(const __attribute__((address_space(3))) bf16x8*)(kp+2560);
  kf[4]=*(const __attribute__((address_space(3))) bf16x8*)(kp+4096); kf[5]=*(const __attribute__((address_space(3))) bf16x8*)(kp+4608);
  kf[6]=*(const __attribute__((address_space(3))) bf16x8*)(kp+6144); kf[7]=*(const __attribute__((address_space(3))) bf16x8*)(kp+6656);
}
__device__ __forceinline__ void kload2(bf16x8*kf,lds_cptr kp,int j){ kf[2*j]=*(const __attribute__((address_space(3))) bf16x8*)(kp+j*2048); kf[2*j+1]=*(const __attribute__((address_space(3))) bf16x8*)(kp+j*2048+512); }
__device__ __forceinline__ s16x4 vtr(lds_cptr p){ return __builtin_bit_cast(s16x4,__builtin_amdgcn_ds_read_tr16_b64_v4i16((__attribute__((address_space(3))) v4i16_t*)p)); }
__device__ __forceinline__ float rowmax(const f32x16&p0,const f32x16&p1){
  float a=max3f(p0[0],p0[1],p1[0]),b=max3f(p0[2],p0[3],p1[1]);a=max3f(a,p1[2],p1[3]);
  #pragma unroll
  for(int r=4;r<16;r+=4){a=max3f(a,p0[r],p0[r+1]);b=max3f(b,p0[r+2],p0[r+3]);a=max3f(a,p1[r],p1[r+1]);b=max3f(b,p1[r+2],p1[r+3]);}
  const float m=max2f(a,b);
  auto rr=__builtin_amdgcn_permlane32_swap(__float_as_uint(m),__float_as_uint(m),false,false);
  return max2f(__uint_as_float(rr[0]),__uint_as_float(rr[1]));
}
__device__ __forceinline__ void pv(f32x16*o,int vb,bf16x8 pa0,bf16x8 pa1,bf16x8 pa2,bf16x8 pa3){
  #pragma unroll
  for(int d0=0;d0<2;++d0){s16x4 lo[4],hi[4];
    #pragma unroll
    for(int ks=0;ks<4;++ks){
      asm volatile("ds_read_b64_tr_b16 %0,%1 offset:%c2":"=&v"(lo[ks]):"v"(vb),"i"(d0*4096+ks*1024):"memory");
      asm volatile("ds_read_b64_tr_b16 %0,%1 offset:%c2":"=&v"(hi[ks]):"v"(vb),"i"(d0*4096+ks*1024+512):"memory");}
    asm volatile("s_waitcnt lgkmcnt(0)":::"memory");SBAR();
    #define PK(k) (bf16x8){lo[k][0],lo[k][1],lo[k][2],lo[k][3],hi[k][0],hi[k][1],hi[k][2],hi[k][3]}
    o[d0]=__builtin_amdgcn_mfma_f32_32x32x16_bf16(pa0,PK(0),o[d0],0,0,0);
    o[d0]=__builtin_amdgcn_mfma_f32_32x32x16_bf16(pa1,PK(1),o[d0],0,0,0);
    o[d0]=__builtin_amdgcn_mfma_f32_32x32x16_bf16(pa2,PK(2),o[d0],0,0,0);
    o[d0]=__builtin_amdgcn_mfma_f32_32x32x16_bf16(pa3,PK(3),o[d0],0,0,0);
    #undef PK
  }
}

#ifndef ATTN_STORE16
#define ATTN_STORE16(p,v) (*(u32x4*)(p)=(v))
#endif
struct AUnit { const bf16* Q; const bf16* K; const bf16* V; bf16* O; int r1, r2, NT, q0; float sink2; const float* qgain; const float2* tab; const float* sinkv; };
template<int LD,int MODE,int THRL,bool HW> __device__ __forceinline__ void attn_unit(const AUnit& U,char*shm,const int tid){
  const int lane=tid&63,r32=lane&31,hi=lane>>5; const int wid=__builtin_amdgcn_readfirstlane(tid>>6);
  constexpr int n1=4; const int r1=U.r1,r2=U.r2;
  #define TROW(t) (MODE==0?r1+64*(t):((t)<n1?r1+64*(t):r2+64*((t)-n1)))
  const bf16*Qw=HW?U.Q+wid*64:U.Q+(long)(wid*QBLK)*LD; const int qrow0=HW?U.q0:U.q0+wid*QBLK;
  const bf16*Kh=U.K,*Vh=U.V;
  const unsigned lds0=(unsigned)(uintptr_t)shm;
  float*wsf=(float*)(shm+LDS_WS)+wid*64;
  const bf16*ksrc=Kh+(long)lane*LD+wid*8;
  const bf16*vsrc=Vh+(long)(16*(wid&3)+(lane>>2))*LD+(wid>>2)*32+(lane&3)*8;
  const unsigned kdst=lds0+LDS_K+wid*1024, vdst=lds0+LDS_V+wid*1024;
  #define DMA_K(t,slot) glds16(ksrc+(long)TROW(t)*LD,(unsigned)__builtin_amdgcn_readfirstlane(kdst+(slot)))
  #define DMA_V(t,slot) glds16(vsrc+(long)TROW(t)*LD,(unsigned)__builtin_amdgcn_readfirstlane(vdst+(slot)))
  const int vb0=(int)(lds0+LDS_V)+((lane>>4)&1)*32+(lane&3)*8+(4*hi+((lane&15)>>2))*64;
  const char*Kbase=shm+LDS_K; bf16x8 kf[8];
  const lds_cptr shm3=(lds_cptr)shm; const lds_cptr kp0=shm3+LDS_K+hi*1024+r32*16; const lds_cptr vp0=shm3+LDS_V+((lane>>4)&1)*32+(lane&3)*8+(4*hi+((lane&15)>>2))*64;
  const int NT=U.NT;
  DMA_K(0,0);DMA_V(0,0);DMA_K(1,SLOTB);
  float4 gq[8],tv[8];
  #pragma unroll
  for(int j=0;j<8;++j){gq[j]=make_float4(0.f,0.f,0.f,0.f);tv[j]=make_float4(0.f,0.f,0.f,0.f);}
  if(U.qgain){ _Pragma("unroll") for(int d0=0;d0<4;++d0){ gq[2*d0]=*(const float4*)(U.qgain+16*d0+8*hi); gq[2*d0+1]=*(const float4*)(U.qgain+16*d0+8*hi+4); } }
  if(U.tab){ const int t=qrow0+r32; const float4*tr=(const float4*)(U.tab+(t>>6)*16+8*hi),*tc=(const float4*)(U.tab+(t&63)*16+8*hi);
    _Pragma("unroll") for(int j=0;j<4;++j){ tv[j]=tr[j]; tv[4+j]=tc[j]; } }
  bf16x8 qr[4];
  #pragma unroll
  for(int d0=0;d0<4;++d0)qr[d0]=*reinterpret_cast<const bf16x8*>(&Qw[(long)r32*LD+d0*16+hi*8]);
  {
    float x[4][8];
    #pragma unroll
    for(int d0=0;d0<4;++d0){ _Pragma("unroll") for(int j=0;j<8;++j) x[d0][j]=__builtin_bit_cast(float,(unsigned)(unsigned short)qr[d0][j]<<16); }
    if(U.qgain){ float ss=0.f;
      #pragma unroll
      for(int d0=0;d0<4;++d0){ _Pragma("unroll") for(int j=0;j<8;++j) ss+=x[d0][j]*x[d0][j]; }
      ss=xl::add_xor32(ss); const float rs=__builtin_amdgcn_rsqf(ss*(1.f/64.f)+1e-6f);
      #pragma unroll
      for(int d0=0;d0<4;++d0){ const float4 g0=gq[2*d0], g1=gq[2*d0+1];
        x[d0][0]*=rs*g0.x;x[d0][1]*=rs*g0.y;x[d0][2]*=rs*g0.z;x[d0][3]*=rs*g0.w;x[d0][4]*=rs*g1.x;x[d0][5]*=rs*g1.y;x[d0][6]*=rs*g1.z;x[d0][7]*=rs*g1.w; } }
    if(U.tab){
      #pragma unroll
      for(int j=0;j<8;++j){ const float4 r4=tv[j>>1],c4=tv[4+(j>>1)]; const float crx=(j&1)?r4.z:r4.x,cry=(j&1)?r4.w:r4.y,ccx=(j&1)?c4.z:c4.x,ccy=(j&1)?c4.w:c4.y;
        const float a0=x[0][j],a1=x[1][j],a2=x[2][j],a3=x[3][j];
        x[0][j]=a0*crx-a1*cry; x[1][j]=a1*crx+a0*cry; x[2][j]=a2*ccx-a3*ccy; x[3][j]=a3*ccx+a2*ccy; } }
    #pragma unroll
    for(int d0=0;d0<4;++d0){ u32x4 w; _Pragma("unroll") for(int j=0;j<4;++j) w[j]=cvtpk_s(x[d0][2*j]*C2,x[d0][2*j+1]*C2); qr[d0]=__builtin_bit_cast(bf16x8,w); }
  }
  float mhat=0.f,l_reg=0.f;f32x16 o[2];o[0]=f32x16{};o[1]=f32x16{};f32x16 negm=f32x16{};asm volatile("":"+v"(negm));
  const int qpos=qrow0+r32;
  #define CMASK(P0,P1,t) do{ if(MODE==1){ if((t)>=n1){ const int tlo_=TROW(t), qw_=qrow0; \
      if(!(tlo_-qw_-31>=-128 && tlo_+63-qw_<=128)){ const int db_=tlo_-qpos+4*hi+128; \
        _Pragma("unroll") for(int r=0;r<16;++r){ const int c_=(r&3)+8*(r>>2); if((unsigned)(db_+c_)>256u)P0[r]=-INFINITY; if((unsigned)(db_+c_+32)>256u)P1[r]=-INFINITY; } } } } }while(0)
  bool resc=false;
  #define START(P0,P1) do{ const float rm=rowmax(P0,P1); resc=false; \
    { const float dl=rm; mhat=fadd_s(mhat,dl); \
      _Pragma("unroll") for(int r=0;r<16;++r){P0[r]=fsub_s(P0[r],dl);P1[r]=fsub_s(P1[r],dl);} \
      _Pragma("unroll") for(int r=0;r<16;++r)negm[r]=-mhat; asm volatile("":"+v"(negm)); } \
    _Pragma("unroll") for(int r=0;r<16;++r)P0[r]=__builtin_amdgcn_exp2f(P0[r]); }while(0)
  #define RESC() do{ if(resc){ asm volatile("s_waitcnt lgkmcnt(0)":::"memory"); \
      _Pragma("unroll") for(int d_=0;d_<2;++d_) _Pragma("unroll") for(int r=0;r<16;++r)o[d_][r]*=wsf[crow(r,hi)]; } }while(0)
  f32x16 pA0,pA1,pB0,pB1;
  int sl_prev=0,sl_cur=0,sl_next=SLOTB;
  #define ROT() do{sl_prev=sl_cur;sl_cur=sl_next;sl_next=(sl_next==(NSLOT-1)*SLOTB)?0:sl_next+SLOTB;}while(0)
  DMA_K(2,2*SLOTB);
  WAIT_BAR(3);
  qkt(pA0,pA1,Kbase,qr,negm,r32,hi);asm volatile("s_nop 15\n\ts_nop 7":"+v"(pA0),"+v"(pA1));CMASK(pA0,pA1,0);
  START(pA0,pA1);
  _Pragma("unroll") for(int r=0;r<16;++r)pA1[r]=__builtin_amdgcn_exp2f(pA1[r]);
  WAIT_BAR(0);
  DMA_K(3,0);DMA_V(1,SLOTB);
  ROT();
  kload8(kf,kp0+sl_cur);
  WAIT_BAR(2);
  s16x4 vlo[8],vhi[8]; u32x4 pw0,pw1,pw2,pw3;
  #define PKW(P,B) cvtpk_s(P[B],P[B+1])
  #define PAF(k) __builtin_bit_cast(bf16x8,pw##k)
  #define VFR(i) (bf16x8){vlo[i][0],vlo[i][1],vlo[i][2],vlo[i][3],vhi[i][0],vhi[i][1],vhi[i][2],vhi[i][3]}
  #define PIN(x) asm volatile("":"+v"(x))
  #define MX3(a,b,c) __builtin_fmaxf(__builtin_fmaxf((a),(b)),(c))
  #define GAPA(MF,A0,A1,A2,A3,W0,W1,PW) do{ MF; sacc+=A0; sacc+=A1; sacc+=A2; sacc+=A3; PIN(sacc); W0; W1; PIN(PW); SBAR(); }while(0)
  #define EX(v) __builtin_amdgcn_exp2f(v)
  #define GAPB(MF,X,B) do{ MF; X[B]=EX(X[B]); X[B+1]=EX(X[B+1]); X[B+2]=EX(X[B+2]); X[B+3]=EX(X[B+3]); PIN(X); SBAR(); }while(0)
  #define VRD(i) do{ vlo[i]=vtr(vp_+(((i)>>2)*4096+((i)&3)*1024)); vhi[i]=vtr(vp_+(((i)>>2)*4096+((i)&3)*1024+512)); }while(0)
  #define KRD(G,j) do{ if(G){ kload2(kf,kp0+sl_next,j); SBAR(); } }while(0)
  #define STEP(C0,C1,P0,P1,t,GK,GV,GL) do{ SBAR(); \
    const lds_cptr vp_=vp0+sl_prev; \
    VRD(0); SBAR(); float sacc=(P0[0]+P0[1]); \
    GAPA(C0=__builtin_amdgcn_mfma_f32_32x32x16_bf16(kf[0],qr[0],negm,0,0,0), P0[2],P0[3],P0[4],P0[5],     pw0[0]=PKW(P0,0), pw0[1]=PKW(P0,2), pw0); \
    VRD(4); SBAR(); GAPA(C1=__builtin_amdgcn_mfma_f32_32x32x16_bf16(kf[1],qr[0],negm,0,0,0), P0[6],P0[7],P0[8],P0[9],     pw0[2]=PKW(P0,4), pw0[3]=PKW(P0,6), pw0); \
    VRD(1); SBAR(); GAPA(C0=__builtin_amdgcn_mfma_f32_32x32x16_bf16(kf[2],qr[1],C0,0,0,0),   P0[10],P0[11],P0[12],P0[13], pw1[0]=PKW(P0,8), pw1[1]=PKW(P0,10), pw1); \
    VRD(5); SBAR(); GAPA(C1=__builtin_amdgcn_mfma_f32_32x32x16_bf16(kf[3],qr[1],C1,0,0,0),   P0[14],P0[15],P1[0],P1[1],   pw1[2]=PKW(P0,12),pw1[3]=PKW(P0,14), pw1); \
    VRD(2); SBAR(); GAPA(C0=__builtin_amdgcn_mfma_f32_32x32x16_bf16(kf[4],qr[2],C0,0,0,0),   P1[2],P1[3],P1[4],P1[5],     pw2[0]=PKW(P1,0), pw2[1]=PKW(P1,2), pw2); \
    VRD(6); SBAR(); GAPA(C1=__builtin_amdgcn_mfma_f32_32x32x16_bf16(kf[5],qr[2],C1,0,0,0),   P1[6],P1[7],P1[8],P1[9],     pw2[2]=PKW(P1,4), pw2[3]=PKW(P1,6), pw2); \
    VRD(3); SBAR(); GAPA(C0=__builtin_amdgcn_mfma_f32_32x32x16_bf16(kf[6],qr[3],C0,0,0,0),   P1[10],P1[11],P1[12],P1[13], pw3[0]=PKW(P1,8), pw3[1]=PKW(P1,10), pw3); \
    VRD(7); SBAR(); GAPA(C1=__builtin_amdgcn_mfma_f32_32x32x16_bf16(kf[7],qr[3],C1,0,0,0),   P1[14],P1[15],0.f,0.f,       pw3[2]=PKW(P1,12),pw3[3]=PKW(P1,14), pw3); \
    l_reg+=sacc; \
    if(GK){DMA_K((t)+3,sl_cur);} if(GV){DMA_V((t)+1,sl_next);} \
    CMASK(C0,C1,t); \
    { float a=MX3(C0[0],C0[1],C1[0]),b=MX3(C0[2],C0[3],C1[1]); a=MX3(a,C1[2],C1[3]); \
      _Pragma("unroll") for(int r=4;r<16;r+=4){a=MX3(a,C0[r],C0[r+1]);b=MX3(b,C0[r+2],C0[r+3]);a=MX3(a,C1[r],C1[r+1]);b=MX3(b,C1[r+2],C1[r+3]);} \
      float rm=__builtin_fmaxf(a,b); { auto rr=__builtin_amdgcn_permlane32_swap(__float_as_uint(rm),__float_as_uint(rm),false,false); rm=__builtin_fmaxf(__uint_as_float(rr[0]),__uint_as_float(rr[1])); } \
      resc=false; \
      if(__builtin_expect(__any(rm>(float)THRL),0)){ const float dl=__builtin_fmaxf(rm,0.f); mhat+=dl; \
        _Pragma("unroll") for(int r=0;r<16;++r){C0[r]-=dl;C1[r]-=dl;} \
        _Pragma("unroll") for(int r=0;r<16;++r)negm[r]=-mhat; asm volatile("":"+v"(negm)); \
        const float f=__builtin_amdgcn_exp2f(-dl); l_reg*=f; if(hi==0)wsf[r32]=f; resc=true; } } \
    SBAR(); \
    GAPB(o[0]=__builtin_amdgcn_mfma_f32_32x32x16_bf16(PAF(0),VFR(0),o[0],0,0,0), C0,0); \
    GAPB(o[1]=__builtin_amdgcn_mfma_f32_32x32x16_bf16(PAF(0),VFR(4),o[1],0,0,0), C0,4); \
    KRD(GL,0); GAPB(o[0]=__builtin_amdgcn_mfma_f32_32x32x16_bf16(PAF(1),VFR(1),o[0],0,0,0), C0,8); \
    KRD(GL,1); GAPB(o[1]=__builtin_amdgcn_mfma_f32_32x32x16_bf16(PAF(1),VFR(5),o[1],0,0,0), C0,12); \
    KRD(GL,2); GAPB(o[0]=__builtin_amdgcn_mfma_f32_32x32x16_bf16(PAF(2),VFR(2),o[0],0,0,0), C1,0); \
    KRD(GL,3); GAPB(o[1]=__builtin_amdgcn_mfma_f32_32x32x16_bf16(PAF(2),VFR(6),o[1],0,0,0), C1,4); \
    GAPB(o[0]=__builtin_amdgcn_mfma_f32_32x32x16_bf16(PAF(3),VFR(3),o[0],0,0,0), C1,8); \
    GAPB(o[1]=__builtin_amdgcn_mfma_f32_32x32x16_bf16(PAF(3),VFR(7),o[1],0,0,0), C1,12); \
    }while(0)
  int t=1;
  for(;t+5<NT;t+=2){
    STEP(pB0,pB1,pA0,pA1,t,true,true,true);     WAIT_BAR(2); RESC(); ROT();
    STEP(pA0,pA1,pB0,pB1,t+1,true,true,true);   WAIT_BAR(2); RESC(); ROT();
  }
  #define ENDW(tt) do{ if((tt)+3<NT){WAIT_BAR(2);} else if((tt)+2<NT){WAIT_BAR(1);} else {WAIT_BAR(0);} }while(0)
  for(;t+1<NT;t+=2){
    STEP(pB0,pB1,pA0,pA1,t,(t+3<NT),(t+1<NT),(t+1<NT));       ENDW(t);   RESC(); ROT();
    STEP(pA0,pA1,pB0,pB1,t+1,(t+4<NT),(t+2<NT),(t+2<NT));     ENDW(t+1); RESC(); ROT();
  }
  #define DRAIN(P0,P1,SL) do{ float sacc=P0[0]+P0[1]; _Pragma("unroll") for(int r=2;r<16;++r)sacc+=P0[r]; _Pragma("unroll") for(int r=0;r<16;++r)sacc+=P1[r]; l_reg+=sacc; \
    pw0=(u32x4){PKW(P0,0),PKW(P0,2),PKW(P0,4),PKW(P0,6)};pw1=(u32x4){PKW(P0,8),PKW(P0,10),PKW(P0,12),PKW(P0,14)};pw2=(u32x4){PKW(P1,0),PKW(P1,2),PKW(P1,4),PKW(P1,6)};pw3=(u32x4){PKW(P1,8),PKW(P1,10),PKW(P1,12),PKW(P1,14)}; \
    SBAR(); pv(o,vb0+(SL),PAF(0),PAF(1),PAF(2),PAF(3)); }while(0)
  if(t<NT){ STEP(pB0,pB1,pA0,pA1,NT-1,false,false,false); RESC(); DRAIN(pB0,pB1,sl_cur); }
  else { DRAIN(pA0,pA1,sl_prev); }
  #undef DRAIN
  #undef PKW
  #undef PAF
  #undef VFR
  #undef PIN
  #undef MX3
  #undef GAPA
  #undef GAPB
  #undef EX
  #undef VRD
  #undef KRD
  #undef STEP
  #undef ENDW
  if(hi==0)l_reg+=__builtin_amdgcn_exp2f((HW?U.sinkv[wid]*1.4426950408889634f:U.sink2)-mhat);
  {auto rr=__builtin_amdgcn_permlane32_swap(__float_as_uint(l_reg),__float_as_uint(l_reg),false,false);l_reg=__uint_as_float(rr[0])+__uint_as_float(rr[1]);}
  if(hi==0)wsf[32+r32]=l_reg;asm volatile("s_waitcnt lgkmcnt(0)":::"memory");
  float rli[16];
  #pragma unroll
  for(int r=0;r<16;++r)rli[r]=__builtin_amdgcn_rcpf(wsf[32+crow(r,hi)]);
  bf16*Ow=HW?U.O+wid*64:U.O+(long)(wid*QBLK)*1024;
  { bf16*stg=(bf16*)(shm+LDS_OST)+wid*2048;
    #pragma unroll
    for(int r=0;r<16;++r){const int orow=crow(r,hi);
      #pragma unroll
      for(int d0=0;d0<2;++d0)stg[orow*64+d0*32+r32]=__float2bfloat16(o[d0][r]*rli[r]);}
    asm volatile("s_waitcnt lgkmcnt(0)":::"memory");
    #pragma unroll
    for(int i=0;i<4;++i){const int row=i*8+(lane>>3),ch=lane&7; const u32x4 v=*(const u32x4*)(stg+row*64+ch*8); ATTN_STORE16(Ow+(long)row*1024+ch*8,v);} }
  asm volatile("s_waitcnt lgkmcnt(0)\n\ts_barrier":::"memory");
  #undef TROW
  #undef DMA_K
  #undef DMA_V
  #undef CMASK
  #undef START
  #undef RESC
  #undef ROT
}
constexpr int ATTN_LDS_BYTES=LDS_BYTES;
#undef SBAR
#undef WAIT_BAR
}
namespace gla {
using bf16 = unsigned short;
using bf16x8 = __attribute__((ext_vector_type(8))) short;
using s16x4 = __attribute__((ext_vector_type(4))) short;
using f32x16 = __attribute__((ext_vector_type(16))) float;
using f32x4 = __attribute__((ext_vector_type(4))) float;
using u32x4 = __attribute__((ext_vector_type(4))) unsigned;
using u32x2 = __attribute__((ext_vector_type(2))) unsigned;
typedef short v4i16_t __attribute__((ext_vector_type(4)));
#define GLAS __attribute__((address_space(3)))
constexpr int LD = cfg::LDE, M = cfg::M;
constexpr float QS = 0.17677669529663687f;
constexpr int KT_STRIDE = 80, KH_STRIDE = 144;
constexpr int WAVE_LDS = 18432;
__device__ __forceinline__ float ex(float x) { return __builtin_amdgcn_exp2f(x * 1.4426950408889634f); }
__device__ __forceinline__ float bf2f(unsigned short v) { return __builtin_bit_cast(float, (unsigned)v << 16); }
__device__ __forceinline__ unsigned short f2bf(float f) { unsigned u = __builtin_bit_cast(unsigned, f); return (unsigned short)((u + 0x7fffu + ((u >> 16) & 1u)) >> 16); }
__device__ __forceinline__ unsigned pk2(float lo, float hi) { return (unsigned)f2bf(lo) | ((unsigned)f2bf(hi) << 16); }
__device__ __forceinline__ int crow(int r, int hi) { return (r & 3) + 8 * (r >> 2) + 4 * hi; }
__device__ __forceinline__ s16x4 vtr(const GLAS char* p) { return __builtin_bit_cast(s16x4, __builtin_amdgcn_ds_read_tr16_b64_v4i16((GLAS v4i16_t*)p)); }
#define GLA_MFMA(a, b, c) __builtin_amdgcn_mfma_f32_32x32x16_bf16(a, b, c, 0, 0, 0)
#define GLA_LDSWAIT() asm volatile("s_waitcnt lgkmcnt(0)" ::: "memory")

struct Ctx {
    const bf16* P;
    float* DEC;
    const float* LR; const float* gkw; const float* gkb;
    size_t mbase;
    int h, bh;
    bf16* US; bf16* SB; float* DD;
    bf16* MIX; const float* gg;
};

template <int CTRL, int ROWMASK> __device__ __forceinline__ float dpp_add(float v) {
    return v + __builtin_bit_cast(float, __builtin_amdgcn_update_dpp(0, __builtin_bit_cast(int, v), CTRL, ROWMASK, 0xf, false)); }
__device__ __forceinline__ float scan64(float v) {
    v = dpp_add<0x111, 0xf>(v); v = dpp_add<0x112, 0xf>(v); v = dpp_add<0x114, 0xf>(v); v = dpp_add<0x118, 0xf>(v);
    v = dpp_add<0x142, 0xa>(v); v = dpp_add<0x143, 0xc>(v); return v; }
__device__ __forceinline__ float sum32(float v) {
    v = dpp_add<0xB1, 0xf>(v); v = dpp_add<0x4E, 0xf>(v); v = dpp_add<0x141, 0xf>(v); v = dpp_add<0x140, 0xf>(v); return v + xl::xor16(v); }
__device__ __forceinline__ void load_g(const float* gp, float (&g)[32]) {
#pragma unroll
    for (int j = 0; j < 8; ++j) { const f32x4 v = *(const f32x4*)(gp + 4 * j); g[4 * j] = v[0]; g[4 * j + 1] = v[1]; g[4 * j + 2] = v[2]; g[4 * j + 3] = v[3]; } }
__device__ __forceinline__ void load_row32(const bf16* p, float (&x)[32]) {
#pragma unroll
    for (int j = 0; j < 4; ++j) { const u32x4 w = *(const u32x4*)(p + 8 * j);
#pragma unroll
        for (int q = 0; q < 4; ++q) { x[8 * j + 2 * q] = __builtin_bit_cast(float, w[q] << 16); x[8 * j + 2 * q + 1] = __builtin_bit_cast(float, w[q] & 0xffff0000u); } } }
__device__ __forceinline__ void load_vtile(const bf16* vp  , GLAS char* vt, int lane) {
#pragma unroll
    for (int p = 0; p < 8; ++p) {
        const u32x4 v = *(const u32x4*)(vp + (size_t)(16 * (p & 3) + (lane >> 2)) * LD + (p >> 2) * 32 + (lane & 3) * 8);
        *(GLAS u32x4*)(vt + p * 1024 + lane * 16) = v;
    }
}
template <int DIR> __device__ __forceinline__ void stage_a(const Ctx& X, int c, GLAS char* wl, int lane_in) {
    int lane = lane_in; asm volatile("" : "+v"(lane));
    const int r32 = lane & 31, hi = lane >> 5;
    GLAS char* khT = wl; GLAS char* vt = wl + 32 * KH_STRIDE;
    const size_t row = X.mbase + 64 * c + lane;
    float g[32], kk[32];
    load_row32(X.P + (size_t)(64 * c + lane) * LD + cfg::E_GK + X.h * 32, kk);
    {
        GLAS float* wsl = (GLAS float*)(wl + 32 * KH_STRIDE + 8192);
        { const int r = lane >> 2, q = (lane & 3) * 8; const float* src = X.gkw + (size_t)(DIR * 16 + r) * 256 + X.h * 32 + q;
          *(GLAS f32x4*)(wsl + r * 32 + q) = *(const f32x4*)src; *(GLAS f32x4*)(wsl + r * 32 + q + 4) = *(const f32x4*)(src + 4);
          if (lane < 8) *(GLAS f32x4*)(wsl + 512 + lane * 4) = *(const f32x4*)(X.gkb + DIR * 256 + X.h * 32 + lane * 4); }
        float lr[16];
#pragma unroll
        for (int j = 0; j < 4; ++j) { const f32x4 v = *(const f32x4*)(X.LR + row * 32 + DIR * 16 + 4 * j); lr[4 * j] = v[0]; lr[4 * j + 1] = v[1]; lr[4 * j + 2] = v[2]; lr[4 * j + 3] = v[3]; }
        GLA_LDSWAIT();
#pragma unroll
        for (int k4 = 0; k4 < 8; ++k4) {
            f32x4 x = *(const GLAS f32x4*)(wsl + 512 + 4 * k4);
#pragma unroll
            for (int r = 0; r < 16; ++r) x += lr[r] * *(const GLAS f32x4*)(wsl + r * 32 + 4 * k4);
#pragma unroll
            for (int q = 0; q < 4; ++q) g[4 * k4 + q] = (fminf(x[q], 0.f) - __logf(1.f + __expf(-fabsf(x[q])))) * (1.f / 16.f);
            *(f32x4*)(X.DEC + ((size_t)DIR * M + row) * 256 + X.h * 32 + 4 * k4) = (f32x4){g[4 * k4], g[4 * k4 + 1], g[4 * k4 + 2], g[4 * k4 + 3]};
        }
    }
    load_vtile(X.P + (size_t)(64 * c) * LD + cfg::E_GV + X.h * 64, vt, lane);
    const size_t slot = ((size_t)(X.bh * 2 + DIR) * 36 + c);
    float dd[32];
#pragma unroll
    for (int i = 0; i < 32; ++i) {
        const float b = scan64(g[i]);
        const float T = __builtin_bit_cast(float, __builtin_amdgcn_readlane(__builtin_bit_cast(int, b), 63));
        const float w = ex(DIR == 0 ? T - b : b - g[i]);
        dd[i] = ex(T);
        *(GLAS unsigned short*)(khT + i * KH_STRIDE + lane * 2) = f2bf(kk[i] * w);
    }
    if (lane == 0) {
#pragma unroll
        for (int j = 0; j < 8; ++j) *(f32x4*)(X.DD + slot * 32 + 4 * j) = (f32x4){dd[4 * j], dd[4 * j + 1], dd[4 * j + 2], dd[4 * j + 3]};
    }
    GLA_LDSWAIT();
    f32x16 u0 = f32x16{}, u1 = f32x16{};
    const GLAS char* vb = vt + ((lane >> 4) & 1) * 32 + (lane & 3) * 8 + (8 * hi + ((lane & 15) >> 2)) * 64;
#pragma unroll
    for (int s = 0; s < 4; ++s) {
        const bf16x8 a = *(const GLAS bf16x8*)(khT + r32 * KH_STRIDE + (16 * s + 8 * hi) * 2);
        const s16x4 l0 = vtr(vb + s * 1024), h0 = vtr(vb + s * 1024 + 256), l1 = vtr(vb + 4096 + s * 1024), h1 = vtr(vb + 4096 + s * 1024 + 256);
        u0 = GLA_MFMA(a, ((bf16x8){l0[0], l0[1], l0[2], l0[3], h0[0], h0[1], h0[2], h0[3]}), u0);
        u1 = GLA_MFMA(a, ((bf16x8){l1[0], l1[1], l1[2], l1[3], h1[0], h1[1], h1[2], h1[3]}), u1);
    }
    bf16* up = X.US + slot * 2048;
#pragma unroll
    for (int g4 = 0; g4 < 4; ++g4) {
        *(u32x2*)(up + (r32) * 32 + 8 * g4 + 4 * hi) = (u32x2){pk2(u0[4 * g4], u0[4 * g4 + 1]), pk2(u0[4 * g4 + 2], u0[4 * g4 + 3])};
        *(u32x2*)(up + (r32 + 32) * 32 + 8 * g4 + 4 * hi) = (u32x2){pk2(u1[4 * g4], u1[4 * g4 + 1]), pk2(u1[4 * g4 + 2], u1[4 * g4 + 3])};
    }
    GLA_LDSWAIT();
}
constexpr int C_KT = 0, C_QT = 64 * KT_STRIDE, C_VT = 128 * KT_STRIDE, C_WAVE = C_VT + 8192;
__device__ __forceinline__ void unpack_row32(const u32x4 (&w4)[4], float (&x)[32]) {
#pragma unroll
    for (int j = 0; j < 4; ++j)
#pragma unroll
        for (int q = 0; q < 4; ++q) { x[8 * j + 2 * q] = __builtin_bit_cast(float, w4[j][q] << 16); x[8 * j + 2 * q + 1] = __builtin_bit_cast(float, w4[j][q] & 0xffff0000u); } }
template <int DIR, bool PF> __device__ __forceinline__ void stage_c_dir(const Ctx& X, int c, GLAS char* wl, int lane_in, f32x16 (&o)[2][2], float (&g)[32], const u32x4 (&kraw)[4], const u32x4 (&qraw)[4], const float* gnp, float (&gn)[32]) {
    int lane = lane_in; asm volatile("" : "+v"(lane));
    const int r32 = lane & 31, hi = lane >> 5;
    GLAS char* kt = wl + C_KT; GLAS char* qt = wl + C_QT; GLAS char* vt = wl + C_VT;
    {
        float x[32];
        unpack_row32(kraw, x);
#pragma unroll
        for (int i = 0; i < 32; ++i) {
            float b = scan64(g[i]);
            if (DIR == 1) { const float T = __builtin_bit_cast(float, __builtin_amdgcn_readlane(__builtin_bit_cast(int, b), 63)); b = T - b + g[i]; }
            const float e = ex(b);
            x[i] *= __builtin_amdgcn_rcpf(e);
            g[i] = e * QS;
        }
#pragma unroll
        for (int j = 0; j < 4; ++j) *(GLAS u32x4*)(kt + lane * KT_STRIDE + 16 * j) = (u32x4){pk2(x[8 * j], x[8 * j + 1]), pk2(x[8 * j + 2], x[8 * j + 3]), pk2(x[8 * j + 4], x[8 * j + 5]), pk2(x[8 * j + 6], x[8 * j + 7])};
        unpack_row32(qraw, x);
#pragma unroll
        for (int j = 0; j < 4; ++j) *(GLAS u32x4*)(qt + lane * KT_STRIDE + 16 * j) = (u32x4){pk2(x[8 * j] * g[8 * j], x[8 * j + 1] * g[8 * j + 1]), pk2(x[8 * j + 2] * g[8 * j + 2], x[8 * j + 3] * g[8 * j + 3]),
                                                                                           pk2(x[8 * j + 4] * g[8 * j + 4], x[8 * j + 5] * g[8 * j + 5]), pk2(x[8 * j + 6] * g[8 * j + 6], x[8 * j + 7] * g[8 * j + 7])};
    }
    if (PF) load_g(gnp, gn);
    GLA_LDSWAIT();
    const bf16* sp = X.SB + ((size_t)(X.bh * 2 + DIR) * 36 + c) * 2048;
    bf16x8 sf[2][2];
#pragma unroll
    for (int s = 0; s < 2; ++s) { sf[s][0] = *(const bf16x8*)(sp + (r32) * 32 + 16 * s + 8 * hi); sf[s][1] = *(const bf16x8*)(sp + (r32 + 32) * 32 + 16 * s + 8 * hi); }
    const GLAS char* vb = vt + ((lane >> 4) & 1) * 32 + (lane & 3) * 8 + (4 * hi + ((lane & 15) >> 2)) * 64;
#pragma unroll
    for (int qh = 0; qh < 2; ++qh) {
        constexpr bool dummy = false; (void)dummy;
        const bool use0 = !(DIR == 1 && qh == 1), use1 = !(DIR == 0 && qh == 0);
        f32x16 p0 = f32x16{}, p1 = f32x16{};
        bf16x8 bq[2];
#pragma unroll
        for (int s = 0; s < 2; ++s) {
            bq[s] = *(const GLAS bf16x8*)(qt + (32 * qh + r32) * KT_STRIDE + (16 * s + 8 * hi) * 2);
            if (use0) { const bf16x8 a0 = *(const GLAS bf16x8*)(kt + r32 * KT_STRIDE + (16 * s + 8 * hi) * 2); p0 = GLA_MFMA(a0, bq[s], p0); }
            if (use1) { const bf16x8 a1 = *(const GLAS bf16x8*)(kt + (32 + r32) * KT_STRIDE + (16 * s + 8 * hi) * 2); p1 = GLA_MFMA(a1, bq[s], p1); }
        }
        const int iq = 32 * qh + r32;
#pragma unroll
        for (int r = 0; r < 16; ++r) { const int j0 = crow(r, hi), j1 = 32 + j0;
            if (DIR == 0) { if (use0 && j0 > iq) p0[r] = 0.f; if (use1 && j1 > iq) p1[r] = 0.f; } else { if (use0 && j0 < iq) p0[r] = 0.f; if (use1 && j1 < iq) p1[r] = 0.f; } }
#pragma unroll
        for (int ks = 0; ks < 4; ++ks) {
            if ((ks < 2) ? !use0 : !use1) continue;
            const f32x16& p = (ks < 2) ? p0 : p1; const int r0 = (ks & 1) * 8;
            const u32x4 pw = (u32x4){pk2(p[r0], p[r0 + 1]), pk2(p[r0 + 2], p[r0 + 3]), pk2(p[r0 + 4], p[r0 + 5]), pk2(p[r0 + 6], p[r0 + 7])};
            const bf16x8 pa = __builtin_bit_cast(bf16x8, pw);
            const s16x4 l0 = vtr(vb + ks * 1024), h0 = vtr(vb + ks * 1024 + 512), l1 = vtr(vb + 4096 + ks * 1024), h1 = vtr(vb + 4096 + ks * 1024 + 512);
            o[qh][0] = GLA_MFMA(pa, ((bf16x8){l0[0], l0[1], l0[2], l0[3], h0[0], h0[1], h0[2], h0[3]}), o[qh][0]);
            o[qh][1] = GLA_MFMA(pa, ((bf16x8){l1[0], l1[1], l1[2], l1[3], h1[0], h1[1], h1[2], h1[3]}), o[qh][1]);
        }
#pragma unroll
        for (int s = 0; s < 2; ++s) { o[qh][0] = GLA_MFMA(bq[s], sf[s][0], o[qh][0]); o[qh][1] = GLA_MFMA(bq[s], sf[s][1], o[qh][1]); }
    }
    GLA_LDSWAIT();
}
__device__ __forceinline__ void stage_c(const Ctx& X, int c, GLAS char* wl, int lane_in) {
    int lane = lane_in; asm volatile("" : "+v"(lane));
    f32x16 o[2][2]; o[0][0] = f32x16{}; o[0][1] = f32x16{}; o[1][0] = f32x16{}; o[1][1] = f32x16{};
    float g0[32], g1[32]; u32x4 kraw[4], qraw[4];
    { const size_t row = X.mbase + 64 * c + lane; const bf16* pr = X.P + (size_t)(64 * c + lane) * LD + X.h * 32;
      load_g(X.DEC + ((size_t)0 * M + row) * 256 + X.h * 32, g0);
#pragma unroll
      for (int j = 0; j < 4; ++j) { kraw[j] = *(const u32x4*)(pr + cfg::E_GK + 8 * j); qraw[j] = *(const u32x4*)(pr + cfg::E_GQ + 8 * j); } }
    load_vtile(X.P + (size_t)(64 * c) * LD + cfg::E_GV + X.h * 64, wl + C_VT, lane);
    stage_c_dir<0, true>(X, c, wl, lane, o, g0, kraw, qraw, X.DEC + ((size_t)1 * M + X.mbase + 64 * c + lane) * 256 + X.h * 32, g1);
    stage_c_dir<1, false>(X, c, wl, lane, o, g1, kraw, qraw, nullptr, g0);
    asm volatile("" : "+v"(lane));
    const int r32 = lane & 31, hi = lane >> 5;
    const float gn0 = X.gg[r32], gn1 = X.gg[r32 + 32];
    GLAS char* stg = wl;
#pragma unroll
    for (int qh = 0; qh < 2; ++qh)
#pragma unroll
        for (int r = 0; r < 16; ++r) {
            const float ss = sum32(o[qh][0][r] * o[qh][0][r] + o[qh][1][r] * o[qh][1][r]);
            const float rs = __builtin_amdgcn_rsqf(ss * (1.f / 64.f) + cfg::EPS);
            GLAS char* rp = stg + (32 * qh + crow(r, hi)) * KH_STRIDE + r32 * 2;
            *(GLAS unsigned short*)rp = f2bf(o[qh][0][r] * rs * gn0); *(GLAS unsigned short*)(rp + 64) = f2bf(o[qh][1][r] * rs * gn1);
        }
    GLA_LDSWAIT();
    const bf16* gp = X.P + (size_t)(64 * c + lane) * LD + cfg::E_GG + X.h * 64; bf16* mp = X.MIX + (X.mbase + 64 * c + lane) * 1024 + X.h * 64;
    u32x4 gv[8];
#pragma unroll
    for (int j = 0; j < 8; ++j) gv[j] = *(const u32x4*)(gp + 8 * j);
#pragma unroll
    for (int j = 0; j < 8; ++j) {
        const u32x4 ov = *(const GLAS u32x4*)(stg + lane * KH_STRIDE + 16 * j); u32x4 res;
#pragma unroll
        for (int q = 0; q < 4; ++q) {
            const float a0 = __builtin_bit_cast(float, gv[j][q] << 16), a1 = __builtin_bit_cast(float, gv[j][q] & 0xffff0000u);
            const float v0 = __builtin_bit_cast(float, ov[q] << 16), v1 = __builtin_bit_cast(float, ov[q] & 0xffff0000u);
            res[q] = pk2(v0 * (a0 * __builtin_amdgcn_rcpf(1.f + ex(-a0))), v1 * (a1 * __builtin_amdgcn_rcpf(1.f + ex(-a1))));
        }
        *(u32x4*)(mp + 8 * j) = res;
    }
    GLA_LDSWAIT();
}
__device__ __forceinline__ Ctx ctx_of(const Ctx& B0, int bh) { Ctx X = B0; const int b = bh >> 3; X.h = bh & 7; X.bh = bh; X.mbase = (size_t)b * cfg::RB; X.P = B0.P + (size_t)b * cfg::RB * LD; return X; }
__device__ __forceinline__ int gla_task(int i, int total, int gw, int NGW, int wid) {
    const int full = total / NGW, left = total - full * NGW, G = NGW >> 3;
    if (i < full) return i * NGW + gw;
    if (i == full) { const int e = wid * G + (gw >> 3); return e < left ? full * NGW + e : -1; }
    return -1;
}
__device__ __forceinline__ void phase_a(const Ctx& B0, GLAS char* lds, int gw, int NGW, int wid, int lane) {
    GLAS char* wl = lds + wid * WAVE_LDS;
    for (int i = 0;; ++i) { const int t = gla_task(i, 64 * 72, gw, NGW, wid); if (t < 0) break; const int bh = t / 72, r = t - bh * 72; const Ctx X = ctx_of(B0, bh); if (r & 1) stage_a<1>(X, r >> 1, wl, lane); else stage_a<0>(X, r >> 1, wl, lane); }
}
__device__ __forceinline__ void phase_c(const Ctx& B0, GLAS char* lds, int gw, int NGW, int wid, int lane) {
    GLAS char* wl = lds + wid * WAVE_LDS;
    for (int i = 0;; ++i) { const int t = gla_task(i, 64 * 36, gw, NGW, wid); if (t < 0) break; const int bh = t / 36, c = t - bh * 36; const Ctx X = ctx_of(B0, bh); stage_c(X, c, wl, lane); }
}
#ifndef UB_BATCH
#define UB_BATCH 18
#endif
__device__ __forceinline__ void unit_b(const Ctx& X, GLAS char* lds, const int tid) {
    const int dir = tid >> 8, dv = (tid >> 2) & 63, k8 = (tid & 3) * 8;
    float S[8];
#pragma unroll
    for (int i = 0; i < 8; ++i) S[i] = 0.f;
    const size_t base = (size_t)(X.bh * 2 + dir) * 36;
    const bf16* __restrict__ USp = X.US + base * 2048 + dv * 32 + k8; bf16* __restrict__ SBp = X.SB + base * 2048 + dv * 32 + k8;
    GLAS float* dl = (GLAS float*)lds;
    { const float* __restrict__ src = X.DD + (size_t)X.bh * 2 * 36 * 32;
      const f32x4 a = *(const f32x4*)(src + 4 * tid); f32x4 b = (f32x4){0.f, 0.f, 0.f, 0.f}; if (tid < 64) b = *(const f32x4*)(src + 2048 + 4 * tid);
      *(GLAS f32x4*)(dl + 4 * tid) = a; if (tid < 64) *(GLAS f32x4*)(dl + 2048 + 4 * tid) = b; }
    const GLAS float* dk = dl + dir * 36 * 32 + k8;
#pragma unroll
    for (int s0 = 0; s0 < 36; s0 += UB_BATCH) {
        u32x4 uw[UB_BATCH];
#pragma unroll
        for (int j = 0; j < UB_BATCH; ++j) { const int s = s0 + j, cc = dir == 0 ? (s < 4 ? 32 + s : s - 4) : 35 - s; uw[j] = *(const u32x4*)(USp + (size_t)cc * 2048); }
        if (s0 == 0) { GLA_LDSWAIT(); __syncthreads(); }
#pragma unroll
        for (int j = 0; j < UB_BATCH; ++j) {
            const int s = s0 + j, cc = dir == 0 ? (s < 4 ? 32 + s : s - 4) : 35 - s;
            *(u32x4*)(SBp + (size_t)cc * 2048) = (u32x4){pk2(S[0], S[1]), pk2(S[2], S[3]), pk2(S[4], S[5]), pk2(S[6], S[7])};
            const f32x4 d0 = *(const GLAS f32x4*)(dk + cc * 32), d1 = *(const GLAS f32x4*)(dk + cc * 32 + 4);
            const unsigned uu[4] = {uw[j].x, uw[j].y, uw[j].z, uw[j].w};
#pragma unroll
            for (int i = 0; i < 4; ++i) {
                S[2 * i] = (i < 2 ? d0[2 * i] : d1[2 * i - 4]) * S[2 * i] + __builtin_bit_cast(float, uu[i] << 16);
                S[2 * i + 1] = (i < 2 ? d0[2 * i + 1] : d1[2 * i - 3]) * S[2 * i + 1] + __builtin_bit_cast(float, uu[i] & 0xffff0000u);
            }
        }
    }
}
#undef GLAS
}
namespace fw {
using namespace cfg;
constexpr int NWAVES = 8;
constexpr size_t MiB = 1u << 20;
constexpr size_t WS_CTL = 0, CTL_ZERO_BYTES = 512 * 1024;
constexpr size_t WS_MOD = 1 * MiB;
constexpr size_t WS_TAB = 1 * MiB + 896 * 1024;
constexpr size_t WS_DD = 2 * MiB;
constexpr size_t WS_CB = 640 * 1024;
constexpr size_t WS_SQ = 2 * MiB + 576 * 1024;
constexpr size_t WS_LR = 3 * MiB + 768 * 1024;
constexpr size_t WS_XC = 6 * MiB;
constexpr size_t WS_W = 14 * MiB;
constexpr size_t W_IN_E = (size_t)LDE * D * 2, W_IN_O = (size_t)LDO * D * 2, W_OUT = (size_t)D * D * 2, W_13 = (size_t)2 * FFH * D * 2, W_2 = (size_t)D * FFH * 2;
constexpr size_t W_LAYER_E = W_IN_E + W_OUT + W_13 + W_2, W_LAYER_O = W_IN_O + W_OUT + W_13 + W_2;
constexpr size_t WS_HN = 103 * MiB;
constexpr size_t WS_PROJ = 139 * MiB;
constexpr size_t WS_MIX = 238 * MiB;
constexpr size_t WS_H = 139 * MiB;
constexpr size_t WS_US = 274 * MiB, WS_SB = 292 * MiB;
constexpr size_t WS_XMID = WS_US;
constexpr size_t WS_SLAB = 310 * MiB;
constexpr size_t WS_DEC = WS_SLAB;
constexpr size_t WS_END = 374 * MiB;
static_assert(WS_W + 2 * W_LAYER_E + 2 * W_LAYER_O <= WS_HN && WS_HN + (size_t)M * D * 2 <= WS_PROJ && WS_PROJ + (size_t)M * LDE * 2 <= WS_MIX && WS_MIX + (size_t)M * D * 2 <= WS_US, "ws map");
static_assert(WS_CB >= CTL_ZERO_BYTES && WS_CB + (size_t)9 * (LDE + 2 * FFH) * 4 <= WS_MOD && WS_DD + (size_t)64 * 72 * 32 * 4 <= WS_SQ && WS_SQ + (size_t)M * 16 * 4 <= WS_LR && WS_LR + (size_t)M * 32 * 4 <= WS_XC, "ws map 3");
static_assert((size_t)2 * M * 256 * 4 <= (size_t)M * D * 2 && WS_H + (size_t)M * FFH * 2 <= WS_MIX && WS_SB + 18 * MiB <= WS_SLAB && WS_SLAB + 64 * MiB <= WS_END && (size_t)64 * 72 * 4096 <= 18 * MiB, "ws map 2");
__host__ __device__ constexpr size_t w_layer_off(int l) { return (size_t)(l >> 1) * (W_LAYER_E + W_LAYER_O) + ((l & 1) ? W_LAYER_E : 0); }
constexpr int CW_TMO = 0, CW_BAR = 1024, CW_Q = 8192;
constexpr int CW_SPLIT = 16384;
constexpr int RTAB_OFF = 131072;
constexpr int RING_BYTES = 131072, GLA_LDS_BYTES = 8 * 18432, MISC_OFF = GLA_LDS_BYTES + 320, LDS_BYTES = GLA_LDS_BYTES + 1024;

#define GAS __attribute__((address_space(1)))
#define LAS __attribute__((address_space(3)))
typedef unsigned short bf16;
typedef unsigned v4u __attribute__((ext_vector_type(4)));
typedef float f32x4 __attribute__((ext_vector_type(4)));
typedef GAS unsigned gu32;
#define RLX_AGENT __ATOMIC_RELAXED, __HIP_MEMORY_SCOPE_AGENT
#define LDS_WAIT() asm volatile("s_waitcnt lgkmcnt(0)" ::: "memory")
#define VM_WAIT() asm volatile("s_waitcnt vmcnt(0)" ::: "memory")
__device__ __forceinline__ unsigned f2bf(float f) { unsigned u = __builtin_bit_cast(unsigned, f); return (u + 0x7fffu + ((u >> 16) & 1u)) >> 16; }
__device__ __forceinline__ unsigned pk2(float lo, float hi) { return f2bf(lo) | (f2bf(hi) << 16); }
__device__ __forceinline__ float bf2f(unsigned short v) { return __builtin_bit_cast(float, (unsigned)v << 16); }
__device__ __forceinline__ float wave_sum(float v) { return xl::sum64(v); }

#define XB_TMO      128
#define XB_XCNT(j)  (256  + 64 * (j))
#define XB_XSUB(j)  (1280 + 64 * (j))
#define XB_XGEN(j)  (2304 + 64 * (j))
#define XB_TOP      3328
#define XB_TOPGEN   3392
#define XCD_BAR_WORDS 3456
#define XB_SPIN_CAP (1u << 18)
__device__ __forceinline__ unsigned xb_ld(unsigned* p)              { return __hip_atomic_load(p, __ATOMIC_RELAXED, __HIP_MEMORY_SCOPE_AGENT); }
__device__ __forceinline__ unsigned xb_add(unsigned* p, unsigned v) { return __hip_atomic_fetch_add(p, v, __ATOMIC_RELAXED, __HIP_MEMORY_SCOPE_AGENT); }
__device__ __forceinline__ unsigned xb_xcc_id() { return (unsigned)__builtin_amdgcn_s_getreg((3 << 11) | 20) & 0xFu; }
#define XB_SPIN(cond, bar) do { unsigned _sp = 0; while (cond) { __builtin_amdgcn_s_sleep(1); \
    if ((++_sp & 255u) == 0u) { if (xb_ld(&(bar)[XB_TMO])) break; if (_sp > XB_SPIN_CAP) { atomicAdd(&(bar)[XB_TMO], 1u); break; } } } } while (0)
struct XcdBarrier { unsigned* bar; unsigned x; volatile LAS unsigned* st; };
__device__ __forceinline__ XcdBarrier xcd_barrier_post(unsigned* bar, volatile LAS unsigned* st) {
    XcdBarrier b; b.bar = bar; b.x = xb_xcc_id(); b.st = st;
    if (threadIdx.x == 0) (void)xb_add(&bar[XB_XCNT(b.x)], 1u);
    return b;
}
__device__ __forceinline__ void xcd_barrier_complete(unsigned* bar, unsigned x, unsigned& nloc, unsigned& nx) {
    const unsigned G = gridDim.x * gridDim.y * gridDim.z;
    unsigned sum, cnt, mine, sp = 0u;
    for (;;) {
        sum = 0u; cnt = 0u; mine = 0u;
#pragma unroll
        for (unsigned j = 0; j < 16; ++j) { const unsigned c = xb_ld(&bar[XB_XCNT(j)]); sum += c; cnt += (c > 0u) ? 1u : 0u; mine = (j == x) ? c : mine; }
        if (sum == G) break;
        __builtin_amdgcn_s_sleep(1);
        if ((++sp & 255u) == 0u) { if (xb_ld(&bar[XB_TMO])) break; if (sp > XB_SPIN_CAP) { atomicAdd(&bar[XB_TMO], 1u); break; } }
    }
    nloc = mine > 0u ? mine : 1u; nx = cnt > 0u ? cnt : 1u;
}
__device__ __forceinline__ void xcd_barrier(const XcdBarrier& b, const bool t0) {
    asm volatile("s_waitcnt vmcnt(0)" ::: "memory");
    __syncthreads();
    if (t0) {
        unsigned* bar = b.bar;
        __builtin_amdgcn_s_waitcnt(0);
        unsigned nloc = b.st[0], nx = b.st[1];
        if (nloc == 0u) { xcd_barrier_complete(bar, b.x, nloc, nx); b.st[0] = nloc; b.st[1] = nx; }
        const unsigned old = xb_add(&bar[XB_XSUB(b.x)], 1u);
        const unsigned gen = old / nloc;
        if (old + 1u == (gen + 1u) * nloc) {
            __builtin_amdgcn_fence(__ATOMIC_RELEASE, "agent");
            asm volatile("s_waitcnt vmcnt(0)" ::: "memory");
            const unsigned og = xb_add(&bar[XB_TOP], 1u);
            const unsigned tg = og / nx;
            if (og + 1u == (tg + 1u) * nx) xb_add(&bar[XB_TOPGEN], 1u);
            else XB_SPIN(xb_ld(&bar[XB_TOPGEN]) == tg, bar);
            __builtin_amdgcn_fence(__ATOMIC_ACQUIRE, "agent");
            xb_add(&bar[XB_XGEN(b.x)], 1u);
            asm volatile("s_waitcnt vmcnt(0)" ::: "memory");
        } else {
            XB_SPIN(xb_ld(&bar[XB_XGEN(b.x)]) == gen, bar);
            __builtin_amdgcn_fence(__ATOMIC_ACQUIRE, "agent");
            asm volatile("s_waitcnt vmcnt(0)" ::: "memory");
        }
    }
    __syncthreads();
}

struct Args { const float* in[22]; float* out; unsigned char* ws; int ph_lo, ph_hi; };
typedef const __attribute__((address_space(4))) Args* ArgP;
enum { I_X = 0, I_C, I_CTX, I_CCTX, I_ADAW, I_ADAB, I_N1G, I_N2G, I_W1, I_W3, I_W2, I_EIN, I_EOUT, I_GKW, I_GKB, I_GLAG, I_QNG, I_KNG, I_OIN, I_OOUT, I_SINK, I_FG };
enum { S_NORM1 = 0, S_G1, S_PREP, S_GLAA, S_MIX, S_GLAC, S_G2, S_NORM2, S_G3, S_G3B, S_G4, PH_PER_LAYER };
constexpr int N_PHASES = 2 + PH_PER_LAYER * DEPTH;
__host__ __device__ constexpr bool phase_active(int ph) {
    if (ph == 0 || ph == N_PHASES - 1) return true;
    const int l = (ph - 1) / PH_PER_LAYER, s = (ph - 1) % PH_PER_LAYER;
    if (s == S_NORM2 || s == S_PREP || (s == S_NORM1 && l > 0)) return false;
    if (s == S_G3B && l == DEPTH - 1) return false;
    return !((l & 1) && (s == S_GLAA || s == S_GLAC));
}

__device__ __forceinline__ void p0_mods(ArgP A, LAS unsigned char* lds, int l0, int nl, int slot, int nslots, int tid, int lane, int wave) {
    LAS float* sc = (LAS float*)lds;
    LAS float* part = (LAS float*)(lds + 40960);
    if (slot >= 96 * nl) return;
    for (int i = tid; i < 9 * 1024; i += 512) { const int j = i >> 10, k = i & 1023; const float v = j < 8 ? A->in[I_C][j * 1024 + k] : A->in[I_CCTX][k]; sc[i] = v * __builtin_amdgcn_rcpf(1.f + __builtin_amdgcn_exp2f(-LOG2E * v)); }
    __syncthreads();
    float* mod = (float*)(A->ws + WS_MOD);
    for (int t = slot; t < 96 * nl; t += nslots) {
        const int l = l0 + t / 96, cg = t % 96, n = cg * 64 + lane;
        const float* w = A->in[I_ADAW] + ((size_t)l * 1024 + wave * 128) * 6144 + n;
        float acc[9];
#pragma unroll
        for (int j = 0; j < 9; ++j) acc[j] = 0.f;
#pragma nounroll
        for (int k0 = 0; k0 < 128; k0 += 32) { float wv[32];
#pragma unroll
            for (int k = 0; k < 32; ++k) wv[k] = __builtin_nontemporal_load(w + (size_t)(k0 + k) * 6144);
#pragma unroll
            for (int k = 0; k < 32; ++k)
#pragma unroll
                for (int j = 0; j < 9; ++j) acc[j] += sc[j * 1024 + wave * 128 + k0 + k] * wv[k]; }
#pragma unroll
        for (int j = 0; j < 9; ++j) part[(wave * 9 + j) * 64 + lane] = acc[j];
        __syncthreads();
        for (int o = tid; o < 576; o += 512) { const int j = o >> 6, c = o & 63; float s = 0.f;
#pragma unroll
            for (int w8 = 0; w8 < 8; ++w8) s += part[(w8 * 9 + j) * 64 + c];
            mod[((size_t)l * 9 + j) * 6144 + cg * 64 + c] = s + A->in[I_ADAB][l * 6144 + cg * 64 + c]; }
        __syncthreads();
    }
}
__device__ __forceinline__ void p0_item(const float* W, int Nsrc, int srccol, int k0, bf16* WT, int K, int dstrow, LAS float* scr, int lane) {
    if (srccol >= 0) {
        float v[32]; const float* wp = W + (size_t)(k0 + (lane >> 5)) * Nsrc + srccol + (lane & 31);
#pragma unroll
        for (int i = 0; i < 32; ++i) v[i] = __builtin_nontemporal_load(wp + (size_t)(2 * i) * Nsrc);
#pragma unroll
        for (int i = 0; i < 32; ++i) scr[(2 * i + (lane >> 5)) * 33 + (lane & 31)] = v[i];
    } else {
#pragma unroll 8
        for (int i = 0; i < 32; ++i) { const int kk = 2 * i + (lane >> 5); scr[kk * 33 + (lane & 31)] = 0.f; }
    }
    LDS_WAIT(); asm volatile("" ::: "memory");
    const int c = lane & 7;
#pragma unroll
    for (int j = 0; j < 4; ++j) { const int n = (lane >> 3) + 8 * j; const LAS float* s = scr + (8 * c) * 33 + n;
        v4u o; o.x = pk2(s[0 * 33], s[1 * 33]); o.y = pk2(s[2 * 33], s[3 * 33]); o.z = pk2(s[4 * 33], s[5 * 33]); o.w = pk2(s[6 * 33], s[7 * 33]);
        *(GAS v4u*)(WT + (size_t)(dstrow + n) * K + k0 + 8 * c) = o; }
    LDS_WAIT(); asm volatile("" ::: "memory");
}
__device__ __forceinline__ void conv_layer(ArgP A, int l, LAS unsigned char* lds, int wslot, int nslots, int lane, int wave) {
    LAS float* scr = (LAS float*)(lds + wave * 16384);
    constexpr int IT_E = 16 * 80, IT_O = 16 * 40, IT_OUT = 16 * 32, IT_13 = 16 * 176, IT_2 = 44 * 32;
    const int odd = l & 1, i = l >> 1;
    const int it_in = odd ? IT_O : IT_E, total = it_in + IT_OUT + IT_13 + IT_2; const size_t w_in_b = odd ? W_IN_O : W_IN_E;
    bf16* wl = (bf16*)(A->ws + WS_W + w_layer_off(l));
    for (int it = wslot; it < total; it += nslots) {
        int r = it;
        if (r < it_in) {
            const int nblk = odd ? 40 : 80, kb = r / nblk, nb = r % nblk, d0 = 32 * nb;
            if (odd) p0_item(A->in[I_OIN] + (size_t)i * D * LDO, LDO, d0, 64 * kb, wl, D, d0, scr, lane);
            else { const int sc = d0 < 1536 ? d0 : (d0 < 2304 ? d0 + 32 : (d0 == 2304 ? 1536 : -1)); p0_item(A->in[I_EIN] + (size_t)i * D * 2336, 2336, sc, 64 * kb, wl, D, d0, scr, lane); }
            continue; }
        r -= it_in;
        if (r < IT_OUT) { const int kb = r / 32, nb = r % 32; p0_item((odd ? A->in[I_OOUT] : A->in[I_EOUT]) + (size_t)i * D * D, D, 32 * nb, 64 * kb, (bf16*)((unsigned char*)wl + w_in_b), D, 32 * nb, scr, lane); continue; }
        r -= IT_OUT;
        if (r < IT_13) { const int kb = r / 176, nb = r % 176, d0 = 32 * nb, tile = d0 >> 8, within = d0 & 255;
            const float* src = (within < 128 ? A->in[I_W1] : A->in[I_W3]) + (size_t)l * D * FFH;
            p0_item(src, FFH, 128 * tile + (within & 127), 64 * kb, (bf16*)((unsigned char*)wl + w_in_b + W_OUT), D, d0, scr, lane); continue; }
        r -= IT_13;
        { const int kb = r / 32, nb = r % 32; p0_item(A->in[I_W2] + (size_t)l * FFH * D, D, 32 * nb, 64 * kb, (bf16*)((unsigned char*)wl + w_in_b + W_OUT + W_13), FFH, 32 * nb, scr, lane); }
    }
}
__device__ __forceinline__ void p0_tab(ArgP A, int tid) {
    float2* tab = (float2*)(A->ws + WS_TAB);
    for (int e = tid; e < 1024; e += 512) {
        const int p = e >> 4, i = e & 15;
        const float inv = __builtin_amdgcn_exp2f(-(float)(2 * i) * (1.f / 32.f) * 13.287712379549449f);
        const float x = (float)p * inv;
        const float q = __builtin_rintf(x * 0.63661977236758f);
        float r = __builtin_fmaf(-q, 1.5703125f, x); r = __builtin_fmaf(-q, 4.837512969970703125e-4f, r); r = __builtin_fmaf(-q, 7.549789954891882e-8f, r);
        const int qi = ((int)q) & 3; const float r2 = r * r;
        const float s = r + r * r2 * (-1.6666654611e-1f + r2 * (8.3321608736e-3f + r2 * (-1.9515295891e-4f)));
        const float c = 1.f - 0.5f * r2 + r2 * r2 * (4.166664568298827e-2f + r2 * (-1.388731625493765e-3f + r2 * 2.443315711809948e-5f));
        float cs, sn;
        if (qi == 0) { cs = c; sn = s; } else if (qi == 1) { cs = -s; sn = c; } else if (qi == 2) { cs = -c; sn = -s; } else { cs = s; sn = -c; }
        tab[e] = make_float2(cs, sn);
    }
}

__device__ __forceinline__ const float* x_row(const float* lat, const float* ctx, int b, int t) { return t < SEQ ? lat + ((size_t)b * SEQ + t) * D : ctx + ((size_t)b * CTX + (t - SEQ)) * D; }

__device__ __forceinline__ void xg_phase(ArgP A, int gw, int NGW, int lane) {
    const float* g = A->in[I_N1G]; const float* mod = (const float*)(A->ws + WS_MOD);
    bf16* HN = (bf16*)(A->ws + WS_HN); float* SQ = (float*)(A->ws + WS_SQ); bf16* XB = (bf16*)A->out;
    f32x4 gv[4];
#pragma unroll
    for (int j = 0; j < 4; ++j) gv[j] = *(const f32x4*)(g + lane * 4 + 256 * j);
    for (int m = gw; m < M; m += NGW) {
        const int b = m / RB, t = m - b * RB;
        const float* xr = x_row(A->in[I_X], A->in[I_CTX], b, t) + lane * 4; const float* mp = mod + (size_t)(t < SEQ ? b : 8) * 6144 + D + lane * 4;
        f32x4 v[4]; float s = 0.f;
#pragma unroll
        for (int j = 0; j < 4; ++j) { v[j] = *(const f32x4*)(xr + 256 * j); s += (v[j].x * v[j].x + v[j].y * v[j].y) + (v[j].z * v[j].z + v[j].w * v[j].w); }
        s = wave_sum(s);
        if (lane < 16) SQ[(size_t)m * 16 + lane] = lane == 0 ? s : 0.f;
        unsigned long long* o8 = (unsigned long long*)(HN + (size_t)m * D) + lane; unsigned long long* x8 = (unsigned long long*)(XB + (size_t)m * D) + lane;
#pragma unroll
        for (int j = 0; j < 4; ++j) { const f32x4 sc = *(const f32x4*)(mp + 256 * j); const f32x4 y = v[j] * gv[j] * (sc + 1.f);
            o8[64 * j] = (unsigned long long)pk2(y.x, y.y) | ((unsigned long long)pk2(y.z, y.w) << 32);
            x8[64 * j] = (unsigned long long)pk2(v[j].x, v[j].y) | ((unsigned long long)pk2(v[j].z, v[j].w) << 32); }
    }
}
__device__ __forceinline__ void cb_layer(ArgP A, int l, LAS unsigned char* lds, int wslot, int nslots, int tid, int lane) {
    LAS float* sh = (LAS float*)lds;
    const float* mod = (const float*)(A->ws + WS_MOD) + (size_t)l * 9 * 6144;
    for (int e = tid; e < 2 * 9 * 1024; e += 512) { const int w2 = e / 9216, r = e - w2 * 9216, j = r >> 10, k = r & 1023; sh[e] = mod[(size_t)j * 6144 + (w2 ? 3 * D : 0) + k]; }
    __syncthreads();
    if (wslot >= 0) {
        const int odd = l & 1, nin = odd ? LDO : LDE, total = nin + 2 * FFH;
        const bf16* wl = (const bf16*)(A->ws + WS_W + w_layer_off(l)); const bf16* w13 = (const bf16*)((const unsigned char*)wl + (odd ? W_IN_O : W_IN_E) + W_OUT);
        float* cb = (float*)(A->ws + WS_CB);
        for (int n = wslot; n < total; n += nslots) {
            const bool up = n >= nin; const bf16* wr = up ? w13 + (size_t)(n - nin) * D : wl + (size_t)n * D;
            const v4u w0 = *(const v4u*)(wr + lane * 16), w1 = *(const v4u*)(wr + lane * 16 + 8);
            float wv[16];
#pragma unroll
            for (int q = 0; q < 4; ++q) { wv[2 * q] = __builtin_bit_cast(float, w0[q] << 16); wv[2 * q + 1] = __builtin_bit_cast(float, w0[q] & 0xffff0000u); wv[8 + 2 * q] = __builtin_bit_cast(float, w1[q] << 16); wv[8 + 2 * q + 1] = __builtin_bit_cast(float, w1[q] & 0xffff0000u); }
            const LAS float* sp = sh + (up ? 9216 : 0) + lane * 16;
            float acc[9];
#pragma unroll
            for (int j = 0; j < 9; ++j) { float a = 0.f;
#pragma unroll
                for (int q = 0; q < 4; ++q) { const f32x4 s4 = *(const LAS f32x4*)(sp + j * 1024 + 4 * q); a += (wv[4 * q] * s4[0] + wv[4 * q + 1] * s4[1]) + (wv[4 * q + 2] * s4[2] + wv[4 * q + 3] * s4[3]); }
                acc[j] = wave_sum(a); }
            if (lane < 9) { float v = acc[0];
#pragma unroll
                for (int j = 1; j < 9; ++j) v = lane == j ? acc[j] : v;
                cb[up ? (size_t)9 * LDE + (size_t)lane * 2 * FFH + (n - nin) : (size_t)lane * LDE + n] = v; }
        }
    }
    __syncthreads();
}
template <class Sched> __device__ __forceinline__ void rtab_build(const Sched& S, const float* SQ, LAS float* rtab, int tid) {
    f32x4 v[4][4]; bool ok[4];
#pragma unroll
    for (int it = 0; it < 4; ++it) { const int e = tid + 512 * it; pg8::Unit u; ok[it] = (e < 7 * 256) && S.next(e >> 8, u);
        const f32x4* p = (const f32x4*)(SQ + ((size_t)(ok[it] ? u.pm : 0) * 256 + (e & 255)) * 16);
#pragma unroll
        for (int q = 0; q < 4; ++q) v[it][q] = p[q]; }
#pragma unroll
    for (int it = 0; it < 4; ++it) { const f32x4 a = v[it][0], b = v[it][1], c = v[it][2], d = v[it][3];
        const float s = ((a[0] + a[1]) + (a[2] + a[3])) + ((b[0] + b[1]) + (b[2] + b[3])) + ((c[0] + c[1]) + (c[2] + c[3])) + ((d[0] + d[1]) + (d[2] + d[3]));
        if (ok[it]) rtab[tid + 512 * it] = __builtin_amdgcn_rsqf(s * (1.f / D) + EPS); }
    __syncthreads();
}
__device__ __forceinline__ void final_phase(ArgP A, int gw, int NGW, int lane) {
    const bf16* X = (const bf16*)(A->ws + WS_HN);
    f32x4 gv[4];
#pragma unroll
    for (int j = 0; j < 4; ++j) gv[j] = *(const f32x4*)(A->in[I_FG] + lane * 4 + 256 * j);
    for (int r = gw; r < NB * SEQ; r += NGW) {
        const int b = r >> 11, t = r & 2047; const unsigned long long* xr = (const unsigned long long*)(X + ((size_t)b * RB + t) * D) + lane;
        f32x4 v[4]; float s = 0.f;
#pragma unroll
        for (int j = 0; j < 4; ++j) { const unsigned long long w = xr[64 * j]; const unsigned lo = (unsigned)w, hi = (unsigned)(w >> 32);
            v[j] = (f32x4){__builtin_bit_cast(float, lo << 16), __builtin_bit_cast(float, lo & 0xffff0000u), __builtin_bit_cast(float, hi << 16), __builtin_bit_cast(float, hi & 0xffff0000u)};
            s += (v[j].x * v[j].x + v[j].y * v[j].y) + (v[j].z * v[j].z + v[j].w * v[j].w); }
        const float rr = __builtin_amdgcn_rsqf(wave_sum(s) * (1.f / D) + EPS);
        float* orow = A->out + (size_t)r * D + lane * 4;
#pragma unroll
        for (int j = 0; j < 4; ++j) *(f32x4*)(orow + 256 * j) = v[j] * rr * gv[j];
    }
}
typedef unsigned u32x4v __attribute__((ext_vector_type(4)));
__device__ __forceinline__ float xor_sum8(float v) { return xl::sum8(v); }
__device__ __forceinline__ void head8(float (&x)[8], int lane, bool norm, const float (&gain)[8], bool latent, const float2* tab, int t, float outscale) {
    if (norm) { float ss = 0.f;
#pragma unroll
        for (int j = 0; j < 8; ++j) ss += x[j] * x[j];
        const float rs = __builtin_amdgcn_rsqf(xor_sum8(ss) * (1.f / 64.f) + EPS);
#pragma unroll
        for (int j = 0; j < 8; ++j) x[j] *= rs * gain[j]; }
    if (latent) {
        const int pos = (lane & 4) ? (t & 63) : (t >> 6); const f32x4* tp = (const f32x4*)(tab + pos * 16 + 8 * (lane & 1));
        const bool second = lane & 2;
#pragma unroll
        for (int j4 = 0; j4 < 4; ++j4) { const f32x4 cs = tp[j4];
            const float p0 = xl::xor2(x[2 * j4]), p1 = xl::xor2(x[2 * j4 + 1]);
            x[2 * j4] = x[2 * j4] * cs[0] + (second ? p0 : -p0) * cs[1]; x[2 * j4 + 1] = x[2 * j4 + 1] * cs[2] + (second ? p1 : -p1) * cs[3]; }
    }
#pragma unroll
    for (int j = 0; j < 8; ++j) x[j] *= outscale;
}
__device__ __forceinline__ void unpack8(const u32x4v w, float (&x)[8]) {
#pragma unroll
    for (int j = 0; j < 4; ++j) { x[2 * j] = __builtin_bit_cast(float, w[j] << 16); x[2 * j + 1] = __builtin_bit_cast(float, w[j] & 0xffff0000u); } }
__device__ __forceinline__ u32x4v pack8(const float (&x)[8]) { u32x4v w; w[0] = pk2(x[0], x[1]); w[1] = pk2(x[2], x[3]); w[2] = pk2(x[4], x[5]); w[3] = pk2(x[6], x[7]); return w; }
}
namespace fwpost {
struct Ctx { unsigned short* P; int ld; int even; const float* qn; const float* kn; const float2* tab; const float* LR; float* DEC; const float* gkw; const float* gkb; };
__device__ __forceinline__ void run(const Ctx& c, int pm, int pn, int tid_in) {
    using namespace fw;
    int tid = tid_in; asm volatile("" : "+v"(tid));
    const int lane = tid & 63, wave = __builtin_amdgcn_readfirstlane(tid >> 6); const int b = pm / 9, j = pm - 9 * b; const bool latent = j < 8; const int t0 = 256 * j;
    const size_t m0 = (size_t)pm * 256;
    const bool ktile = c.even ? pn == 8 : pn == 4;
    float gain[8];
#pragma unroll
    for (int q = 0; q < 8; ++q) gain[q] = c.even ? (ktile ? c.kn : c.qn)[8 * (lane & 7) + q] : 1.f;
    if (!ktile) return;
    if (c.even || latent) {
        unsigned short* p0 = c.P + (m0 + wave * 32 + (lane >> 4)) * c.ld + pn * 256 + 8 * (lane & 15);
#pragma nounroll
        for (int h4 = 0; h4 < 2; ++h4) {
            u32x4v raw[4];
#pragma unroll
            for (int s = 0; s < 4; ++s) raw[s] = *(const u32x4v*)(p0 + (size_t)(16 * h4 + 4 * s) * c.ld);
#pragma unroll
            for (int s = 0; s < 4; ++s) { float x[8]; unpack8(raw[s], x); head8(x, lane, c.even, gain, latent, c.tab, t0 + wave * 32 + 16 * h4 + 4 * s + (lane >> 4), 1.f); raw[s] = pack8(x); }
#pragma unroll
            for (int s = 0; s < 4; ++s) *(u32x4v*)(p0 + (size_t)(16 * h4 + 4 * s) * c.ld) = raw[s];
        }
    }
}
}
namespace fw {
__device__ __forceinline__ gla::Ctx gla_base(ArgP A, int i) {
    gla::Ctx X; X.P = (const gla::bf16*)(A->ws + WS_PROJ); X.DEC = (float*)(A->ws + WS_DEC); X.LR = (const float*)(A->ws + WS_LR); X.gkw = A->in[I_GKW] + (size_t)i * 2 * 16 * 256; X.gkb = A->in[I_GKB] + (size_t)i * 512; X.mbase = 0; X.h = 0; X.bh = 0;
    X.US = (gla::bf16*)(A->ws + WS_US); X.SB = (gla::bf16*)(A->ws + WS_SB); X.DD = (float*)(A->ws + WS_DD); X.MIX = (gla::bf16*)(A->ws + WS_MIX); X.gg = A->in[I_GLAG] + i * 64; return X;
}
__device__ __forceinline__ int q_next(gu32* ctr, volatile LAS unsigned* slot, int tid) {
    __syncthreads();
    if (tid == 0) slot[0] = __hip_atomic_fetch_add(ctr, 1u, RLX_AGENT);
    __syncthreads();
    return (int)slot[0];
}
__device__ __forceinline__ void mixer_even(ArgP A, int l, LAS unsigned char* ldsl, char* lds, volatile LAS unsigned* MISC, int tid, int rep) {
    const int i = l >> 1; gu32* ctr = (gu32*)(A->ws + WS_CTL) + CW_Q + 64 * l + 16 * rep;
    const ab::bf16* P = (const ab::bf16*)(A->ws + WS_PROJ); ab::bf16* MIXp = (ab::bf16*)(A->ws + WS_MIX);
    constexpr int NSCAN = 64;
    const int total = NSCAN + 512 + 64;
    int qi = q_next(ctr, MISC + 16, tid);
    while (qi < total) {
        const int idx = qi - NSCAN;
        if (idx < 0) {
#ifndef NO_GLA
            { int t_ = tid; asm volatile("" : "+v"(t_)); const int sidx = idx + NSCAN;
              const gla::Ctx X = gla::ctx_of(gla_base(A, i), sidx); gla::unit_b(X, (__attribute__((address_space(3))) char*)ldsl, t_);
            }
#endif
        } else {
            ab::AUnit U; int b, head, j;
            if (idx < 512) { const int r = idx; b = r >> 6; head = (r >> 3) & 7; j = r & 7; U.r1 = 0; U.NT = 36; }
            else { const int r = idx - 512; b = r >> 3; head = r & 7; j = 8; U.r1 = SEQ; U.NT = 4; }
            const size_t row0 = (size_t)b * RB, qrow = row0 + 256 * j;
            U.Q = P + qrow * LDE + E_BQ + 64 * head; U.K = P + row0 * LDE + E_BK + 64 * (head >> 2); U.V = P + row0 * LDE + E_BV + 64 * (head >> 2);
            U.O = MIXp + qrow * 1024 + 512 + 64 * head; U.r2 = 0; U.q0 = 256 * j; U.sink2 = -INFINITY; U.sinkv = nullptr; U.qgain = A->in[I_QNG] + i * 64; U.tab = j < 8 ? (const float2*)(A->ws + WS_TAB) : nullptr;
#ifndef NO_ATTB
            { int t_ = tid; asm volatile("" : "+v"(t_)); ab::attn_unit<LDE, 0, 8, false>(U, lds, t_); }
#endif
        }
        qi = q_next(ctr, MISC + 16, tid);
    }
}
__device__ __forceinline__ void mixer_odd(ArgP A, int l, bool with_ctx, char* lds, volatile LAS unsigned* MISC, int tid, int rep, int vcu, int G) {
    const int i = l >> 1; (void)MISC; (void)rep;
    const ab::bf16* P = (const ab::bf16*)(A->ws + WS_PROJ); ab::bf16* MIXp = (ab::bf16*)(A->ws + WS_MIX);
    const int total = 1024 + (with_ctx ? 128 : 0);
    int idx = vcu; bool in_ctx = false;
    if (idx >= 1024) { idx = 1024 + vcu; in_ctx = true; }
    while (idx < total) {
        ab::AUnit U; int b, kvh, q0; bool latent;
        U.r1 = SEQ;
        if (idx < 1024) { b = idx >> 7; kvh = (idx >> 6) & 1; q0 = 32 * (idx & 63); latent = true;
            int lo = max(0, (q0 - 128) & ~63), hi = min(SEQ, ((q0 + 159) | 63) + 1);
            U.r2 = lo; U.NT = 4 + (hi - lo) / 64; }
        else { const int r = idx - 1024; b = r >> 4; kvh = (r >> 3) & 1; q0 = SEQ + 32 * (r & 7); latent = false; U.r2 = 0; U.NT = 4; }
        const size_t row0 = (size_t)b * RB, qrow = row0 + q0;
        U.Q = P + qrow * LDO + O_Q + 512 * kvh; U.K = P + row0 * LDO + O_K + 64 * kvh; U.V = P + row0 * LDO + O_V + 64 * kvh;
        U.O = MIXp + qrow * 1024 + 512 * kvh; U.q0 = q0; U.sink2 = 0.f; U.sinkv = A->in[I_SINK] + i * 16 + 8 * kvh; U.qgain = nullptr; U.tab = latent ? (const float2*)(A->ws + WS_TAB) : nullptr;
#ifndef NO_ATTC
        { int t_ = tid; asm volatile("" : "+v"(t_)); ab::attn_unit<LDO, 1, 8, true>(U, lds, t_); }
#endif
        if (!in_ctx) { idx += G; if (idx >= 1024) { idx = 1024 + vcu; in_ctx = true; } } else idx += G;
    }
}

#ifndef REPEAT_N
#define REPEAT_N 1
#endif
#ifndef REPEAT_PARITY
#define REPEAT_OK(ph) true
#else
#define REPEAT_OK(ph) ((ph) == 0 || (ph) == N_PHASES - 1 || (((((ph) - 1) / PH_PER_LAYER) & 1) == REPEAT_PARITY))
#endif
#ifndef KSPLIT_DOWN
#define KSPLIT_DOWN 8
#endif
__global__ void __launch_bounds__(NWAVES * 64, 2) fwd(Args A_) {
    extern __shared__ __attribute__((aligned(16))) unsigned char lds[];
    LAS unsigned char* ldsl = (LAS unsigned char*)lds;
    volatile LAS unsigned* MISC = (volatile LAS unsigned*)(ldsl + MISC_OFF);
    for (int u = threadIdx.x; u < (LDS_BYTES - GLA_LDS_BYTES) / 4; u += NWAVES * 64) ((LAS unsigned*)(ldsl + GLA_LDS_BYTES))[u] = 0u;
    __syncthreads();
    const int wave_s = __builtin_amdgcn_readfirstlane(threadIdx.x >> 6);
    const int ph_lo = A_.ph_lo, ph_hi = A_.ph_hi;
    gu32* ctl = (gu32*)(A_.ws + WS_CTL);
    XcdBarrier bar; bar.bar = (unsigned*)(ctl + CW_BAR); bar.x = 0; bar.st = nullptr;
    const bool multi = (ph_hi - ph_lo) > 1;
    if (multi) bar = xcd_barrier_post((unsigned*)(ctl + CW_BAR), MISC + 8);
    int rep_ = 0;
#pragma nounroll
    for (int ph = ph_lo; ph < ph_hi; ++ph) {
        if (!phase_active(ph)) continue;
        ArgP A = (ArgP)__builtin_amdgcn_kernarg_segment_ptr(); asm volatile("" : "+s"(A));
        const int lane = olane(), wave = wave_s, tid = wave * 64 + lane;
        const int G = ogrid(), bx = obid(), vcu = (G % 8 == 0) ? (bx % 8) * (G / 8) + bx / 8 : bx;
        const int gw = vcu * NWAVES + wave, NGW = G * NWAVES;
        if (ph == 0) {
#ifndef NO_P0M
            p0_mods(A, ldsl, 0, 1, vcu, G, tid, lane, wave);
#endif
            __syncthreads();
#ifndef NO_P0W
            conv_layer(A, 0, ldsl, gw, NGW, lane, wave);
#endif
#ifndef NO_P0T
            if (vcu == G - 1) p0_tab(A, tid);
#endif
        } else if (ph == N_PHASES - 1) {
            final_phase(A, gw, NGW, lane);
        } else {
            const int l = (ph - 1) / PH_PER_LAYER, s = (ph - 1) - l * PH_PER_LAYER, i = l >> 1; const bool odd = l & 1, with_ctx = l < DEPTH - 1;
            unsigned char* wl = A->ws + WS_W + w_layer_off(l); const size_t w_in_b = odd ? W_IN_O : W_IN_E;
            const float* mod = (const float*)(A->ws + WS_MOD) + (size_t)l * 9 * 6144;
            if (s == S_NORM1) { cb_layer(A, 0, ldsl, gw, NGW, tid, lane); xg_phase(A, gw, NGW, lane); }
            else if (s == S_G1) {
                pg8::Gemm g{(const pg8::bf16_t*)(A->ws + WS_HN), (const pg8::bf16_t*)wl, M, odd ? LDO : LDE, D, (float*)(A->ws + WS_SLAB), (unsigned*)(A->ws + WS_CTL) + CW_SPLIT + (4 * l + 0) * 2048};
                pg8::RowSched S; S.init(0, odd ? LDO : LDE, G, bx, D);
                rtab_build(S, (const float*)(A->ws + WS_SQ), (LAS float*)(ldsl + RTAB_OFF), tid);
                const fwpost::Ctx pc{(unsigned short*)(A->ws + WS_PROJ), odd ? LDO : LDE, odd ? 0 : 1, A->in[I_QNG] + i * 64, A->in[I_KNG] + i * 64, (const float2*)(A->ws + WS_TAB), (const float*)(A->ws + WS_LR),
                                     (float*)(A->ws + WS_DEC), A->in[I_GKW] + (size_t)i * 2 * 16 * 256, A->in[I_GKB] + (size_t)i * 512};
                pg8::EpiProj E{(pg8::bf16_t*)(A->ws + WS_PROJ), odd ? LDO : LDE, (float*)(A->ws + WS_LR), odd ? -1 : 9, (const LAS float*)(ldsl + RTAB_OFF), (const float*)(A->ws + WS_CB), LDE, &pc, odd ? 4 : 8, odd ? 4 : 8};
#ifndef NO_G1
                pg8::gemm_phase<pg8::EpiProj, pg8::RowSched, true, true>(ldsl, g, S, E, tid);
#endif
            }
            else if (s == S_GLAA) { gla::phase_a(gla_base(A, i), (__attribute__((address_space(3))) char*)ldsl, gw, NGW, wave, lane); }
            else if (s == S_GLAC) { gla::phase_c(gla_base(A, i), (__attribute__((address_space(3))) char*)ldsl, gw, NGW, wave, lane); }
            else if (s == S_MIX) { if (odd) mixer_odd(A, l, with_ctx, (char*)lds, MISC, tid, rep_, vcu, G); else mixer_even(A, l, ldsl, (char*)lds, MISC, tid, rep_); }
            else {
                const bool do_resid = s == S_G2 || s == S_G4 || (s == S_G3 && with_ctx && rep_ == 0), do_up = s == S_G3 || s == S_G3B;
                {
                    const bool down = s == S_G4; const int rows = s == S_G2 ? 1 : (s == S_G3 ? 2 : (with_ctx ? 0 : 1));
                    int t_ = tid; asm volatile("" : "+v"(t_));
                    if (do_resid) {
                        int busy_ = 0;
#pragma nounroll
                        for (int pass = 0; pass < 2; ++pass) {
                        int tp_ = wave * 64 + olane(); asm volatile("" : "+v"(tp_));
                        pg8::Gemm g{(const pg8::bf16_t*)(A->ws + (down ? WS_H : WS_MIX)), (const pg8::bf16_t*)(wl + w_in_b + (down ? W_OUT + W_13 : 0)), M, D, down ? FFH : D, (float*)(A->ws + WS_SLAB), (unsigned*)(A->ws + WS_CTL) + CW_SPLIT + (4 * l + (down ? 3 : 1)) * 2048};
                        pg8::RowSched S; S.init(rows, D, G, bx, down ? FFH : D, down ? KSPLIT_DOWN : 1);
#ifdef DOWN_TWO_PASS
                        const bool two = S.sp > 1;
#else
                        const bool two = false;
#endif
                        if (pass == 1 && !two) break;
                        if (two) { if (pass == 0) S.i_hi = S.R - 1; else S.i_lo = S.R - 1; }
                        busy_ = S.sp > 1 ? S.rem * S.sp : (S.rem < G ? S.rem : 0);
#ifdef REPEAT_MASK
                        const bool dry_ = ((REPEAT_MASK >> s) & 1) && rep_ < REPEAT_N && REPEAT_OK(ph) && s != S_G3;
#endif
                        const bool emit = !(down && l + 1 == DEPTH); const int nl = down ? l + 1 : l;
                        const bool last = down && l + 1 == DEPTH;
                        pg8::bf16_t* XB = (pg8::bf16_t*)A->out; pg8::bf16_t* XM = (pg8::bf16_t*)(A->ws + WS_XMID);
                        pg8::bf16_t* xo = last ? (pg8::bf16_t*)(A->ws + WS_HN) : (down ? XB : XM);
#ifdef REPEAT_MASK
                        if (dry_) xo = (pg8::bf16_t*)(A->ws + WS_SLAB);
#endif
                        pg8::EpiResid E{down ? XM : XB, xo, mod + (down ? 5 : 2) * D,
                                        emit, (pg8::bf16_t*)(A->ws + WS_HN), (float*)(A->ws + WS_SQ), (down ? A->in[I_N1G] : A->in[I_N2G]) + (size_t)(emit ? nl : 0) * D,
                                        (const float*)(A->ws + WS_MOD) + (size_t)(emit ? nl : 0) * 9 * 6144 + (down ? 1 : 4) * D, ldsl};
#ifndef NO_G2
                        pg8::gemm_phase<pg8::EpiResid, pg8::RowSched, true, true>(ldsl, g, S, E, tp_);
#endif
                        }
                        if (down && l + 1 < DEPTH && rep_ == 0) {
                            const int busy = busy_;
                            const bool all = busy >= G || busy == 0, mine = all || bx >= busy;
                            const int ln2 = olane();
                            cb_layer(A, l + 1, ldsl, mine ? (all ? gw : (bx - busy) * NWAVES + wave) : -1, all ? NGW : (G - busy) * NWAVES, wave * 64 + ln2, ln2);
                        }
                    }
                }
                {
                    const int rows = s == S_G3 ? 1 : 2, skew = (s == S_G3 && with_ctx) ? 32 : 0;
                    int t_ = tid; asm volatile("" : "+v"(t_));
                    if (do_up) {
                        pg8::Gemm g{(const pg8::bf16_t*)(A->ws + WS_HN), (const pg8::bf16_t*)(wl + w_in_b + W_OUT), M, 2 * FFH, D, (float*)(A->ws + WS_SLAB), (unsigned*)(A->ws + WS_CTL) + CW_SPLIT + (4 * l + 2) * 2048};
                        pg8::RowSched S; S.init(rows, 2 * FFH, G, bx, D, 1, skew);
                        rtab_build(S, (const float*)(A->ws + WS_SQ), (LAS float*)(ldsl + RTAB_OFF), t_);
                        pg8::EpiSwiglu E{(pg8::bf16_t*)(A->ws + WS_H), FFH, (const LAS float*)(ldsl + RTAB_OFF), (const float*)(A->ws + WS_CB) + (size_t)9 * LDE, 2 * FFH};
#ifndef NO_G3
                        pg8::gemm_phase<pg8::EpiSwiglu, pg8::RowSched, true, true>(ldsl, g, S, E, t_);
#endif
                        if (s == S_G3 && skew > 0 && l + 1 < DEPTH && rep_ == 0 && bx < skew) { const int ln2 = olane(); p0_mods(A, ldsl, l + 1, 1, bx, skew, wave * 64 + ln2, ln2, wave); }
                        if (s == S_G3B && rep_ == 0) {
                            const int busy = S.so.nwg < G ? S.so.nwg : G;
                            const int ln2 = olane();
                            if (busy >= G) conv_layer(A, l + 1, ldsl, gw, NGW, ln2, wave); else if (bx >= busy) conv_layer(A, l + 1, ldsl, (bx - busy) * NWAVES + wave, (G - busy) * NWAVES, ln2, wave);
                        }
                    }
                }
            }
        }
#ifdef REPEAT_BAR
        if (ph + 1 < ph_hi) xcd_barrier(bar, tid == 0);
#endif
#ifdef REPEAT_MASK
        { const int s_ = (ph == 0) ? 12 : (ph == N_PHASES - 1 ? 13 : ((ph - 1) % PH_PER_LAYER)); if (((REPEAT_MASK >> s_) & 1) && rep_ < REPEAT_N && REPEAT_OK(ph)) { ++rep_; --ph; xcd_barrier(bar, tid == 0); continue; } rep_ = 0; }
#endif
        if (ph + 1 < ph_hi) xcd_barrier(bar, tid == 0);
    }
}

inline int grid_size() {
    static int grid = 0;
    if (grid == 0) {
        int dev = 0, cus = 0, per_cu = 0;
        if (hipGetDevice(&dev) != hipSuccess || hipDeviceGetAttribute(&cus, hipDeviceAttributeMultiprocessorCount, dev) != hipSuccess) { grid = -1; return grid; }
        if (hipFuncSetAttribute((const void*)fwd, hipFuncAttributeMaxDynamicSharedMemorySize, LDS_BYTES) != hipSuccess) { grid = -1; return grid; }
        if (hipOccupancyMaxActiveBlocksPerMultiprocessor(&per_cu, (const void*)fwd, NWAVES * 64, LDS_BYTES) != hipSuccess || per_cu < 1) per_cu = 1;
        (void)hipGetLastError();
        grid = cus;
    }
    return grid;
}
inline void launch_phases(hipStream_t st, const Args& a0, int lo, int hi) { Args a = a0; a.ph_lo = lo; a.ph_hi = hi; hipLaunchKernelGGL(fwd, dim3(grid_size()), dim3(NWAVES * 64), LDS_BYTES, st, a); }
inline Args make_args(void* const* d_in, void* d_out, void* d_ws) { Args a{}; for (int i = 0; i < 22; ++i) a.in[i] = (const float*)d_in[i]; a.out = (float*)d_out; a.ws = (unsigned char*)d_ws; return a; }
}
#ifndef MK_PER_PHASE
#define MK_PER_PHASE 1
#endif
extern "C" void kernel_launch(void* const* d_in, const int* in_sizes, int n_in, void* d_out, int out_size, void* d_ws, size_t ws_size, hipStream_t stream) {
    if (fw::grid_size() <= 0 || ws_size < fw::WS_END) return;
    (void)hipMemsetAsync((char*)d_ws + fw::WS_CTL, 0, fw::CTL_ZERO_BYTES, stream);
    const fw::Args a = fw::make_args(d_in, d_out, d_ws);
#if MK_PER_PHASE
    for (int ph = 0; ph < fw::N_PHASES; ++ph) if (fw::phase_active(ph)) fw::launch_phases(stream, a, ph, ph + 1);
#else
    fw::launch_phases(stream, a, 0, fw::N_PHASES);
#endif
}
```

```cpp
#define P0_DEFER 1
#define DEC_BF16 1
#define SLAB_BF16 1
#define DOWN_TWO_PASS 1
#define RESID_VIA_LDS 1
#define MK_PER_PHASE 0
#define KSPLIT_DOWN 4
#include <hip/hip_runtime.h>
#include <hip/hip_bf16.h>
#include <cstdio>
#include <cstdint>
#include <cmath>
namespace cfg {
constexpr int D = 1024, NB = 8, SEQ = 2048, CTX = 256, RB = SEQ + CTX  , M = NB * RB  , FFH = 2816;
constexpr int LDE = 2560  , LDO = 1280, DEPTH = 4;
constexpr float EPS = 1e-6f, LOG2E = 1.4426950408889634f, C2 = 0.125f * 1.4426950408889634f;
constexpr int E_GQ = 0, E_GK = 256, E_GV = 512, E_GG = 1024, E_BQ = 1536, E_BK = 2048, E_BV = 2176, E_LR = 2304;
constexpr int O_Q = 0, O_K = 1024, O_V = 1152;
}
__device__ __forceinline__ int olane() { int l; asm volatile("v_mbcnt_lo_u32_b32 %0, -1, 0\n\tv_mbcnt_hi_u32_b32 %0, -1, %0" : "=v"(l)); return l; }
__device__ __forceinline__ int obid() { int b = blockIdx.x; asm volatile("" : "+s"(b)); return b; }
__device__ __forceinline__ int ogrid() { int g = gridDim.x; asm volatile("" : "+s"(g)); return g; }
namespace xl {
template <int CTRL> __device__ __forceinline__ float dpp_mov(float v) { return __builtin_bit_cast(float, __builtin_amdgcn_update_dpp(0, __builtin_bit_cast(int, v), CTRL, 0xf, 0xf, false)); }
__device__ __forceinline__ float xor1(float v) { return dpp_mov<0xB1>(v); }
__device__ __forceinline__ float xor2(float v) { return dpp_mov<0x4E>(v); }
__device__ __forceinline__ float xor16(float v) { return __builtin_bit_cast(float, __builtin_amdgcn_ds_swizzle(__builtin_bit_cast(int, v), 0x401F)); }
__device__ __forceinline__ float add_xor32(float v) { const unsigned u = __builtin_bit_cast(unsigned, v); auto r = __builtin_amdgcn_permlane32_swap(u, u, false, false); return __builtin_bit_cast(float, (unsigned)r[0]) + __builtin_bit_cast(float, (unsigned)r[1]); }
__device__ __forceinline__ float sum8(float v) { v += xor1(v); v += xor2(v); v += dpp_mov<0x141>(v); return v; }
__device__ __forceinline__ float sum16(float v) { v = sum8(v); v += dpp_mov<0x140>(v); return v; }
__device__ __forceinline__ float sum64(float v) { v = sum16(v);
    const int i = __builtin_bit_cast(int, v);
    return (__builtin_bit_cast(float, __builtin_amdgcn_readlane(i, 0)) + __builtin_bit_cast(float, __builtin_amdgcn_readlane(i, 16))) + (__builtin_bit_cast(float, __builtin_amdgcn_readlane(i, 32)) + __builtin_bit_cast(float, __builtin_amdgcn_readlane(i, 48))); }
}
namespace fwpost { struct Ctx; __device__ __forceinline__ void run(const Ctx& c, int pm, int pn, int tid); }
namespace pg8 {
#define PG8_LAS __attribute__((address_space(3)))
typedef unsigned short bf16_t;
typedef short bf16x8 __attribute__((ext_vector_type(8)));
typedef float f32x4 __attribute__((ext_vector_type(4)));
typedef unsigned u32x4 __attribute__((ext_vector_type(4)));
constexpr int BM = 256, BK = 64, HALF = 128, HTB = HALF * BK * 2  , STAGE_BYTES = 8 * HTB, NXCD = 8, WGM = 8;

__host__ __device__ __forceinline__ int lds_byte(int r, int c) { const int st = (r >> 4) * 2 + (c >> 5), rr = r & 15, cc = c & 31, ob = rr * 64 + cc * 2; return st * 1024 + (ob ^ (((ob >> 9) & 1) << 5)); }
__host__ __device__ __forceinline__ void stage_rc(int b, int& R, int& C) { const int st = b / 1024, sb = b % 1024, swz = sb ^ (((sb >> 9) & 1) << 5); R = (st >> 1) * 16 + swz / 64; C = (st & 1) * 32 + (swz % 64) / 2; }
__host__ __device__ __forceinline__ int perm32(int rho) { const int n = rho >> 4, i = rho & 15; return 8 * (i >> 2) + 4 * n + (i & 3); }

struct Unit { int pm, pn; int kt0, nkt, sp, sl, ul, ord; int rl; };
struct Gemm { const bf16_t* A; const bf16_t* Bt; int M, N, K; float* slab; unsigned* cnt; };

struct StaticOrder {
    int nM, nN, nwg, G, c;
    __host__ __device__ void init(int M, int N, int G_, int c_) { nM = M / BM; nN = N / BM; nwg = nM * nN; G = G_; c = c_; }
    __host__ __device__ bool next(int i, Unit& u) const { return at((long)i * G + c, u); }
    __host__ __device__ bool at(const long L, Unit& u) const {
        if (L >= nwg) return false;
        int wgid = (int)L; { const int q = nwg / NXCD, r = nwg % NXCD, xcd = wgid % NXCD, off = wgid / NXCD; wgid = (xcd < r ? xcd * (q + 1) : r * (q + 1) + (xcd - r) * q) + off; }
        const int nig = WGM * nN, gid = wgid / nig, fm = gid * WGM, gsz = (nM - fm) < WGM ? (nM - fm) : WGM;
        u.pm = fm + ((wgid % nig) % gsz); u.pn = (wgid % nig) / gsz; return true;
    }
    __device__ __forceinline__ void a_ready(const Unit&) const {}
    __device__ __forceinline__ void done(const Unit&) const {}
};

__device__ __forceinline__ unsigned cvt_pk_bf16(float lo, float hi) { unsigned r; asm volatile("v_cvt_pk_bf16_f32 %0, %1, %2" : "=v"(r) : "v"(lo), "v"(hi)); return r; }
__device__ __forceinline__ int batch_kind(int pm) { const int b = pm / 9; return (pm - 9 * b) < 8 ? b : 8; }
struct EpiProj {
    static constexpr bool PERM = true, AFTER_DRAIN = false, PAIR = false, CAN_SPLIT = false, RESID_LDS = false; static constexpr int SLAB_W = 256;
    bf16_t* O; int ldc; float* LR; int lr_pn; const PG8_LAS float* rtab; const float* cb; int ncb;
    const fwpost::Ctx* pc; int post_lo, post_hi;
    static constexpr bool HAS_POST = true;
    __device__ __forceinline__ bool needs_post(const Unit& u) const { return u.pn >= post_lo && u.pn <= post_hi; }
    __device__ __forceinline__ void post(const Unit& u, int tid) const { fwpost::run(*pc, u.pm, u.pn, tid); }
    __device__ __forceinline__ void operator()(const f32x4 (&acc)[2][2][4][2], const Unit& u, int wr, int wc, int fr_in, int fq_in) const {
        int fr = fr_in, fq = fq_in; asm volatile("" : "+v"(fr), "+v"(fq));
        const int row0 = u.pm * BM + wr * 64 + fr; const PG8_LAS float* rt = rtab + u.ord * 256 + wr * 64 + fr;
        const int col0 = u.pn * BM + wc * 32 + 8 * fq; const float* cbv = cb + (size_t)batch_kind(u.pm) * ncb + col0;
        if (u.pn == lr_pn) {
            if (wc == 0) { const f32x4 c0 = *(const f32x4*)cbv, c1 = *(const f32x4*)(cbv + 4);
#pragma unroll
                for (int ai = 0; ai < 2; ++ai)
#pragma unroll
                    for (int m = 0; m < 4; ++m) { const float r = rt[ai * HALF + m * 16]; float* p = LR + (size_t)(row0 + ai * HALF + m * 16) * 32 + 8 * fq; *(f32x4*)p = acc[ai][0][m][0] * r + c0; *(f32x4*)(p + 4) = acc[ai][0][m][1] * r + c1; }
            }
            return;
        }
        f32x4 cv[2][2];
#pragma unroll
        for (int bj = 0; bj < 2; ++bj)
#pragma unroll
            for (int n = 0; n < 2; ++n) cv[bj][n] = *(const f32x4*)(cbv + bj * HALF + 4 * n);
#pragma unroll
        for (int ai = 0; ai < 2; ++ai)
#pragma unroll
            for (int m = 0; m < 4; ++m) { bf16_t* rowp = O + (size_t)(row0 + ai * HALF + m * 16) * ldc + col0; const float r = rt[ai * HALF + m * 16];
#pragma unroll
                for (int bj = 0; bj < 2; ++bj) { const f32x4 v0 = acc[ai][bj][m][0] * r + cv[bj][0], v1 = acc[ai][bj][m][1] * r + cv[bj][1];
                    u32x4 w; w.x = cvt_pk_bf16(v0[0], v0[1]); w.y = cvt_pk_bf16(v0[2], v0[3]); w.z = cvt_pk_bf16(v1[0], v1[1]); w.w = cvt_pk_bf16(v1[2], v1[3]);
                    *(u32x4*)(rowp + bj * HALF) = w; } }
    }
};
__device__ __forceinline__ float silu_mul(float a, float b) { return a * __builtin_amdgcn_rcpf(1.f + __builtin_amdgcn_exp2f(-1.4426950408889634f * a)) * b; }
__device__ __forceinline__ f32x4 silu_mul4(const f32x4 a, const f32x4 b) {
    const f32x4 t = a * -1.4426950408889634f; f32x4 e;
    e[0] = __builtin_amdgcn_exp2f(t[0]); e[1] = __builtin_amdgcn_exp2f(t[1]); e[2] = __builtin_amdgcn_exp2f(t[2]); e[3] = __builtin_amdgcn_exp2f(t[3]);
    const f32x4 d = e + 1.f; f32x4 r;
    r[0] = __builtin_amdgcn_rcpf(d[0]); r[1] = __builtin_amdgcn_rcpf(d[1]); r[2] = __builtin_amdgcn_rcpf(d[2]); r[3] = __builtin_amdgcn_rcpf(d[3]);
    return (a * b) * r;
}
struct EpiSwiglu {
    static constexpr bool PERM = true, AFTER_DRAIN = false, PAIR = true, CAN_SPLIT = false, RESID_LDS = false; static constexpr int SLAB_W = 128;
    bf16_t* H; int ldh; const PG8_LAS float* rtab; const float* cb; int ncb;
    static constexpr bool HAS_POST = false;
    __device__ __forceinline__ void operator()(const f32x4 (&acc)[2][2][4][2], const Unit& u, int wr, int wc, int fr_in, int fq_in) const {
        int fr = fr_in, fq = fq_in; asm volatile("" : "+v"(fr), "+v"(fq));
        const int row0 = u.pm * BM + wr * 64 + fr, col0 = u.pn * HALF + wc * 32 + 8 * fq; const PG8_LAS float* rt = rtab + u.ord * 256 + wr * 64 + fr;
        const float* cbv = cb + (size_t)batch_kind(u.pm) * ncb + u.pn * BM + wc * 32 + 8 * fq;
        const f32x4 ca0 = *(const f32x4*)cbv, ca1 = *(const f32x4*)(cbv + 4), cb0 = *(const f32x4*)(cbv + HALF), cb1 = *(const f32x4*)(cbv + HALF + 4);
#pragma unroll
        for (int ai = 0; ai < 2; ++ai)
#pragma unroll
            for (int m = 0; m < 4; ++m) { const float r = rt[ai * HALF + m * 16];
                const f32x4 a0 = acc[ai][0][m][0] * r + ca0, a1 = acc[ai][0][m][1] * r + ca1, b0 = acc[ai][1][m][0] * r + cb0, b1 = acc[ai][1][m][1] * r + cb1;
                const f32x4 s0 = silu_mul4(a0, b0), s1 = silu_mul4(a1, b1);
                u32x4 w; w.x = cvt_pk_bf16(s0[0], s0[1]); w.y = cvt_pk_bf16(s0[2], s0[3]); w.z = cvt_pk_bf16(s1[0], s1[1]); w.w = cvt_pk_bf16(s1[2], s1[3]);
                *(u32x4*)(H + (size_t)(row0 + ai * HALF + m * 16) * ldh + col0) = w; }
    }
};
#ifndef RESID_GRP
#define RESID_GRP 2
#endif
struct EpiResid {
#ifdef RESID_VIA_LDS
    static constexpr bool PERM = true, AFTER_DRAIN = false, PAIR = false, CAN_SPLIT = true, RESID_LDS = true; static constexpr int SLAB_W = 256;
#else
    static constexpr bool PERM = true, AFTER_DRAIN = false, PAIR = false, CAN_SPLIT = true, RESID_LDS = false; static constexpr int SLAB_W = 256;
#endif
    const bf16_t* xin_b; bf16_t* xout_b; const float* gate_base;
    bool emit; bf16_t* XG; float* SQ; const float* ngain; const float* nscale_base;
    const PG8_LAS unsigned char* ring;
    __device__ __forceinline__ const char* res_base(const Unit& u) const { return (const char*)(xin_b + (size_t)u.pm * BM * 1024 + u.pn * BM); }
    __device__ __forceinline__ static constexpr int rbuf(int g) { return (g == 0 ? 4 : g == 1 ? 5 : g == 2 ? 0 : g == 3 ? 1 : g == 4 ? 6 : g == 5 ? 7 : 2) * HTB; }
    static constexpr bool HAS_POST = false;
    typedef unsigned u32x2 __attribute__((ext_vector_type(2)));
    __device__ __forceinline__ static f32x4 up4(unsigned a, unsigned b) { return (f32x4){__builtin_bit_cast(float, a << 16), __builtin_bit_cast(float, a & 0xffff0000u), __builtin_bit_cast(float, b << 16), __builtin_bit_cast(float, b & 0xffff0000u)}; }
    __device__ __forceinline__ void slab(const Unit& u, int row, int c, const f32x4 v, const f32x4) const {
        const int bk = batch_kind(u.pm); const int col = u.pn * BM + c; const size_t m = (size_t)u.pm * BM + row;
        const u32x2 w = *(const u32x2*)(xin_b + m * 1024 + col);
        const f32x4 xn = up4(w[0], w[1]) + *(const f32x4*)(gate_base + 6144 * bk + col) * v;
        *(u32x2*)(xout_b + m * 1024 + col) = (u32x2){cvt_pk_bf16(xn[0], xn[1]), cvt_pk_bf16(xn[2], xn[3])};
        if (emit) {
            const f32x4 gv = *(const f32x4*)(ngain + col) * (*(const f32x4*)(nscale_base + 6144 * bk + col) + 1.f), xg = xn * gv;
            *(u32x2*)(XG + m * 1024 + col) = (u32x2){cvt_pk_bf16(xg[0], xg[1]), cvt_pk_bf16(xg[2], xg[3])};
            float ss = (xn[0] * xn[0] + xn[1] * xn[1]) + (xn[2] * xn[2] + xn[3] * xn[3]);
            ss = xl::sum64(ss);
            if (c < 16) SQ[m * 16 + u.pn * 4 + (c >> 2)] = (c == 0) ? ss : 0.f;
        }
    }
    __device__ __forceinline__ void operator()(const f32x4 (&acc)[2][2][4][2], const Unit& u, int wr, int wc, int fr_in, int fq_in) const {
        int fr = fr_in, fq = fq_in; asm volatile("" : "+v"(fr), "+v"(fq));
        const int bk = batch_kind(u.pm);
        const int col0 = u.pn * BM + wc * 32 + 8 * fq;
        const bf16_t* xib = xin_b + (size_t)u.pm * BM * 1024 + col0; bf16_t* xob = xout_b + (size_t)u.pm * BM * 1024 + col0;
        const float* gate = gate_base + 6144 * bk + col0;
        f32x4 gv[2][2], nv[2][2];
#pragma unroll
        for (int bj = 0; bj < 2; ++bj)
#pragma unroll
            for (int n = 0; n < 2; ++n) { gv[bj][n] = *(const f32x4*)(gate + bj * HALF + n * 4);
                if (emit) nv[bj][n] = *(const f32x4*)(ngain + col0 + bj * HALF + n * 4) * (*(const f32x4*)(nscale_base + 6144 * bk + col0 + bj * HALF + n * 4) + 1.f); }
        bf16_t* xg = XG + (size_t)u.pm * BM * 1024 + col0; float* sq = SQ + (size_t)u.pm * BM * 16 + u.pn * 4 + wc;
        u32x4 x7[2]; x7[0] = (u32x4){0u, 0u, 0u, 0u}; x7[1] = x7[0];
        if (RESID_LDS && u.rl) {
#pragma unroll
            for (int bj = 0; bj < 2; ++bj) x7[bj] = *(const u32x4*)(xib + (size_t)(HALF + wr * 64 + 48 + fr) * 1024 + bj * HALF); }
#pragma unroll
        for (int q0 = 0; q0 < 8; q0 += RESID_GRP) {
            u32x4 xv[RESID_GRP][2];
#pragma unroll
            for (int q = 0; q < RESID_GRP; ++q) { const int ai = (q0 + q) >> 2, m = (q0 + q) & 3; const size_t ro = (size_t)(ai * HALF + wr * 64 + m * 16 + fr) * 1024;
                if (RESID_LDS && u.rl) {
#pragma unroll
                    for (int bj = 0; bj < 2; ++bj) xv[q][bj] = q0 + q < 7 ? *(const PG8_LAS u32x4*)(ring + rbuf(q0 + q < 7 ? q0 + q : 0) + (wr * 16 + fr) * 512 + (((wc * 4 + fq + bj * 16) ^ fr) * 16)) : x7[bj];
                } else {
#pragma unroll
                    for (int bj = 0; bj < 2; ++bj) xv[q][bj] = *(const u32x4*)(xib + ro + bj * HALF); } }
#pragma unroll
            for (int q = 0; q < RESID_GRP; ++q) { const int ai = (q0 + q) >> 2, m = (q0 + q) & 3; const int rt = ai * HALF + wr * 64 + m * 16 + fr; const size_t ro = (size_t)rt * 1024; float ss = 0.f;
#pragma unroll
                for (int bj = 0; bj < 2; ++bj) { const f32x4 x0 = up4(xv[q][bj][0], xv[q][bj][1]) + gv[bj][0] * acc[ai][bj][m][0], x1 = up4(xv[q][bj][2], xv[q][bj][3]) + gv[bj][1] * acc[ai][bj][m][1];
                    *(u32x4*)(xob + ro + bj * HALF) = (u32x4){cvt_pk_bf16(x0[0], x0[1]), cvt_pk_bf16(x0[2], x0[3]), cvt_pk_bf16(x1[0], x1[1]), cvt_pk_bf16(x1[2], x1[3])};
                    if (emit) { const f32x4 y0 = x0 * nv[bj][0], y1 = x1 * nv[bj][1];
                        *(u32x4*)(xg + ro + bj * HALF) = (u32x4){cvt_pk_bf16(y0[0], y0[1]), cvt_pk_bf16(y0[2], y0[3]), cvt_pk_bf16(y1[0], y1[1]), cvt_pk_bf16(y1[2], y1[3])};
                        ss += ((x0[0] * x0[0] + x0[1] * x0[1]) + (x0[2] * x0[2] + x0[3] * x0[3])) + ((x1[0] * x1[0] + x1[1] * x1[1]) + (x1[2] * x1[2] + x1[3] * x1[3])); } }
                if (emit) { ss += xl::xor16(ss); ss = xl::add_xor32(ss); if (fq == 0) sq[(size_t)rt * 16] = ss; } }
            asm volatile("" ::: "memory");
        }
    }
};
struct RowSched {
    StaticOrder so; int mode; int G, c, R, rem, sp, npairs, skew, lead, a; int i_lo = 0, i_hi = 0x7fffffff;
    __device__ void init(int mode_, int N, int G_, int c_, int K, int max_sp = 1, int skew_ = 0) {
        mode = mode_; so.init((mode_ == 0 ? 72 : (mode_ == 1 ? 64 : 8)) * BM, N, G_, c_); G = G_; c = c_; npairs = K / (2 * BK); skew = skew_;
        R = (so.nwg + G - 1) / G; rem = so.nwg - (R - 1) * G; sp = rem < G ? G / rem : 1; if (sp > max_sp) sp = max_sp; if (sp > npairs) sp = npairs; if (sp < 2) sp = 1;
        a = R; lead = 0; if (skew > 0) { const int left = so.nwg - a * (G - skew); lead = left > 0 ? (left + skew - 1) / skew : 0; sp = 1; }
#ifdef NO_KSPLIT
        sp = 1;
#endif
    }
    __device__ __forceinline__ bool next(int i_, Unit& u) const {
        const int i = i_ + i_lo; if (i >= i_hi) return false;
        u.kt0 = 0; u.nkt = 2 * npairs; u.sp = 1; u.sl = 0; u.ul = 0; u.ord = i; u.rl = 0;
        if (skew > 0) {
            long L;
            if (c >= skew) { if (i >= a) return false; L = (long)i * (G - skew) + (c - skew); if (L >= (long)a * (G - skew)) return false; }
            else { if (i >= lead) return false; L = (long)a * (G - skew) + (long)c * lead + i; }
            if (!so.at(L, u)) return false;
        } else if (i < R - 1 || sp == 1) { if (!so.next(i, u)) return false; }
        else { if (i > R - 1 || c >= rem * sp) return false;
            const int sl = c / rem, ul = c - sl * rem; if (!so.at((long)(R - 1) * G + ul, u)) return false;
            const int base = npairs / sp, extra = npairs - base * sp;
            u.sp = sp; u.sl = sl; u.ul = ul; u.kt0 = 2 * (sl * base + (sl < extra ? sl : extra)); u.nkt = 2 * (base + (sl < extra ? 1 : 0)); }
        if (mode == 1) u.pm += u.pm >> 3; else if (mode == 2) u.pm = 9 * u.pm + 8;
        return true; }
    __device__ __forceinline__ void a_ready(const Unit&) const {}
    __device__ __forceinline__ void done(const Unit&) const {}
};
__device__ __forceinline__ void st_sc1(float* p, const f32x4 v) { asm volatile("global_store_dwordx4 %0, %1, off sc1\n\ts_nop 1" :: "v"(p), "v"(v) : "memory"); }
template <class Epi, int SP> __device__ __forceinline__ void split_reduce(const Unit& u, const Epi& E, const float* s0, int tid) {
    const int r0 = (256 * u.sl) / SP, r1 = (256 * (u.sl + 1)) / SP; constexpr int CW = Epi::SLAB_W / 4;
    for (int idx = tid; idx < (r1 - r0) * CW; idx += 512) {
        const int row = r0 + idx / CW, c = (idx % CW) * 4; const float* p = s0 + (size_t)row * 256 + c;
        f32x4 a = (f32x4){0.f, 0.f, 0.f, 0.f}, b = (f32x4){0.f, 0.f, 0.f, 0.f};
#ifdef SLAB_BF16
        { const unsigned short* p16 = (const unsigned short*)s0 + (size_t)row * 256 + c;
#pragma unroll
          for (int s = 0; s < SP; ++s) { typedef unsigned u2_t __attribute__((ext_vector_type(2))); const u2_t w = *(const u2_t*)(p16 + (size_t)s * 65536);
              a += (f32x4){__builtin_bit_cast(float, w[0] << 16), __builtin_bit_cast(float, w[0] & 0xffff0000u), __builtin_bit_cast(float, w[1] << 16), __builtin_bit_cast(float, w[1] & 0xffff0000u)}; } }
        (void)p;
#else
#pragma unroll
        for (int s = 0; s < SP; ++s) { a += *(const f32x4*)(p + (size_t)s * 65536); if (Epi::PAIR) b += *(const f32x4*)(p + (size_t)s * 65536 + 128); }
#endif
        E.slab(u, row, c, a, b);
    }
}
template <class Epi> __device__ __forceinline__ void split_epilogue(const f32x4 (&acc)[2][2][4][2], const Unit& u, const Epi& E, const Gemm& g, int tid, int wr, int wc, int fr, int fq) {
    float* s0 = g.slab + (size_t)u.ul * u.sp * 65536; float* my = s0 + (size_t)u.sl * 65536;
#pragma unroll
    for (int ai = 0; ai < 2; ++ai)
#pragma unroll
        for (int m = 0; m < 4; ++m) { float* rp = my + (size_t)(ai * HALF + wr * 64 + m * 16 + fr) * 256 + wc * 32;
#ifdef SLAB_BF16
            static_assert(Epi::PERM && !Epi::PAIR, "bf16 slabs: 8 consecutive columns per lane");
            unsigned short* rp16 = (unsigned short*)s0 + (size_t)u.sl * 65536 + (size_t)(ai * HALF + wr * 64 + m * 16 + fr) * 256 + wc * 32; (void)rp;
#pragma unroll
            for (int bj = 0; bj < 2; ++bj) { const f32x4 v0 = acc[ai][bj][m][0], v1 = acc[ai][bj][m][1]; u32x4 w; w.x = cvt_pk_bf16(v0[0], v0[1]); w.y = cvt_pk_bf16(v0[2], v0[3]); w.z = cvt_pk_bf16(v1[0], v1[1]); w.w = cvt_pk_bf16(v1[2], v1[3]);
                st_sc1((float*)(rp16 + bj * HALF + 8 * fq), __builtin_bit_cast(f32x4, w)); } }
#else
#pragma unroll
            for (int bj = 0; bj < 2; ++bj)
#pragma unroll
                for (int n = 0; n < 2; ++n) st_sc1(rp + bj * HALF + (Epi::PERM ? 8 * fq + 4 * n : 16 * n + 4 * fq), acc[ai][bj][m][n]); }
#endif
    asm volatile("s_waitcnt vmcnt(0)" ::: "memory");
    __syncthreads();
    if (tid == 0) {
        unsigned* cw = g.cnt + 16 * u.ul;
        __hip_atomic_fetch_add(cw, 1u, __ATOMIC_RELAXED, __HIP_MEMORY_SCOPE_AGENT);
        unsigned spin = 0;
        while (__hip_atomic_load(cw, __ATOMIC_RELAXED, __HIP_MEMORY_SCOPE_AGENT) < (unsigned)u.sp) { __builtin_amdgcn_s_sleep(2); if (++spin > (1u << 22)) break; }
        __builtin_amdgcn_fence(__ATOMIC_ACQUIRE, "agent");
        asm volatile("s_waitcnt vmcnt(0)" ::: "memory");
    }
    __syncthreads();
    switch (u.sp) {
        case 2: split_reduce<Epi, 2>(u, E, s0, tid); break; case 3: split_reduce<Epi, 3>(u, E, s0, tid); break; case 4: split_reduce<Epi, 4>(u, E, s0, tid); break; case 5: split_reduce<Epi, 5>(u, E, s0, tid); break;
        case 6: split_reduce<Epi, 6>(u, E, s0, tid); break; case 7: split_reduce<Epi, 7>(u, E, s0, tid); break; default: split_reduce<Epi, 8>(u, E, s0, tid); break; }
}
template <class Epi, class Sched, bool ALIGN_EPI = false, bool SP2 = false>
__device__ __forceinline__ void gemm_phase(PG8_LAS unsigned char* lds, const Gemm g, const Sched& S, const Epi& E, const int tid) {
    const int wid = __builtin_amdgcn_readfirstlane(tid >> 6), lane = tid & 63, wr = wid >> 2, wc = wid & 3, fr = lane & 15, fq = lane >> 4;
    const int K = g.K;
    unsigned voffA[2], voffB[2];
#pragma unroll
    for (int i = 0; i < 2; ++i) { int R, C; stage_rc(tid * 16 + i * 8192, R, C); const int Rb = Epi::PERM ? ((R & ~31) + perm32(R & 31)) : R;
        voffA[i] = (unsigned)(R * K + C) * 2u; voffB[i] = (unsigned)(Rb * K + C) * 2u; }
    unsigned voffR[2]; { const int frl = wid * 2 + (lane >> 5), Lc = (lane & 31) ^ frl; voffR[0] = (unsigned)(frl * 2048 + Lc * 16); voffR[1] = (unsigned)((frl + 64) * 2048 + Lc * 16); }
    static_assert(!Epi::RESID_LDS || SP2, "the residual staging is written for the SP2 loop");
    const size_t kstep = (size_t)(BK * 2);
    const size_t hstep = (size_t)HALF * K * 2;
    const size_t tstep = 2 * hstep;
    const unsigned ldsw = (unsigned)wid * 1024u;
    const int aoff = lds_byte(wr * 64 + fr, fq * 8), boff = lds_byte(wc * 32 + fr, fq * 8);
#define PG8_SA(b, h) (((b) * 2 + (h)) * HTB)
#define PG8_SB(b, h) ((4 + (b) * 2 + (h)) * HTB)
#define PG8_STAGE(bufoff, gbase, voff) do { _Pragma("unroll") for (int _i = 0; _i < 2; ++_i) \
        __builtin_amdgcn_global_load_lds((const unsigned*)((const char*)(gbase) + (voff)[_i]), (PG8_LAS unsigned*)(lds + (bufoff) + ldsw + _i * 8192), 16, 0, 0); } while (0)
#define PG8_LDA(dst, b, h) do { _Pragma("unroll") for (int m = 0; m < 4; ++m) _Pragma("unroll") for (int k = 0; k < 2; ++k) dst[m][k] = *(const PG8_LAS bf16x8*)(lds + PG8_SA(b, h) + aoff + m * 2048 + k * 1024); } while (0)
#define PG8_LDB(dst, b, h) do { _Pragma("unroll") for (int n = 0; n < 2; ++n) _Pragma("unroll") for (int k = 0; k < 2; ++k) dst[n][k] = *(const PG8_LAS bf16x8*)(lds + PG8_SB(b, h) + boff + n * 2048 + k * 1024); } while (0)
#define PG8_MMA(ai, bj, At, Bt) do { __builtin_amdgcn_s_setprio(1); _Pragma("unroll") for (int m = 0; m < 4; ++m) _Pragma("unroll") for (int n = 0; n < 2; ++n) _Pragma("unroll") for (int k = 0; k < 2; ++k) \
        acc[ai][bj][m][n] = __builtin_amdgcn_mfma_f32_16x16x32_bf16(Bt[n][k], At[m][k], acc[ai][bj][m][n], 0, 0, 0); __builtin_amdgcn_s_setprio(0); } while (0)
#define PG8_WAIT_V(n) asm volatile("s_waitcnt vmcnt(" #n ")" ::: "memory")
#define PG8_WAIT_L(n) asm volatile("s_waitcnt lgkmcnt(" #n ")" ::: "memory")
#define PG8_BAR __builtin_amdgcn_s_barrier()
#define PG8_SCHED __builtin_amdgcn_sched_barrier(0)
    Unit cur, nxt; int ui = 0;
    if (!S.next(0, cur)) return;
    f32x4 acc[2][2][4][2];
#pragma unroll
    for (int a = 0; a < 2; ++a)
#pragma unroll
        for (int b = 0; b < 2; ++b)
#pragma unroll
            for (int m = 0; m < 4; ++m)
#pragma unroll
                for (int n = 0; n < 2; ++n) acc[a][b][m][n] = (f32x4){0.f, 0.f, 0.f, 0.f};
    bf16x8 At[4][2], B0[2][2], B1[2][2];
    const char* cA = (const char*)g.A + (size_t)cur.pm * tstep + (size_t)cur.kt0 * kstep; const char* cB = (const char*)g.Bt + (size_t)cur.pn * tstep + (size_t)cur.kt0 * kstep;
    S.a_ready(cur);
    if constexpr (SP2) {
        PG8_STAGE(PG8_SB(0, 0), cB, voffB); PG8_STAGE(PG8_SB(0, 1), cB + hstep, voffB); PG8_STAGE(PG8_SA(0, 0), cA, voffA); PG8_STAGE(PG8_SA(0, 1), cA + hstep, voffA);
        if (wr == 1) PG8_BAR;
        PG8_WAIT_V(2); PG8_BAR;
        PG8_STAGE(PG8_SB(1, 0), cB + kstep, voffB); PG8_STAGE(PG8_SA(1, 0), cA + kstep, voffA); PG8_STAGE(PG8_SB(1, 1), cB + hstep + kstep, voffB);
        PG8_WAIT_V(6); PG8_BAR;
    } else {
        PG8_STAGE(PG8_SB(0, 0), cB, voffB); PG8_STAGE(PG8_SA(0, 0), cA, voffA); PG8_STAGE(PG8_SB(0, 1), cB + hstep, voffB); PG8_STAGE(PG8_SA(0, 1), cA + hstep, voffA);
        if (wr == 1) PG8_BAR;
        PG8_WAIT_V(4); PG8_BAR;
        PG8_STAGE(PG8_SB(1, 0), cB + kstep, voffB); PG8_STAGE(PG8_SA(1, 0), cA + kstep, voffA); PG8_STAGE(PG8_SB(1, 1), cB + hstep + kstep, voffB);
        PG8_WAIT_V(6); PG8_BAR;
    }
    for (;;) {
        const bool has_next = S.next(ui + 1, nxt);
        const char* nA = has_next ? (const char*)g.A + (size_t)nxt.pm * tstep + (size_t)nxt.kt0 * kstep : cA; const char* nB = has_next ? (const char*)g.Bt + (size_t)nxt.pn * tstep + (size_t)nxt.kt0 * kstep : cB;
        const int nt = cur.nkt;
        const bool rlu = Epi::RESID_LDS && !has_next && cur.sp == 1;
        const char* rbase = nullptr; if constexpr (Epi::RESID_LDS) { rbase = E.res_base(cur); }
        for (int t = 0; t < nt; t += 2) {
            const bool last = (t == nt - 2);
            const char* a1 = cA + (size_t)(t + 1) * kstep;
            const char* a2 = last ? nA : cA + (size_t)(t + 2) * kstep; const char* b2 = last ? nB : cB + (size_t)(t + 2) * kstep;
            const char* a3 = a2 + kstep; const char* b3 = b2 + kstep;
            if (last && has_next) S.a_ready(nxt);
            const bool rll = Epi::RESID_LDS && last && rlu;
            const char* p_b00 = rll ? rbase : b2;                         const char* p_b01 = rll ? rbase + (size_t)16 * 2048 : b2 + hstep;
            const char* p_a00 = rll ? rbase + (size_t)32 * 2048 : a2;     const char* p_a01 = rll ? rbase + (size_t)48 * 2048 : a2 + hstep;
            const char* p_b10 = rll ? rbase + (size_t)128 * 2048 : b3;    const char* p_b11 = rll ? rbase + (size_t)144 * 2048 : b3 + hstep;
            const char* p_a10 = rll ? rbase + (size_t)160 * 2048 : a3;
            unsigned vA2[2] = {rll ? voffR[0] : voffA[0], rll ? voffR[1] : voffA[1]}, vB2[2] = {rll ? voffR[0] : voffB[0], rll ? voffR[1] : voffB[1]};
            if constexpr (SP2) {
            PG8_LDB(B0, 0, 0); PG8_LDB(B1, 0, 1); PG8_SCHED; PG8_LDA(At, 0, 0); PG8_STAGE(PG8_SA(1, 1), a1 + hstep, voffA);
            PG8_WAIT_V(8); PG8_WAIT_L(0); PG8_BAR; PG8_MMA(0, 0, At, B0); PG8_MMA(0, 1, At, B1); PG8_BAR; PG8_SCHED;
            PG8_LDA(At, 0, 1); PG8_STAGE(PG8_SB(0, 0), p_b00, vB2); PG8_STAGE(PG8_SB(0, 1), p_b01, vB2); PG8_STAGE(PG8_SA(0, 0), p_a00, vA2);
            PG8_WAIT_V(8); PG8_WAIT_L(0); PG8_BAR; PG8_MMA(1, 0, At, B0); PG8_MMA(1, 1, At, B1); PG8_BAR; PG8_SCHED;
            PG8_LDB(B0, 1, 0); PG8_LDB(B1, 1, 1); PG8_SCHED; PG8_LDA(At, 1, 0); PG8_STAGE(PG8_SA(0, 1), p_a01, vA2);
            PG8_WAIT_V(8); PG8_WAIT_L(0); PG8_BAR; PG8_MMA(0, 0, At, B0); PG8_MMA(0, 1, At, B1); PG8_BAR; PG8_SCHED;
            PG8_LDA(At, 1, 1); PG8_STAGE(PG8_SB(1, 0), p_b10, vB2); PG8_STAGE(PG8_SB(1, 1), p_b11, vB2); PG8_STAGE(PG8_SA(1, 0), p_a10, vA2);
            PG8_WAIT_V(8); PG8_WAIT_L(0); PG8_BAR; PG8_MMA(1, 0, At, B0); PG8_MMA(1, 1, At, B1); PG8_BAR; PG8_SCHED;
            } else {
            PG8_LDB(B0, 0, 0); PG8_SCHED; PG8_LDA(At, 0, 0); PG8_STAGE(PG8_SA(1, 1), a1 + hstep, voffA);
            PG8_WAIT_L(8); PG8_BAR; PG8_WAIT_L(0); PG8_MMA(0, 0, At, B0); PG8_BAR; PG8_SCHED;
            PG8_LDB(B1, 0, 1); PG8_STAGE(PG8_SB(0, 0), b2, voffB);
            PG8_BAR; PG8_WAIT_L(0); PG8_MMA(0, 1, At, B1); PG8_BAR;
            PG8_LDA(At, 0, 1); PG8_STAGE(PG8_SA(0, 0), a2, voffA);
            PG8_BAR; PG8_WAIT_L(0); PG8_MMA(1, 0, At, B0); PG8_BAR; PG8_SCHED;
            PG8_STAGE(PG8_SB(0, 1), b2 + hstep, voffB);
            PG8_WAIT_V(6); PG8_BAR; PG8_MMA(1, 1, At, B1); PG8_BAR;
            PG8_LDB(B0, 1, 0); PG8_SCHED; PG8_LDA(At, 1, 0); PG8_STAGE(PG8_SA(0, 1), a2 + hstep, voffA);
            PG8_WAIT_L(8); PG8_BAR; PG8_WAIT_L(0); PG8_MMA(0, 0, At, B0); PG8_BAR; PG8_SCHED;
            PG8_LDB(B1, 1, 1); PG8_STAGE(PG8_SB(1, 0), b3, voffB);
            PG8_BAR; PG8_WAIT_L(0); PG8_MMA(0, 1, At, B1); PG8_BAR;
            PG8_LDA(At, 1, 1); PG8_STAGE(PG8_SA(1, 0), a3, voffA);
            PG8_BAR; PG8_WAIT_L(0); PG8_MMA(1, 0, At, B0); PG8_BAR; PG8_SCHED;
            PG8_STAGE(PG8_SB(1, 1), b3 + hstep, voffB);
            PG8_WAIT_V(6); PG8_BAR; PG8_MMA(1, 1, At, B1); PG8_BAR;
            }
        }
        if constexpr (ALIGN_EPI) { if (wr == 0) PG8_BAR; }
        if constexpr (Epi::RESID_LDS) { static_assert(!Epi::RESID_LDS || ALIGN_EPI, "both halves must be aligned here"); if (rlu) { PG8_WAIT_V(0); PG8_BAR; } cur.rl = rlu ? 1 : 0; }
        if constexpr (!Epi::AFTER_DRAIN) { if (!Epi::CAN_SPLIT || cur.sp == 1) { E(acc, cur, wr, wc, fr, fq);
            if constexpr (Epi::HAS_POST) { if (E.needs_post(cur)) { asm volatile("s_waitcnt vmcnt(0)" ::: "memory"); PG8_BAR; asm volatile("" ::: "memory"); E.post(cur, wid * 64 + olane()); } }
            S.done(cur); } }
        if (!has_next) break;
#pragma unroll
        for (int a = 0; a < 2; ++a)
#pragma unroll
            for (int b = 0; b < 2; ++b)
#pragma unroll
                for (int m = 0; m < 4; ++m)
#pragma unroll
                    for (int n = 0; n < 2; ++n) acc[a][b][m][n] = (f32x4){0.f, 0.f, 0.f, 0.f};
        cur = nxt; cA = nA; cB = nB; ++ui;
        if constexpr (ALIGN_EPI) { if (wr == 1) PG8_BAR; }
    }
    PG8_WAIT_V(0);
    if constexpr (!ALIGN_EPI) { if (wr == 0) PG8_BAR; }
    PG8_BAR;
    if constexpr (Epi::AFTER_DRAIN) { E.fused(acc, cur, wr, wc, fr, fq, lds, wid, lane); S.done(cur); }
    else if constexpr (Epi::CAN_SPLIT) { if (cur.sp > 1) { split_epilogue<Epi>(acc, cur, E, g, wid * 64 + olane(), wr, wc, fr, fq); S.done(cur); } }
#undef PG8_SA
#undef PG8_SB
#undef PG8_STAGE
#undef PG8_LDA
#undef PG8_LDB
#undef PG8_MMA
#undef PG8_WAIT_V
#undef PG8_WAIT_L
#undef PG8_BAR
#undef PG8_SCHED
}
}
namespace ab {
using bf16=__hip_bfloat16;
using bf16x8=__attribute__((ext_vector_type(8)))short;
using s16x4=__attribute__((ext_vector_type(4)))short;
using f32x16=__attribute__((ext_vector_type(16)))float;
using u32x4=__attribute__((ext_vector_type(4)))unsigned;
constexpr int D=64;
constexpr int NW=8,QBLK=32,QB=QBLK*NW,KVBLK=64;
__device__ __forceinline__ int crow(int r,int hi){return (r&3)+8*(r>>2)+4*hi;}
#define SBAR() __builtin_amdgcn_sched_barrier(0)
constexpr int NSLOT=3, SLOTB=8192;
constexpr int LDS_K=0, LDS_V=NSLOT*SLOTB, LDS_WS=2*NSLOT*SLOTB, LDS_OST=LDS_WS+NW*64*4, LDS_BYTES=LDS_OST+NW*4096;
constexpr float C2=0.125f*1.4426950408889634f;
__device__ __forceinline__ void glds16(const void*gsrc,unsigned lds_dst){unsigned keep;
  asm volatile("s_mov_b32 %0, m0\n\ts_mov_b32 m0, %2\n\ts_nop 0\n\tglobal_load_lds_dwordx4 %1, off\n\ts_mov_b32 m0, %0":"=&s"(keep):"v"(gsrc),"s"(lds_dst):"memory");}
__device__ __forceinline__ float max3f(float a,float b,float c){float r;asm("v_max3_f32 %0, %1, %2, %3":"=v"(r):"v"(a),"v"(b),"v"(c));return r;}
__device__ __forceinline__ float max2f(float a,float b){float r;asm("v_max_f32_e32 %0, %1, %2":"=v"(r):"v"(a),"v"(b));return r;}
__device__ __forceinline__ float fadd_s(float a,float b){float r;asm("v_add_f32_e32 %0, %1, %2":"=v"(r):"v"(a),"v"(b));return r;}
__device__ __forceinline__ float fsub_s(float a,float b){float r;asm("v_sub_f32_e32 %0, %1, %2":"=v"(r):"v"(a),"v"(b));return r;}
typedef float f32x2_t __attribute__((ext_vector_type(2))); typedef __bf16 bf16x2_t __attribute__((ext_vector_type(2)));
__device__ __forceinline__ unsigned cvtpk_s(float lo,float hi){f32x2_t v={lo,hi};bf16x2_t b=__builtin_convertvector(v,bf16x2_t);return __builtin_bit_cast(unsigned,b);}
#define WAIT_BAR(N) asm volatile("s_waitcnt vmcnt(" #N ") lgkmcnt(0)\n\ts_barrier":::"memory")

__device__ __forceinline__ void qkt(f32x16&p0,f32x16&p1,const char*Kslot,const bf16x8*qr,const f32x16&negm,int r32,int hi){
  const char*kb=Kslot+hi*1024+r32*16;
  #pragma unroll
  for(int d0=0;d0<4;++d0){
    const bf16x8 b0=*reinterpret_cast<const bf16x8*>(kb+d0*2048);
    const bf16x8 b1=*reinterpret_cast<const bf16x8*>(kb+d0*2048+512);
    if(d0==0){p0=__builtin_amdgcn_mfma_f32_32x32x16_bf16(b0,qr[0],negm,0,0,0);p1=__builtin_amdgcn_mfma_f32_32x32x16_bf16(b1,qr[0],negm,0,0,0);}
    else{p0=__builtin_amdgcn_mfma_f32_32x32x16_bf16(b0,qr[d0],p0,0,0,0);p1=__builtin_amdgcn_mfma_f32_32x32x16_bf16(b1,qr[d0],p1,0,0,0);}}
}
typedef __attribute__((address_space(3))) const char* lds_cptr;
typedef short v4i16_t __attribute__((ext_vector_type(4)));
__device__ __forceinline__ void kload8(bf16x8*kf,lds_cptr kp){
  kf[0]=*(const __attribute__((address_space(3))) bf16x8*)(kp);      kf[1]=*(const __attribute__((address_space(3))) bf16x8*)(kp+512);
  kf[2]=*(const __attribute__((address_space(3))) bf16x8*)(kp+2048); kf[3]=*(const __attribute__((address_space(3))) bf16x8*)(kp+2560);
  kf[4]=*(const __attribute__((address_space(3))) bf16x8*)(kp+4096); kf[5]=*(const __attribute__((address_space(3))) bf16x8*)(kp+4608);
  kf[6]=*(const __attribute__((address_space(3))) bf16x8*)(kp+6144); kf[7]=*(const __attribute__((address_space(3))) bf16x8*)(kp+6656);
}
__device__ __forceinline__ void kload2(bf16x8*kf,lds_cptr kp,int j){ kf[2*j]=*(const __attribute__((address_space(3))) bf16x8*)(kp+j*2048); kf[2*j+1]=*(const __attribute__((address_space(3))) bf16x8*)(kp+j*2048+512); }
__device__ __forceinline__ s16x4 vtr(lds_cptr p){ return __builtin_bit_cast(s16x4,__builtin_amdgcn_ds_read_tr16_b64_v4i16((__attribute__((address_space(3))) v4i16_t*)p)); }
__device__ __forceinline__ float rowmax(const f32x16&p0,const f32x16&p1){
  float a=max3f(p0[0],p0[1],p1[0]),b=max3f(p0[2],p0[3],p1[1]);a=max3f(a,p1[2],p1[3]);
  #pragma unroll
  for(int r=4;r<16;r+=4){a=max3f(a,p0[r],p0[r+1]);b=max3f(b,p0[r+2],p0[r+3]);a=max3f(a,p1[r],p1[r+1]);b=max3f(b,p1[r+2],p1[r+3]);}
  const float m=max2f(a,b);
  auto rr=__builtin_amdgcn_permlane32_swap(__float_as_uint(m),__float_as_uint(m),false,false);
  return max2f(__uint_as_float(rr[0]),__uint_as_float(rr[1]));
}
__device__ __forceinline__ void pv(f32x16*o,int vb,bf16x8 pa0,bf16x8 pa1,bf16x8 pa2,bf16x8 pa3){
  #pragma unroll
  for(int d0=0;d0<2;++d0){s16x4 lo[4],hi[4];
    #pragma unroll
    for(int ks=0;ks<4;++ks){
      asm volatile("ds_read_b64_tr_b16 %0,%1 offset:%c2":"=&v"(lo[ks]):"v"(vb),"i"(d0*4096+ks*1024):"memory");
      asm volatile("ds_read_b64_tr_b16 %0,%1 offset:%c2":"=&v"(hi[ks]):"v"(vb),"i"(d0*4096+ks*1024+512):"memory");}
    asm volatile("s_waitcnt lgkmcnt(0)":::"memory");SBAR();
    #define PK(k) (bf16x8){lo[k][0],lo[k][1],lo[k][2],lo[k][3],hi[k][0],hi[k][1],hi[k][2],hi[k][3]}
    o[d0]=__builtin_amdgcn_mfma_f32_32x32x16_bf16(pa0,PK(0),o[d0],0,0,0);
    o[d0]=__builtin_amdgcn_mfma_f32_32x32x16_bf16(pa1,PK(1),o[d0],0,0,0);
    o[d0]=__builtin_amdgcn_mfma_f32_32x32x16_bf16(pa2,PK(2),o[d0],0,0,0);
    o[d0]=__builtin_amdgcn_mfma_f32_32x32x16_bf16(pa3,PK(3),o[d0],0,0,0);
    #undef PK
  }
}

#ifndef ATTN_STORE16
#define ATTN_STORE16(p,v) (*(u32x4*)(p)=(v))
#endif
struct AUnit { const bf16* Q; const bf16* K; const bf16* V; bf16* O; int r1, r2, NT, q0; float sink2; const float* qgain; const float2* tab; const float* sinkv; };
template<int LD,int MODE,int THRL,bool HW> __device__ __forceinline__ void attn_unit(const AUnit& U,char*shm,const int tid){
  const int lane=tid&63,r32=lane&31,hi=lane>>5; const int wid=__builtin_amdgcn_readfirstlane(tid>>6);
  constexpr int n1=4; const int r1=U.r1,r2=U.r2;
  #define TROW(t) (MODE==0?r1+64*(t):((t)<n1?r1+64*(t):r2+64*((t)-n1)))
  const bf16*Qw=HW?U.Q+wid*64:U.Q+(long)(wid*QBLK)*LD; const int qrow0=HW?U.q0:U.q0+wid*QBLK;
  const bf16*Kh=U.K,*Vh=U.V;
  const unsigned lds0=(unsigned)(uintptr_t)shm;
  float*wsf=(float*)(shm+LDS_WS)+wid*64;
  const bf16*ksrc=Kh+(long)lane*LD+wid*8;
  const bf16*vsrc=Vh+(long)(16*(wid&3)+(lane>>2))*LD+(wid>>2)*32+(lane&3)*8;
  const unsigned kdst=lds0+LDS_K+wid*1024, vdst=lds0+LDS_V+wid*1024;
  #define DMA_K(t,slot) glds16(ksrc+(long)TROW(t)*LD,(unsigned)__builtin_amdgcn_readfirstlane(kdst+(slot)))
  #define DMA_V(t,slot) glds16(vsrc+(long)TROW(t)*LD,(unsigned)__builtin_amdgcn_readfirstlane(vdst+(slot)))
  const int vb0=(int)(lds0+LDS_V)+((lane>>4)&1)*32+(lane&3)*8+(4*hi+((lane&15)>>2))*64;
  const char*Kbase=shm+LDS_K; bf16x8 kf[8];
  const lds_cptr shm3=(lds_cptr)shm; const lds_cptr kp0=shm3+LDS_K+hi*1024+r32*16; const lds_cptr vp0=shm3+LDS_V+((lane>>4)&1)*32+(lane&3)*8+(4*hi+((lane&15)>>2))*64;
  const int NT=U.NT;
  DMA_K(0,0);DMA_V(0,0);DMA_K(1,SLOTB);
  float4 gq[8],tv[8];
  #pragma unroll
  for(int j=0;j<8;++j){gq[j]=make_float4(0.f,0.f,0.f,0.f);tv[j]=make_float4(0.f,0.f,0.f,0.f);}
  if(U.qgain){ _Pragma("unroll") for(int d0=0;d0<4;++d0){ gq[2*d0]=*(const float4*)(U.qgain+16*d0+8*hi); gq[2*d0+1]=*(const float4*)(U.qgain+16*d0+8*hi+4); } }
  if(U.tab){ const int t=qrow0+r32; const float4*tr=(const float4*)(U.tab+(t>>6)*16+8*hi),*tc=(const float4*)(U.tab+(t&63)*16+8*hi);
    _Pragma("unroll") for(int j=0;j<4;++j){ tv[j]=tr[j]; tv[4+j]=tc[j]; } }
  bf16x8 qr[4];
  #pragma unroll
  for(int d0=0;d0<4;++d0)qr[d0]=*reinterpret_cast<const bf16x8*>(&Qw[(long)r32*LD+d0*16+hi*8]);
  {
    float x[4][8];
    #pragma unroll
    for(int d0=0;d0<4;++d0){ _Pragma("unroll") for(int j=0;j<8;++j) x[d0][j]=__builtin_bit_cast(float,(unsigned)(unsigned short)qr[d0][j]<<16); }
    if(U.qgain){ float ss=0.f;
      #pragma unroll
      for(int d0=0;d0<4;++d0){ _Pragma("unroll") for(int j=0;j<8;++j) ss+=x[d0][j]*x[d0][j]; }
      ss=xl::add_xor32(ss); const float rs=__builtin_amdgcn_rsqf(ss*(1.f/64.f)+1e-6f);
      #pragma unroll
      for(int d0=0;d0<4;++d0){ const float4 g0=gq[2*d0], g1=gq[2*d0+1];
        x[d0][0]*=rs*g0.x;x[d0][1]*=rs*g0.y;x[d0][2]*=rs*g0.z;x[d0][3]*=rs*g0.w;x[d0][4]*=rs*g1.x;x[d0][5]*=rs*g1.y;x[d0][6]*=rs*g1.z;x[d0][7]*=rs*g1.w; } }
    if(U.tab){
      #pragma unroll
      for(int j=0;j<8;++j){ const float4 r4=tv[j>>1],c4=tv[4+(j>>1)]; const float crx=(j&1)?r4.z:r4.x,cry=(j&1)?r4.w:r4.y,ccx=(j&1)?c4.z:c4.x,ccy=(j&1)?c4.w:c4.y;
        const float a0=x[0][j],a1=x[1][j],a2=x[2][j],a3=x[3][j];
        x[0][j]=a0*crx-a1*cry; x[1][j]=a1*crx+a0*cry; x[2][j]=a2*ccx-a3*ccy; x[3][j]=a3*ccx+a2*ccy; } }
    #pragma unroll
    for(int d0=0;d0<4;++d0){ u32x4 w; _Pragma("unroll") for(int j=0;j<4;++j) w[j]=cvtpk_s(x[d0][2*j]*C2,x[d0][2*j+1]*C2); qr[d0]=__builtin_bit_cast(bf16x8,w); }
  }
  float mhat=0.f,l_reg=0.f;f32x16 o[2];o[0]=f32x16{};o[1]=f32x16{};f32x16 negm=f32x16{};asm volatile("":"+v"(negm));
  const int qpos=qrow0+r32;
  #define CMASK(P0,P1,t) do{ if(MODE==1){ if((t)>=n1){ const int tlo_=TROW(t), qw_=qrow0; \
      if(!(tlo_-qw_-31>=-128 && tlo_+63-qw_<=128)){ const int db_=tlo_-qpos+4*hi+128; \
        _Pragma("unroll") for(int r=0;r<16;++r){ const int c_=(r&3)+8*(r>>2); if((unsigned)(db_+c_)>256u)P0[r]=-INFINITY; if((unsigned)(db_+c_+32)>256u)P1[r]=-INFINITY; } } } } }while(0)
  bool resc=false;
  #define START(P0,P1) do{ const float rm=rowmax(P0,P1); resc=false; \
    { const float dl=rm; mhat=fadd_s(mhat,dl); \
      _Pragma("unroll") for(int r=0;r<16;++r){P0[r]=fsub_s(P0[r],dl);P1[r]=fsub_s(P1[r],dl);} \
      _Pragma("unroll") for(int r=0;r<16;++r)negm[r]=-mhat; asm volatile("":"+v"(negm)); } \
    _Pragma("unroll") for(int r=0;r<16;++r)P0[r]=__builtin_amdgcn_exp2f(P0[r]); }while(0)
  #define RESC() do{ if(resc){ asm volatile("s_waitcnt lgkmcnt(0)":::"memory"); \
      _Pragma("unroll") for(int d_=0;d_<2;++d_) _Pragma("unroll") for(int r=0;r<16;++r)o[d_][r]*=wsf[crow(r,hi)]; } }while(0)
  f32x16 pA0,pA1,pB0,pB1;
  int sl_prev=0,sl_cur=0,sl_next=SLOTB;
  #define ROT() do{sl_prev=sl_cur;sl_cur=sl_next;sl_next=(sl_next==(NSLOT-1)*SLOTB)?0:sl_next+SLOTB;}while(0)
  DMA_K(2,2*SLOTB);
  WAIT_BAR(3);
  qkt(pA0,pA1,Kbase,qr,negm,r32,hi);asm volatile("s_nop 15\n\ts_nop 7":"+v"(pA0),"+v"(pA1));CMASK(pA0,pA1,0);
  START(pA0,pA1);
  _Pragma("unroll") for(int r=0;r<16;++r)pA1[r]=__builtin_amdgcn_exp2f(pA1[r]);
  WAIT_BAR(0);
  DMA_K(3,0);DMA_V(1,SLOTB);
  ROT();
  kload8(kf,kp0+sl_cur);
  WAIT_BAR(2);
  s16x4 vlo[8],vhi[8]; u32x4 pw0,pw1,pw2,pw3;
  #define PKW(P,B) cvtpk_s(P[B],P[B+1])
  #define PAF(k) __builtin_bit_cast(bf16x8,pw##k)
  #define VFR(i) (bf16x8){vlo[i][0],vlo[i][1],vlo[i][2],vlo[i][3],vhi[i][0],vhi[i][1],vhi[i][2],vhi[i][3]}
  #define PIN(x) asm volatile("":"+v"(x))
  #define MX3(a,b,c) __builtin_fmaxf(__builtin_fmaxf((a),(b)),(c))
  #define GAPA(MF,A0,A1,A2,A3,W0,W1,PW) do{ MF; sacc+=A0; sacc+=A1; sacc+=A2; sacc+=A3; PIN(sacc); W0; W1; PIN(PW); SBAR(); }while(0)
  #define EX(v) __builtin_amdgcn_exp2f(v)
  #define GAPB(MF,X,B) do{ MF; X[B]=EX(X[B]); X[B+1]=EX(X[B+1]); X[B+2]=EX(X[B+2]); X[B+3]=EX(X[B+3]); PIN(X); SBAR(); }while(0)
  #define VRD(i) do{ vlo[i]=vtr(vp_+(((i)>>2)*4096+((i)&3)*1024)); vhi[i]=vtr(vp_+(((i)>>2)*4096+((i)&3)*1024+512)); }while(0)
  #define KRD(G,j) do{ if(G){ kload2(kf,kp0+sl_next,j); SBAR(); } }while(0)
  #define STEP(C0,C1,P0,P1,t,GK,GV,GL) do{ SBAR(); \
    const lds_cptr vp_=vp0+sl_prev; \
    VRD(0); SBAR(); float sacc=(P0[0]+P0[1]); \
    GAPA(C0=__builtin_amdgcn_mfma_f32_32x32x16_bf16(kf[0],qr[0],negm,0,0,0), P0[2],P0[3],P0[4],P0[5],     pw0[0]=PKW(P0,0), pw0[1]=PKW(P0,2), pw0); \
    VRD(4); SBAR(); GAPA(C1=__builtin_amdgcn_mfma_f32_32x32x16_bf16(kf[1],qr[0],negm,0,0,0), P0[6],P0[7],P0[8],P0[9],     pw0[2]=PKW(P0,4), pw0[3]=PKW(P0,6), pw0); \
    VRD(1); SBAR(); GAPA(C0=__builtin_amdgcn_mfma_f32_32x32x16_bf16(kf[2],qr[1],C0,0,0,0),   P0[10],P0[11],P0[12],P0[13], pw1[0]=PKW(P0,8), pw1[1]=PKW(P0,10), pw1); \
    VRD(5); SBAR(); GAPA(C1=__builtin_amdgcn_mfma_f32_32x32x16_bf16(kf[3],qr[1],C1,0,0,0),   P0[14],P0[15],P1[0],P1[1],   pw1[2]=PKW(P0,12),pw1[3]=PKW(P0,14), pw1); \
    VRD(2); SBAR(); GAPA(C0=__builtin_amdgcn_mfma_f32_32x32x16_bf16(kf[4],qr[2],C0,0,0,0),   P1[2],P1[3],P1[4],P1[5],     pw2[0]=PKW(P1,0), pw2[1]=PKW(P1,2), pw2); \
    VRD(6); SBAR(); GAPA(C1=__builtin_amdgcn_mfma_f32_32x32x16_bf16(kf[5],qr[2],C1,0,0,0),   P1[6],P1[7],P1[8],P1[9],     pw2[2]=PKW(P1,4), pw2[3]=PKW(P1,6), pw2); \
    VRD(3); SBAR(); GAPA(C0=__builtin_amdgcn_mfma_f32_32x32x16_bf16(kf[6],qr[3],C0,0,0,0),   P1[10],P1[11],P1[12],P1[13], pw3[0]=PKW(P1,8), pw3[1]=PKW(P1,10), pw3); \
    VRD(7); SBAR(); GAPA(C1=__builtin_amdgcn_mfma_f32_32x32x16_bf16(kf[7],qr[3],C1,0,0,0),   P1[14],P1[15],0.f,0.f,       pw3[2]=PKW(P1,12),pw3[3]=PKW(P1,14), pw3); \
    l_reg+=sacc; \
    if(GK){DMA_K((t)+3,sl_cur);} if(GV){DMA_V((t)+1,sl_next);} \
    CMASK(C0,C1,t); \
    { float a=MX3(C0[0],C0[1],C1[0]),b=MX3(C0[2],C0[3],C1[1]); a=MX3(a,C1[2],C1[3]); \
      _Pragma("unroll") for(int r=4;r<16;r+=4){a=MX3(a,C0[r],C0[r+1]);b=MX3(b,C0[r+2],C0[r+3]);a=MX3(a,C1[r],C1[r+1]);b=MX3(b,C1[r+2],C1[r+3]);} \
      float rm=__builtin_fmaxf(a,b); { auto rr=__builtin_amdgcn_permlane32_swap(__float_as_uint(rm),__float_as_uint(rm),false,false); rm=__builtin_fmaxf(__uint_as_float(rr[0]),__uint_as_float(rr[1])); } \
      resc=false; \
      if(__builtin_expect(__any(rm>(float)THRL),0)){ const float dl=__builtin_fmaxf(rm,0.f); mhat+=dl; \
        _Pragma("unroll") for(int r=0;r<16;++r){C0[r]-=dl;C1[r]-=dl;} \
        _Pragma("unroll") for(int r=0;r<16;++r)negm[r]=-mhat; asm volatile("":"+v"(negm)); \
        const float f=__builtin_amdgcn_exp2f(-dl); l_reg*=f; if(hi==0)wsf[r32]=f; resc=true; } } \
    SBAR(); \
    GAPB(o[0]=__builtin_amdgcn_mfma_f32_32x32x16_bf16(PAF(0),VFR(0),o[0],0,0,0), C0,0); \
    GAPB(o[1]=__builtin_amdgcn_mfma_f32_32x32x16_bf16(PAF(0),VFR(4),o[1],0,0,0), C0,4); \
    KRD(GL,0); GAPB(o[0]=__builtin_amdgcn_mfma_f32_32x32x16_bf16(PAF(1),VFR(1),o[0],0,0,0), C0,8); \
    KRD(GL,1); GAPB(o[1]=__builtin_amdgcn_mfma_f32_32x32x16_bf16(PAF(1),VFR(5),o[1],0,0,0), C0,12); \
    KRD(GL,2); GAPB(o[0]=__builtin_amdgcn_mfma_f32_32x32x16_bf16(PAF(2),VFR(2),o[0],0,0,0), C1,0); \
    KRD(GL,3); GAPB(o[1]=__builtin_amdgcn_mfma_f32_32x32x16_bf16(PAF(2),VFR(6),o[1],0,0,0), C1,4); \
    GAPB(o[0]=__builtin_amdgcn_mfma_f32_32x32x16_bf16(PAF(3),VFR(3),o[0],0,0,0), C1,8); \
    GAPB(o[1]=__builtin_amdgcn_mfma_f32_32x32x16_bf16(PAF(3),VFR(7),o[1],0,0,0), C1,12); \
    }while(0)
  int t=1;
  for(;t+5<NT;t+=2){
    STEP(pB0,pB1,pA0,pA1,t,true,true,true);     WAIT_BAR(2); RESC(); ROT();
    STEP(pA0,pA1,pB0,pB1,t+1,true,true,true);   WAIT_BAR(2); RESC(); ROT();
  }
  #define ENDW(tt) do{ if((tt)+3<NT){WAIT_BAR(2);} else if((tt)+2<NT){WAIT_BAR(1);} else {WAIT_BAR(0);} }while(0)
  for(;t+1<NT;t+=2){
    STEP(pB0,pB1,pA0,pA1,t,(t+3<NT),(t+1<NT),(t+1<NT));       ENDW(t);   RESC(); ROT();
    STEP(pA0,pA1,pB0,pB1,t+1,(t+4<NT),(t+2<NT),(t+2<NT));     ENDW(t+1); RESC(); ROT();
  }
  #define DRAIN(P0,P1,SL) do{ float sacc=P0[0]+P0[1]; _Pragma("unroll") for(int r=2;r<16;++r)sacc+=P0[r]; _Pragma("unroll") for(int r=0;r<16;++r)sacc+=P1[r]; l_reg+=sacc; \
    pw0=(u32x4){PKW(P0,0),PKW(P0,2),PKW(P0,4),PKW(P0,6)};pw1=(u32x4){PKW(P0,8),PKW(P0,10),PKW(P0,12),PKW(P0,14)};pw2=(u32x4){PKW(P1,0),PKW(P1,2),PKW(P1,4),PKW(P1,6)};pw3=(u32x4){PKW(P1,8),PKW(P1,10),PKW(P1,12),PKW(P1,14)}; \
    SBAR(); pv(o,vb0+(SL),PAF(0),PAF(1),PAF(2),PAF(3)); }while(0)
  if(t<NT){ STEP(pB0,pB1,pA0,pA1,NT-1,false,false,false); RESC(); DRAIN(pB0,pB1,sl_cur); }
  else { DRAIN(pA0,pA1,sl_prev); }
  #undef DRAIN
  #undef PKW
  #undef PAF
  #undef VFR
  #undef PIN
  #undef MX3
  #undef GAPA
  #undef GAPB
  #undef EX
  #undef VRD
  #undef KRD
  #undef STEP
  #undef ENDW
  if(hi==0)l_reg+=__builtin_amdgcn_exp2f((HW?U.sinkv[wid]*1.4426950408889634f:U.sink2)-mhat);
  {auto rr=__builtin_amdgcn_permlane32_swap(__float_as_uint(l_reg),__float_as_uint(l_reg),false,false);l_reg=__uint_as_float(rr[0])+__uint_as_float(rr[1]);}
  if(hi==0)wsf[32+r32]=l_reg;asm volatile("s_waitcnt lgkmcnt(0)":::"memory");
  float rli[16];
  #pragma unroll
  for(int r=0;r<16;++r)rli[r]=__builtin_amdgcn_rcpf(wsf[32+crow(r,hi)]);
  bf16*Ow=HW?U.O+wid*64:U.O+(long)(wid*QBLK)*1024;
  { bf16*stg=(bf16*)(shm+LDS_OST)+wid*2048;
    #pragma unroll
    for(int r=0;r<16;++r){const int orow=crow(r,hi);
      #pragma unroll
      for(int d0=0;d0<2;++d0)stg[orow*64+d0*32+r32]=__float2bfloat16(o[d0][r]*rli[r]);}
    asm volatile("s_waitcnt lgkmcnt(0)":::"memory");
    #pragma unroll
    for(int i=0;i<4;++i){const int row=i*8+(lane>>3),ch=lane&7; const u32x4 v=*(const u32x4*)(stg+row*64+ch*8); ATTN_STORE16(Ow+(long)row*1024+ch*8,v);} }
  asm volatile("s_waitcnt lgkmcnt(0)\n\ts_barrier":::"memory");
  #undef TROW
  #undef DMA_K
  #undef DMA_V
  #undef CMASK
  #undef START
  #undef RESC
  #undef ROT
}
constexpr int ATTN_LDS_BYTES=LDS_BYTES;
#undef SBAR
#undef WAIT_BAR
}
namespace gla {
using bf16 = unsigned short;
using bf16x8 = __attribute__((ext_vector_type(8))) short;
using s16x4 = __attribute__((ext_vector_type(4))) short;
using f32x16 = __attribute__((ext_vector_type(16))) float;
using f32x4 = __attribute__((ext_vector_type(4))) float;
using u32x4 = __attribute__((ext_vector_type(4))) unsigned;
using u32x2 = __attribute__((ext_vector_type(2))) unsigned;
typedef short v4i16_t __attribute__((ext_vector_type(4)));
#define GLAS __attribute__((address_space(3)))
constexpr int LD = cfg::LDE, M = cfg::M;
constexpr float QS = 0.17677669529663687f;
constexpr int KT_STRIDE = 80, KH_STRIDE = 144;
constexpr int WAVE_LDS = 18432;
__device__ __forceinline__ float ex(float x) { return __builtin_amdgcn_exp2f(x * 1.4426950408889634f); }
__device__ __forceinline__ float bf2f(unsigned short v) { return __builtin_bit_cast(float, (unsigned)v << 16); }
__device__ __forceinline__ unsigned short f2bf(float f) { unsigned u = __builtin_bit_cast(unsigned, f); return (unsigned short)((u + 0x7fffu + ((u >> 16) & 1u)) >> 16); }
__device__ __forceinline__ unsigned pk2(float lo, float hi) { return (unsigned)f2bf(lo) | ((unsigned)f2bf(hi) << 16); }
__device__ __forceinline__ int crow(int r, int hi) { return (r & 3) + 8 * (r >> 2) + 4 * hi; }
__device__ __forceinline__ s16x4 vtr(const GLAS char* p) { return __builtin_bit_cast(s16x4, __builtin_amdgcn_ds_read_tr16_b64_v4i16((GLAS v4i16_t*)p)); }
#define GLA_MFMA(a, b, c) __builtin_amdgcn_mfma_f32_32x32x16_bf16(a, b, c, 0, 0, 0)
#define GLA_LDSWAIT() asm volatile("s_waitcnt lgkmcnt(0)" ::: "memory")

struct Ctx {
    const bf16* P;
    float* DEC;
    const float* LR; const float* gkw; const float* gkb;
    size_t mbase;
    int h, bh;
    bf16* US; bf16* SB; float* DD;
    bf16* MIX; const float* gg;
};

template <int CTRL, int ROWMASK> __device__ __forceinline__ float dpp_add(float v) {
    return v + __builtin_bit_cast(float, __builtin_amdgcn_update_dpp(0, __builtin_bit_cast(int, v), CTRL, ROWMASK, 0xf, false)); }
__device__ __forceinline__ float scan64(float v) {
    v = dpp_add<0x111, 0xf>(v); v = dpp_add<0x112, 0xf>(v); v = dpp_add<0x114, 0xf>(v); v = dpp_add<0x118, 0xf>(v);
    v = dpp_add<0x142, 0xa>(v); v = dpp_add<0x143, 0xc>(v); return v; }
__device__ __forceinline__ float sum32(float v) {
    v = dpp_add<0xB1, 0xf>(v); v = dpp_add<0x4E, 0xf>(v); v = dpp_add<0x141, 0xf>(v); v = dpp_add<0x140, 0xf>(v); return v + xl::xor16(v); }
__device__ __forceinline__ void load_g(const float* gp, float (&g)[32]) {
#pragma unroll
    for (int j = 0; j < 8; ++j) { const f32x4 v = *(const f32x4*)(gp + 4 * j); g[4 * j] = v[0]; g[4 * j + 1] = v[1]; g[4 * j + 2] = v[2]; g[4 * j + 3] = v[3]; } }
__device__ __forceinline__ void load_row32(const bf16* p, float (&x)[32]) {
#pragma unroll
    for (int j = 0; j < 4; ++j) { const u32x4 w = *(const u32x4*)(p + 8 * j);
#pragma unroll
        for (int q = 0; q < 4; ++q) { x[8 * j + 2 * q] = __builtin_bit_cast(float, w[q] << 16); x[8 * j + 2 * q + 1] = __builtin_bit_cast(float, w[q] & 0xffff0000u); } } }
#ifdef DEC_BF16
typedef bf16 dec_t;
__device__ __forceinline__ void load_g(const bf16* gp, float (&g)[32]) { load_row32(gp, g); }
#else
typedef float dec_t;
#endif
__device__ __forceinline__ void load_vtile(const bf16* vp  , GLAS char* vt, int lane) {
#pragma unroll
    for (int p = 0; p < 8; ++p) {
        const u32x4 v = *(const u32x4*)(vp + (size_t)(16 * (p & 3) + (lane >> 2)) * LD + (p >> 2) * 32 + (lane & 3) * 8);
        *(GLAS u32x4*)(vt + p * 1024 + lane * 16) = v;
    }
}
template <int DIR> __device__ __forceinline__ void stage_a(const Ctx& X, int c, GLAS char* wl, int lane_in) {
    int lane = lane_in; asm volatile("" : "+v"(lane));
    const int r32 = lane & 31, hi = lane >> 5;
    GLAS char* khT = wl; GLAS char* vt = wl + 32 * KH_STRIDE;
    const size_t row = X.mbase + 64 * c + lane;
    float g[32], kk[32];
    load_row32(X.P + (size_t)(64 * c + lane) * LD + cfg::E_GK + X.h * 32, kk);
    {
        GLAS float* wsl = (GLAS float*)(wl + 32 * KH_STRIDE + 8192);
        { const int r = lane >> 2, q = (lane & 3) * 8; const float* src = X.gkw + (size_t)(DIR * 16 + r) * 256 + X.h * 32 + q;
          *(GLAS f32x4*)(wsl + r * 32 + q) = *(const f32x4*)src; *(GLAS f32x4*)(wsl + r * 32 + q + 4) = *(const f32x4*)(src + 4);
          if (lane < 8) *(GLAS f32x4*)(wsl + 512 + lane * 4) = *(const f32x4*)(X.gkb + DIR * 256 + X.h * 32 + lane * 4); }
        float lr[16];
#pragma unroll
        for (int j = 0; j < 4; ++j) { const f32x4 v = *(const f32x4*)(X.LR + row * 32 + DIR * 16 + 4 * j); lr[4 * j] = v[0]; lr[4 * j + 1] = v[1]; lr[4 * j + 2] = v[2]; lr[4 * j + 3] = v[3]; }
        GLA_LDSWAIT();
#pragma unroll
        for (int k4 = 0; k4 < 8; ++k4) {
            f32x4 x = *(const GLAS f32x4*)(wsl + 512 + 4 * k4);
#pragma unroll
            for (int r = 0; r < 16; ++r) x += lr[r] * *(const GLAS f32x4*)(wsl + r * 32 + 4 * k4);
#pragma unroll
            for (int q = 0; q < 4; ++q) g[4 * k4 + q] = (fminf(x[q], 0.f) - __logf(1.f + __expf(-fabsf(x[q])))) * (1.f / 16.f);
#ifdef DEC_BF16
            *(u32x2*)((dec_t*)X.DEC + ((size_t)DIR * M + row) * 256 + X.h * 32 + 4 * k4) = (u32x2){pk2(g[4 * k4], g[4 * k4 + 1]), pk2(g[4 * k4 + 2], g[4 * k4 + 3])};
#else
            *(f32x4*)(X.DEC + ((size_t)DIR * M + row) * 256 + X.h * 32 + 4 * k4) = (f32x4){g[4 * k4], g[4 * k4 + 1], g[4 * k4 + 2], g[4 * k4 + 3]};
#endif
        }
    }
    load_vtile(X.P + (size_t)(64 * c) * LD + cfg::E_GV + X.h * 64, vt, lane);
    const size_t slot = ((size_t)(X.bh * 2 + DIR) * 36 + c);
    float dd[32];
#pragma unroll
    for (int i = 0; i < 32; ++i) {
        const float b = scan64(g[i]);
        const float T = __builtin_bit_cast(float, __builtin_amdgcn_readlane(__builtin_bit_cast(int, b), 63));
        const float w = ex(DIR == 0 ? T - b : b - g[i]);
        dd[i] = ex(T);
        *(GLAS unsigned short*)(khT + i * KH_STRIDE + lane * 2) = f2bf(kk[i] * w);
    }
    if (lane == 0) {
#pragma unroll
        for (int j = 0; j < 8; ++j) *(f32x4*)(X.DD + slot * 32 + 4 * j) = (f32x4){dd[4 * j], dd[4 * j + 1], dd[4 * j + 2], dd[4 * j + 3]};
    }
    GLA_LDSWAIT();
    f32x16 u0 = f32x16{}, u1 = f32x16{};
    const GLAS char* vb = vt + ((lane >> 4) & 1) * 32 + (lane & 3) * 8 + (8 * hi + ((lane & 15) >> 2)) * 64;
#pragma unroll
    for (int s = 0; s < 4; ++s) {
        const bf16x8 a = *(const GLAS bf16x8*)(khT + r32 * KH_STRIDE + (16 * s + 8 * hi) * 2);
        const s16x4 l0 = vtr(vb + s * 1024), h0 = vtr(vb + s * 1024 + 256), l1 = vtr(vb + 4096 + s * 1024), h1 = vtr(vb + 4096 + s * 1024 + 256);
        u0 = GLA_MFMA(a, ((bf16x8){l0[0], l0[1], l0[2], l0[3], h0[0], h0[1], h0[2], h0[3]}), u0);
        u1 = GLA_MFMA(a, ((bf16x8){l1[0], l1[1], l1[2], l1[3], h1[0], h1[1], h1[2], h1[3]}), u1);
    }
    bf16* up = X.US + slot * 2048;
#pragma unroll
    for (int g4 = 0; g4 < 4; ++g4) {
        *(u32x2*)(up + (r32) * 32 + 8 * g4 + 4 * hi) = (u32x2){pk2(u0[4 * g4], u0[4 * g4 + 1]), pk2(u0[4 * g4 + 2], u0[4 * g4 + 3])};
        *(u32x2*)(up + (r32 + 32) * 32 + 8 * g4 + 4 * hi) = (u32x2){pk2(u1[4 * g4], u1[4 * g4 + 1]), pk2(u1[4 * g4 + 2], u1[4 * g4 + 3])};
    }
    GLA_LDSWAIT();
}
constexpr int C_KT = 0, C_QT = 64 * KT_STRIDE, C_VT = 128 * KT_STRIDE, C_WAVE = C_VT + 8192;
__device__ __forceinline__ void unpack_row32(const u32x4 (&w4)[4], float (&x)[32]) {
#pragma unroll
    for (int j = 0; j < 4; ++j)
#pragma unroll
        for (int q = 0; q < 4; ++q) { x[8 * j + 2 * q] = __builtin_bit_cast(float, w4[j][q] << 16); x[8 * j + 2 * q + 1] = __builtin_bit_cast(float, w4[j][q] & 0xffff0000u); } }
template <int DIR, bool PF> __device__ __forceinline__ void stage_c_dir(const Ctx& X, int c, GLAS char* wl, int lane_in, f32x16 (&o)[2][2], float (&g)[32], const u32x4 (&kraw)[4], const u32x4 (&qraw)[4], const dec_t* gnp, float (&gn)[32]) {
    int lane = lane_in; asm volatile("" : "+v"(lane));
    const int r32 = lane & 31, hi = lane >> 5;
    GLAS char* kt = wl + C_KT; GLAS char* qt = wl + C_QT; GLAS char* vt = wl + C_VT;
    {
        float x[32];
        unpack_row32(kraw, x);
#pragma unroll
        for (int i = 0; i < 32; ++i) {
            float b = scan64(g[i]);
            if (DIR == 1) { const float T = __builtin_bit_cast(float, __builtin_amdgcn_readlane(__builtin_bit_cast(int, b), 63)); b = T - b + g[i]; }
            const float e = ex(b);
            x[i] *= __builtin_amdgcn_rcpf(e);
            g[i] = e * QS;
        }
#pragma unroll
        for (int j = 0; j < 4; ++j) *(GLAS u32x4*)(kt + lane * KT_STRIDE + 16 * j) = (u32x4){pk2(x[8 * j], x[8 * j + 1]), pk2(x[8 * j + 2], x[8 * j + 3]), pk2(x[8 * j + 4], x[8 * j + 5]), pk2(x[8 * j + 6], x[8 * j + 7])};
        unpack_row32(qraw, x);
#pragma unroll
        for (int j = 0; j < 4; ++j) *(GLAS u32x4*)(qt + lane * KT_STRIDE + 16 * j) = (u32x4){pk2(x[8 * j] * g[8 * j], x[8 * j + 1] * g[8 * j + 1]), pk2(x[8 * j + 2] * g[8 * j + 2], x[8 * j + 3] * g[8 * j + 3]),
                                                                                           pk2(x[8 * j + 4] * g[8 * j + 4], x[8 * j + 5] * g[8 * j + 5]), pk2(x[8 * j + 6] * g[8 * j + 6], x[8 * j + 7] * g[8 * j + 7])};
    }
    if (PF) load_g(gnp, gn);
    GLA_LDSWAIT();
    const bf16* sp = X.SB + ((size_t)(X.bh * 2 + DIR) * 36 + c) * 2048;
    bf16x8 sf[2][2];
#pragma unroll
    for (int s = 0; s < 2; ++s) { sf[s][0] = *(const bf16x8*)(sp + (r32) * 32 + 16 * s + 8 * hi); sf[s][1] = *(const bf16x8*)(sp + (r32 + 32) * 32 + 16 * s + 8 * hi); }
    const GLAS char* vb = vt + ((lane >> 4) & 1) * 32 + (lane & 3) * 8 + (4 * hi + ((lane & 15) >> 2)) * 64;
#pragma unroll
    for (int qh = 0; qh < 2; ++qh) {
        constexpr bool dummy = false; (void)dummy;
        const bool use0 = !(DIR == 1 && qh == 1), use1 = !(DIR == 0 && qh == 0);
        f32x16 p0 = f32x16{}, p1 = f32x16{};
        bf16x8 bq[2];
#pragma unroll
        for (int s = 0; s < 2; ++s) {
            bq[s] = *(const GLAS bf16x8*)(qt + (32 * qh + r32) * KT_STRIDE + (16 * s + 8 * hi) * 2);
            if (use0) { const bf16x8 a0 = *(const GLAS bf16x8*)(kt + r32 * KT_STRIDE + (16 * s + 8 * hi) * 2); p0 = GLA_MFMA(a0, bq[s], p0); }
            if (use1) { const bf16x8 a1 = *(const GLAS bf16x8*)(kt + (32 + r32) * KT_STRIDE + (16 * s + 8 * hi) * 2); p1 = GLA_MFMA(a1, bq[s], p1); }
        }
        const int iq = 32 * qh + r32;
#pragma unroll
        for (int r = 0; r < 16; ++r) { const int j0 = crow(r, hi), j1 = 32 + j0;
            if (DIR == 0) { if (use0 && j0 > iq) p0[r] = 0.f; if (use1 && j1 > iq) p1[r] = 0.f; } else { if (use0 && j0 < iq) p0[r] = 0.f; if (use1 && j1 < iq) p1[r] = 0.f; } }
#pragma unroll
        for (int ks = 0; ks < 4; ++ks) {
            if ((ks < 2) ? !use0 : !use1) continue;
            const f32x16& p = (ks < 2) ? p0 : p1; const int r0 = (ks & 1) * 8;
            const u32x4 pw = (u32x4){pk2(p[r0], p[r0 + 1]), pk2(p[r0 + 2], p[r0 + 3]), pk2(p[r0 + 4], p[r0 + 5]), pk2(p[r0 + 6], p[r0 + 7])};
            const bf16x8 pa = __builtin_bit_cast(bf16x8, pw);
            const s16x4 l0 = vtr(vb + ks * 1024), h0 = vtr(vb + ks * 1024 + 512), l1 = vtr(vb + 4096 + ks * 1024), h1 = vtr(vb + 4096 + ks * 1024 + 512);
            o[qh][0] = GLA_MFMA(pa, ((bf16x8){l0[0], l0[1], l0[2], l0[3], h0[0], h0[1], h0[2], h0[3]}), o[qh][0]);
            o[qh][1] = GLA_MFMA(pa, ((bf16x8){l1[0], l1[1], l1[2], l1[3], h1[0], h1[1], h1[2], h1[3]}), o[qh][1]);
        }
#pragma unroll
        for (int s = 0; s < 2; ++s) { o[qh][0] = GLA_MFMA(bq[s], sf[s][0], o[qh][0]); o[qh][1] = GLA_MFMA(bq[s], sf[s][1], o[qh][1]); }
    }
    GLA_LDSWAIT();
}
__device__ __forceinline__ void stage_c(const Ctx& X, int c, GLAS char* wl, int lane_in) {
    int lane = lane_in; asm volatile("" : "+v"(lane));
    f32x16 o[2][2]; o[0][0] = f32x16{}; o[0][1] = f32x16{}; o[1][0] = f32x16{}; o[1][1] = f32x16{};
    float g0[32], g1[32]; u32x4 kraw[4], qraw[4];
    { const size_t row = X.mbase + 64 * c + lane; const bf16* pr = X.P + (size_t)(64 * c + lane) * LD + X.h * 32;
      load_g((const dec_t*)X.DEC + ((size_t)0 * M + row) * 256 + X.h * 32, g0);
#pragma unroll
      for (int j = 0; j < 4; ++j) { kraw[j] = *(const u32x4*)(pr + cfg::E_GK + 8 * j); qraw[j] = *(const u32x4*)(pr + cfg::E_GQ + 8 * j); } }
    load_vtile(X.P + (size_t)(64 * c) * LD + cfg::E_GV + X.h * 64, wl + C_VT, lane);
    stage_c_dir<0, true>(X, c, wl, lane, o, g0, kraw, qraw, (const dec_t*)X.DEC + ((size_t)1 * M + X.mbase + 64 * c + lane) * 256 + X.h * 32, g1);
    stage_c_dir<1, false>(X, c, wl, lane, o, g1, kraw, qraw, nullptr, g0);
    asm volatile("" : "+v"(lane));
    const int r32 = lane & 31, hi = lane >> 5;
    const float gn0 = X.gg[r32], gn1 = X.gg[r32 + 32];
    GLAS char* stg = wl;
#pragma unroll
    for (int qh = 0; qh < 2; ++qh)
#pragma unroll
        for (int r = 0; r < 16; ++r) {
            const float ss = sum32(o[qh][0][r] * o[qh][0][r] + o[qh][1][r] * o[qh][1][r]);
            const float rs = __builtin_amdgcn_rsqf(ss * (1.f / 64.f) + cfg::EPS);
            GLAS char* rp = stg + (32 * qh + crow(r, hi)) * KH_STRIDE + r32 * 2;
            *(GLAS unsigned short*)rp = f2bf(o[qh][0][r] * rs * gn0); *(GLAS unsigned short*)(rp + 64) = f2bf(o[qh][1][r] * rs * gn1);
        }
    GLA_LDSWAIT();
    const bf16* gp = X.P + (size_t)(64 * c + lane) * LD + cfg::E_GG + X.h * 64; bf16* mp = X.MIX + (X.mbase + 64 * c + lane) * 1024 + X.h * 64;
    u32x4 gv[8];
#pragma unroll
    for (int j = 0; j < 8; ++j) gv[j] = *(const u32x4*)(gp + 8 * j);
#pragma unroll
    for (int j = 0; j < 8; ++j) {
        const u32x4 ov = *(const GLAS u32x4*)(stg + lane * KH_STRIDE + 16 * j); u32x4 res;
#pragma unroll
        for (int q = 0; q < 4; ++q) {
            const float a0 = __builtin_bit_cast(float, gv[j][q] << 16), a1 = __builtin_bit_cast(float, gv[j][q] & 0xffff0000u);
            const float v0 = __builtin_bit_cast(float, ov[q] << 16), v1 = __builtin_bit_cast(float, ov[q] & 0xffff0000u);
            res[q] = pk2(v0 * (a0 * __builtin_amdgcn_rcpf(1.f + ex(-a0))), v1 * (a1 * __builtin_amdgcn_rcpf(1.f + ex(-a1))));
        }
        *(u32x4*)(mp + 8 * j) = res;
    }
    GLA_LDSWAIT();
}
__device__ __forceinline__ Ctx ctx_of(const Ctx& B0, int bh) { Ctx X = B0; const int b = bh >> 3; X.h = bh & 7; X.bh = bh; X.mbase = (size_t)b * cfg::RB; X.P = B0.P + (size_t)b * cfg::RB * LD; return X; }
__device__ __forceinline__ int gla_task(int i, int total, int gw, int NGW, int wid) {
    const int full = total / NGW, left = total - full * NGW, G = NGW >> 3;
    if (i < full) return i * NGW + gw;
    if (i == full) { const int e = wid * G + (gw >> 3); return e < left ? full * NGW + e : -1; }
    return -1;
}
__device__ __forceinline__ void phase_a(const Ctx& B0, GLAS char* lds, int gw, int NGW, int wid, int lane) {
    GLAS char* wl = lds + wid * WAVE_LDS;
    for (int i = 0;; ++i) { const int t = gla_task(i, 64 * 72, gw, NGW, wid); if (t < 0) break; const int bh = t / 72, r = t - bh * 72; const Ctx X = ctx_of(B0, bh); if (r & 1) stage_a<1>(X, r >> 1, wl, lane); else stage_a<0>(X, r >> 1, wl, lane); }
}
__device__ __forceinline__ void phase_c(const Ctx& B0, GLAS char* lds, int gw, int NGW, int wid, int lane) {
    GLAS char* wl = lds + wid * WAVE_LDS;
    for (int i = 0;; ++i) { const int t = gla_task(i, 64 * 36, gw, NGW, wid); if (t < 0) break; const int bh = t / 36, c = t - bh * 36; const Ctx X = ctx_of(B0, bh); stage_c(X, c, wl, lane); }
}
#ifndef UB_BATCH
#define UB_BATCH 18
#endif
__device__ __forceinline__ void unit_b(const Ctx& X, GLAS char* lds, const int tid) {
    const int dir = tid >> 8, dv = (tid >> 2) & 63, k8 = (tid & 3) * 8;
    float S[8];
#pragma unroll
    for (int i = 0; i < 8; ++i) S[i] = 0.f;
    const size_t base = (size_t)(X.bh * 2 + dir) * 36;
    const bf16* __restrict__ USp = X.US + base * 2048 + dv * 32 + k8; bf16* __restrict__ SBp = X.SB + base * 2048 + dv * 32 + k8;
    GLAS float* dl = (GLAS float*)lds;
    { const float* __restrict__ src = X.DD + (size_t)X.bh * 2 * 36 * 32;
      const f32x4 a = *(const f32x4*)(src + 4 * tid); f32x4 b = (f32x4){0.f, 0.f, 0.f, 0.f}; if (tid < 64) b = *(const f32x4*)(src + 2048 + 4 * tid);
      *(GLAS f32x4*)(dl + 4 * tid) = a; if (tid < 64) *(GLAS f32x4*)(dl + 2048 + 4 * tid) = b; }
    const GLAS float* dk = dl + dir * 36 * 32 + k8;
#pragma unroll
    for (int s0 = 0; s0 < 36; s0 += UB_BATCH) {
        u32x4 uw[UB_BATCH];
#pragma unroll
        for (int j = 0; j < UB_BATCH; ++j) { const int s = s0 + j, cc = dir == 0 ? (s < 4 ? 32 + s : s - 4) : 35 - s; uw[j] = *(const u32x4*)(USp + (size_t)cc * 2048); }
        if (s0 == 0) { GLA_LDSWAIT(); __syncthreads(); }
#pragma unroll
        for (int j = 0; j < UB_BATCH; ++j) {
            const int s = s0 + j, cc = dir == 0 ? (s < 4 ? 32 + s : s - 4) : 35 - s;
            *(u32x4*)(SBp + (size_t)cc * 2048) = (u32x4){pk2(S[0], S[1]), pk2(S[2], S[3]), pk2(S[4], S[5]), pk2(S[6], S[7])};
            const f32x4 d0 = *(const GLAS f32x4*)(dk + cc * 32), d1 = *(const GLAS f32x4*)(dk + cc * 32 + 4);
            const unsigned uu[4] = {uw[j].x, uw[j].y, uw[j].z, uw[j].w};
#pragma unroll
            for (int i = 0; i < 4; ++i) {
                S[2 * i] = (i < 2 ? d0[2 * i] : d1[2 * i - 4]) * S[2 * i] + __builtin_bit_cast(float, uu[i] << 16);
                S[2 * i + 1] = (i < 2 ? d0[2 * i + 1] : d1[2 * i - 3]) * S[2 * i + 1] + __builtin_bit_cast(float, uu[i] & 0xffff0000u);
            }
        }
    }
}
#undef GLAS
}
namespace fw {
using namespace cfg;
constexpr int NWAVES = 8;
constexpr size_t MiB = 1u << 20;
constexpr size_t WS_CTL = 0, CTL_ZERO_BYTES = 512 * 1024;
constexpr size_t WS_MOD = 1 * MiB;
constexpr size_t WS_TAB = 1 * MiB + 896 * 1024;
constexpr size_t WS_DD = 2 * MiB;
constexpr size_t WS_CB = 640 * 1024;
constexpr size_t WS_SQ = 2 * MiB + 576 * 1024;
constexpr size_t WS_LR = 3 * MiB + 768 * 1024;
constexpr size_t WS_XC = 6 * MiB;
constexpr size_t WS_W = 14 * MiB;
constexpr size_t W_IN_E = (size_t)LDE * D * 2, W_IN_O = (size_t)LDO * D * 2, W_OUT = (size_t)D * D * 2, W_13 = (size_t)2 * FFH * D * 2, W_2 = (size_t)D * FFH * 2;
constexpr size_t W_LAYER_E = W_IN_E + W_OUT + W_13 + W_2, W_LAYER_O = W_IN_O + W_OUT + W_13 + W_2;
constexpr size_t WS_HN = 103 * MiB;
constexpr size_t WS_PROJ = 139 * MiB;
constexpr size_t WS_MIX = 238 * MiB;
constexpr size_t WS_H = 139 * MiB;
constexpr size_t WS_US = 274 * MiB, WS_SB = 292 * MiB;
constexpr size_t WS_XMID = WS_US;
constexpr size_t WS_SLAB = 310 * MiB;
constexpr size_t WS_DEC = WS_SLAB;
constexpr size_t WS_END = 374 * MiB;
static_assert(WS_W + 2 * W_LAYER_E + 2 * W_LAYER_O <= WS_HN && WS_HN + (size_t)M * D * 2 <= WS_PROJ && WS_PROJ + (size_t)M * LDE * 2 <= WS_MIX && WS_MIX + (size_t)M * D * 2 <= WS_US, "ws map");
static_assert(WS_CB >= CTL_ZERO_BYTES && WS_CB + (size_t)9 * (LDE + 2 * FFH) * 4 <= WS_MOD && WS_DD + (size_t)64 * 72 * 32 * 4 <= WS_SQ && WS_SQ + (size_t)M * 16 * 4 <= WS_LR && WS_LR + (size_t)M * 32 * 4 <= WS_XC, "ws map 3");
static_assert((size_t)2 * M * 256 * 4 <= (size_t)M * D * 2 && WS_H + (size_t)M * FFH * 2 <= WS_MIX && WS_SB + 18 * MiB <= WS_SLAB && WS_SLAB + 64 * MiB <= WS_END && (size_t)64 * 72 * 4096 <= 18 * MiB, "ws map 2");
__host__ __device__ constexpr size_t w_layer_off(int l) { return (size_t)(l >> 1) * (W_LAYER_E + W_LAYER_O) + ((l & 1) ? W_LAYER_E : 0); }
constexpr int CW_TMO = 0, CW_BAR = 1024, CW_Q = 8192;
constexpr int CW_SPLIT = 16384;
constexpr int RTAB_OFF = 131072;
constexpr int RING_BYTES = 131072, GLA_LDS_BYTES = 8 * 18432, MISC_OFF = GLA_LDS_BYTES + 320, LDS_BYTES = GLA_LDS_BYTES + 1024;

#define GAS __attribute__((address_space(1)))
#define LAS __attribute__((address_space(3)))
typedef unsigned short bf16;
typedef unsigned v4u __attribute__((ext_vector_type(4)));
typedef float f32x4 __attribute__((ext_vector_type(4)));
typedef GAS unsigned gu32;
#define RLX_AGENT __ATOMIC_RELAXED, __HIP_MEMORY_SCOPE_AGENT
#define LDS_WAIT() asm volatile("s_waitcnt lgkmcnt(0)" ::: "memory")
#define VM_WAIT() asm volatile("s_waitcnt vmcnt(0)" ::: "memory")
__device__ __forceinline__ unsigned f2bf(float f) { unsigned u = __builtin_bit_cast(unsigned, f); return (u + 0x7fffu + ((u >> 16) & 1u)) >> 16; }
__device__ __forceinline__ unsigned pk2(float lo, float hi) { return f2bf(lo) | (f2bf(hi) << 16); }
__device__ __forceinline__ float bf2f(unsigned short v) { return __builtin_bit_cast(float, (unsigned)v << 16); }
__device__ __forceinline__ float wave_sum(float v) { return xl::sum64(v); }

#define XB_TMO      128
#define XB_XCNT(j)  (256  + 64 * (j))
#define XB_XSUB(j)  (1280 + 64 * (j))
#define XB_XGEN(j)  (2304 + 64 * (j))
#define XB_TOP      3328
#define XB_TOPGEN   3392
#define XCD_BAR_WORDS 3456
#define XB_SPIN_CAP (1u << 18)
__device__ __forceinline__ unsigned xb_ld(unsigned* p)              { return __hip_atomic_load(p, __ATOMIC_RELAXED, __HIP_MEMORY_SCOPE_AGENT); }
__device__ __forceinline__ unsigned xb_add(unsigned* p, unsigned v) { return __hip_atomic_fetch_add(p, v, __ATOMIC_RELAXED, __HIP_MEMORY_SCOPE_AGENT); }
__device__ __forceinline__ unsigned xb_xcc_id() { return (unsigned)__builtin_amdgcn_s_getreg((3 << 11) | 20) & 0xFu; }
#define XB_SPIN(cond, bar) do { unsigned _sp = 0; while (cond) { __builtin_amdgcn_s_sleep(1); \
    if ((++_sp & 255u) == 0u) { if (xb_ld(&(bar)[XB_TMO])) break; if (_sp > XB_SPIN_CAP) { atomicAdd(&(bar)[XB_TMO], 1u); break; } } } } while (0)
struct XcdBarrier { unsigned* bar; unsigned x; volatile LAS unsigned* st; };
__device__ __forceinline__ XcdBarrier xcd_barrier_post(unsigned* bar, volatile LAS unsigned* st) {
    XcdBarrier b; b.bar = bar; b.x = xb_xcc_id(); b.st = st;
    if (threadIdx.x == 0) (void)xb_add(&bar[XB_XCNT(b.x)], 1u);
    return b;
}
__device__ __forceinline__ void xcd_barrier_complete(unsigned* bar, unsigned x, unsigned& nloc, unsigned& nx) {
    const unsigned G = gridDim.x * gridDim.y * gridDim.z;
    unsigned sum, cnt, mine, sp = 0u;
    for (;;) {
        sum = 0u; cnt = 0u; mine = 0u;
#pragma unroll
        for (unsigned j = 0; j < 16; ++j) { const unsigned c = xb_ld(&bar[XB_XCNT(j)]); sum += c; cnt += (c > 0u) ? 1u : 0u; mine = (j == x) ? c : mine; }
        if (sum == G) break;
        __builtin_amdgcn_s_sleep(1);
        if ((++sp & 255u) == 0u) { if (xb_ld(&bar[XB_TMO])) break; if (sp > XB_SPIN_CAP) { atomicAdd(&bar[XB_TMO], 1u); break; } }
    }
    nloc = mine > 0u ? mine : 1u; nx = cnt > 0u ? cnt : 1u;
}
__device__ __forceinline__ void xcd_barrier(const XcdBarrier& b, const bool t0) {
    asm volatile("s_waitcnt vmcnt(0)" ::: "memory");
    __syncthreads();
    if (t0) {
        unsigned* bar = b.bar;
        __builtin_amdgcn_s_waitcnt(0);
        unsigned nloc = b.st[0], nx = b.st[1];
        if (nloc == 0u) { xcd_barrier_complete(bar, b.x, nloc, nx); b.st[0] = nloc; b.st[1] = nx; }
        const unsigned old = xb_add(&bar[XB_XSUB(b.x)], 1u);
        const unsigned gen = old / nloc;
        if (old + 1u == (gen + 1u) * nloc) {
            __builtin_amdgcn_fence(__ATOMIC_RELEASE, "agent");
            asm volatile("s_waitcnt vmcnt(0)" ::: "memory");
            const unsigned og = xb_add(&bar[XB_TOP], 1u);
            const unsigned tg = og / nx;
            if (og + 1u == (tg + 1u) * nx) xb_add(&bar[XB_TOPGEN], 1u);
            else XB_SPIN(xb_ld(&bar[XB_TOPGEN]) == tg, bar);
            __builtin_amdgcn_fence(__ATOMIC_ACQUIRE, "agent");
            xb_add(&bar[XB_XGEN(b.x)], 1u);
            asm volatile("s_waitcnt vmcnt(0)" ::: "memory");
        } else {
            XB_SPIN(xb_ld(&bar[XB_XGEN(b.x)]) == gen, bar);
            __builtin_amdgcn_fence(__ATOMIC_ACQUIRE, "agent");
            asm volatile("s_waitcnt vmcnt(0)" ::: "memory");
        }
    }
    __syncthreads();
}

struct Args { const float* in[22]; float* out; unsigned char* ws; int ph_lo, ph_hi; };
typedef const __attribute__((address_space(4))) Args* ArgP;
enum { I_X = 0, I_C, I_CTX, I_CCTX, I_ADAW, I_ADAB, I_N1G, I_N2G, I_W1, I_W3, I_W2, I_EIN, I_EOUT, I_GKW, I_GKB, I_GLAG, I_QNG, I_KNG, I_OIN, I_OOUT, I_SINK, I_FG };
enum { S_NORM1 = 0, S_G1, S_PREP, S_GLAA, S_MIX, S_GLAC, S_G2, S_NORM2, S_G3, S_G3B, S_G4, PH_PER_LAYER };
constexpr int N_PHASES = 2 + PH_PER_LAYER * DEPTH;
__host__ __device__ constexpr bool phase_active(int ph) {
    if (ph == 0 || ph == N_PHASES - 1) return true;
    const int l = (ph - 1) / PH_PER_LAYER, s = (ph - 1) % PH_PER_LAYER;
    if (s == S_NORM2 || s == S_PREP || (s == S_NORM1 && l > 0)) return false;
    if (s == S_G3B && l == DEPTH - 1) return false;
    return !((l & 1) && (s == S_GLAA || s == S_GLAC));
}

__device__ __forceinline__ void p0_mods(ArgP A, LAS unsigned char* lds, int l0, int nl, int slot, int nslots, int tid, int lane, int wave) {
    LAS float* sc = (LAS float*)lds;
    LAS float* part = (LAS float*)(lds + 40960);
    if (slot >= 96 * nl) return;
    for (int i = tid; i < 9 * 1024; i += 512) { const int j = i >> 10, k = i & 1023; const float v = j < 8 ? A->in[I_C][j * 1024 + k] : A->in[I_CCTX][k]; sc[i] = v * __builtin_amdgcn_rcpf(1.f + __builtin_amdgcn_exp2f(-LOG2E * v)); }
    __syncthreads();
    float* mod = (float*)(A->ws + WS_MOD);
    for (int t = slot; t < 96 * nl; t += nslots) {
        const int l = l0 + t / 96, cg = t % 96, n = cg * 64 + lane;
        const float* w = A->in[I_ADAW] + ((size_t)l * 1024 + wave * 128) * 6144 + n;
        float acc[9];
#pragma unroll
        for (int j = 0; j < 9; ++j) acc[j] = 0.f;
#pragma nounroll
        for (int k0 = 0; k0 < 128; k0 += 32) { float wv[32];
#pragma unroll
            for (int k = 0; k < 32; ++k) wv[k] = __builtin_nontemporal_load(w + (size_t)(k0 + k) * 6144);
#pragma unroll
            for (int k = 0; k < 32; ++k)
#pragma unroll
                for (int j = 0; j < 9; ++j) acc[j] += sc[j * 1024 + wave * 128 + k0 + k] * wv[k]; }
#pragma unroll
        for (int j = 0; j < 9; ++j) part[(wave * 9 + j) * 64 + lane] = acc[j];
        __syncthreads();
        for (int o = tid; o < 576; o += 512) { const int j = o >> 6, c = o & 63; float s = 0.f;
#pragma unroll
            for (int w8 = 0; w8 < 8; ++w8) s += part[(w8 * 9 + j) * 64 + c];
            mod[((size_t)l * 9 + j) * 6144 + cg * 64 + c] = s + A->in[I_ADAB][l * 6144 + cg * 64 + c]; }
        __syncthreads();
    }
}
__device__ __forceinline__ void p0_item(const float* W, int Nsrc, int srccol, int k0, bf16* WT, int K, int dstrow, LAS float* scr, int lane) {
    if (srccol >= 0) {
        float v[32]; const float* wp = W + (size_t)(k0 + (lane >> 5)) * Nsrc + srccol + (lane & 31);
#pragma unroll
        for (int i = 0; i < 32; ++i) v[i] = __builtin_nontemporal_load(wp + (size_t)(2 * i) * Nsrc);
#pragma unroll
        for (int i = 0; i < 32; ++i) scr[(2 * i + (lane >> 5)) * 33 + (lane & 31)] = v[i];
    } else {
#pragma unroll 8
        for (int i = 0; i < 32; ++i) { const int kk = 2 * i + (lane >> 5); scr[kk * 33 + (lane & 31)] = 0.f; }
    }
    LDS_WAIT(); asm volatile("" ::: "memory");
    const int c = lane & 7;
#pragma unroll
    for (int j = 0; j < 4; ++j) { const int n = (lane >> 3) + 8 * j; const LAS float* s = scr + (8 * c) * 33 + n;
        v4u o; o.x = pk2(s[0 * 33], s[1 * 33]); o.y = pk2(s[2 * 33], s[3 * 33]); o.z = pk2(s[4 * 33], s[5 * 33]); o.w = pk2(s[6 * 33], s[7 * 33]);
        *(GAS v4u*)(WT + (size_t)(dstrow + n) * K + k0 + 8 * c) = o; }
    LDS_WAIT(); asm volatile("" ::: "memory");
}
__device__ __forceinline__ void conv_layer(ArgP A, int l, LAS unsigned char* lds, int wslot, int nslots, int lane, int wave, int part = 0) {
    LAS float* scr = (LAS float*)(lds + wave * 16384);
    constexpr int IT_E = 16 * 80, IT_O = 16 * 40, IT_OUT = 16 * 32, IT_13 = 16 * 176, IT_2 = 44 * 32;
    const int odd = l & 1, i = l >> 1;
    const int it_in = odd ? IT_O : IT_E, total = it_in + IT_OUT + IT_13 + IT_2; const size_t w_in_b = odd ? W_IN_O : W_IN_E;
    bf16* wl = (bf16*)(A->ws + WS_W + w_layer_off(l));
    const int it_lo = part == 3 ? it_in + IT_OUT + IT_13 : 0, it_hi = part == 1 ? it_in + IT_OUT + IT_13 : total;
    for (int it = it_lo + wslot; it < it_hi; it += nslots) {
        int r = it;
        if (r < it_in) {
            const int nblk = odd ? 40 : 80, kb = r / nblk, nb = r % nblk, d0 = 32 * nb;
            if (odd) p0_item(A->in[I_OIN] + (size_t)i * D * LDO, LDO, d0, 64 * kb, wl, D, d0, scr, lane);
            else { const int sc = d0 < 1536 ? d0 : (d0 < 2304 ? d0 + 32 : (d0 == 2304 ? 1536 : -1)); p0_item(A->in[I_EIN] + (size_t)i * D * 2336, 2336, sc, 64 * kb, wl, D, d0, scr, lane); }
            continue; }
        r -= it_in;
        if (r < IT_OUT) { const int kb = r / 32, nb = r % 32; p0_item((odd ? A->in[I_OOUT] : A->in[I_EOUT]) + (size_t)i * D * D, D, 32 * nb, 64 * kb, (bf16*)((unsigned char*)wl + w_in_b), D, 32 * nb, scr, lane); continue; }
        r -= IT_OUT;
        if (r < IT_13) { const int kb = r / 176, nb = r % 176, d0 = 32 * nb, tile = d0 >> 8, within = d0 & 255;
            const float* src = (within < 128 ? A->in[I_W1] : A->in[I_W3]) + (size_t)l * D * FFH;
            p0_item(src, FFH, 128 * tile + (within & 127), 64 * kb, (bf16*)((unsigned char*)wl + w_in_b + W_OUT), D, d0, scr, lane); continue; }
        r -= IT_13;
        { const int kb = r / 32, nb = r % 32; p0_item(A->in[I_W2] + (size_t)l * FFH * D, D, 32 * nb, 64 * kb, (bf16*)((unsigned char*)wl + w_in_b + W_OUT + W_13), FFH, 32 * nb, scr, lane); }
    }
}
__device__ __forceinline__ void p0_tab(ArgP A, int tid) {
    float2* tab = (float2*)(A->ws + WS_TAB);
    for (int e = tid; e < 1024; e += 512) {
        const int p = e >> 4, i = e & 15;
        const float inv = __builtin_amdgcn_exp2f(-(float)(2 * i) * (1.f / 32.f) * 13.287712379549449f);
        const float x = (float)p * inv;
        const float q = __builtin_rintf(x * 0.63661977236758f);
        float r = __builtin_fmaf(-q, 1.5703125f, x); r = __builtin_fmaf(-q, 4.837512969970703125e-4f, r); r = __builtin_fmaf(-q, 7.549789954891882e-8f, r);
        const int qi = ((int)q) & 3; const float r2 = r * r;
        const float s = r + r * r2 * (-1.6666654611e-1f + r2 * (8.3321608736e-3f + r2 * (-1.9515295891e-4f)));
        const float c = 1.f - 0.5f * r2 + r2 * r2 * (4.166664568298827e-2f + r2 * (-1.388731625493765e-3f + r2 * 2.443315711809948e-5f));
        float cs, sn;
        if (qi == 0) { cs = c; sn = s; } else if (qi == 1) { cs = -s; sn = c; } else if (qi == 2) { cs = -c; sn = -s; } else { cs = s; sn = -c; }
        tab[e] = make_float2(cs, sn);
    }
}

__device__ __forceinline__ const float* x_row(const float* lat, const float* ctx, int b, int t) { return t < SEQ ? lat + ((size_t)b * SEQ + t) * D : ctx + ((size_t)b * CTX + (t - SEQ)) * D; }

__device__ __forceinline__ void xg_phase(ArgP A, int gw, int NGW, int lane) {
    const float* g = A->in[I_N1G]; const float* mod = (const float*)(A->ws + WS_MOD);
    bf16* HN = (bf16*)(A->ws + WS_HN); float* SQ = (float*)(A->ws + WS_SQ); bf16* XB = (bf16*)A->out;
    f32x4 gv[4];
#pragma unroll
    for (int j = 0; j < 4; ++j) gv[j] = *(const f32x4*)(g + lane * 4 + 256 * j);
    for (int m = gw; m < M; m += NGW) {
        const int b = m / RB, t = m - b * RB;
        const float* xr = x_row(A->in[I_X], A->in[I_CTX], b, t) + lane * 4; const float* mp = mod + (size_t)(t < SEQ ? b : 8) * 6144 + D + lane * 4;
        f32x4 v[4]; float s = 0.f;
#pragma unroll
        for (int j = 0; j < 4; ++j) { v[j] = *(const f32x4*)(xr + 256 * j); s += (v[j].x * v[j].x + v[j].y * v[j].y) + (v[j].z * v[j].z + v[j].w * v[j].w); }
        s = wave_sum(s);
        if (lane < 16) SQ[(size_t)m * 16 + lane] = lane == 0 ? s : 0.f;
        unsigned long long* o8 = (unsigned long long*)(HN + (size_t)m * D) + lane; unsigned long long* x8 = (unsigned long long*)(XB + (size_t)m * D) + lane;
#pragma unroll
        for (int j = 0; j < 4; ++j) { const f32x4 sc = *(const f32x4*)(mp + 256 * j); const f32x4 y = v[j] * gv[j] * (sc + 1.f);
            o8[64 * j] = (unsigned long long)pk2(y.x, y.y) | ((unsigned long long)pk2(y.z, y.w) << 32);
            x8[64 * j] = (unsigned long long)pk2(v[j].x, v[j].y) | ((unsigned long long)pk2(v[j].z, v[j].w) << 32); }
    }
}
__device__ __forceinline__ void cb_layer(ArgP A, int l, LAS unsigned char* lds, int wslot, int nslots, int tid, int lane) {
    LAS float* sh = (LAS float*)lds;
    const float* mod = (const float*)(A->ws + WS_MOD) + (size_t)l * 9 * 6144;
    for (int e = tid; e < 2 * 9 * 1024; e += 512) { const int w2 = e / 9216, r = e - w2 * 9216, j = r >> 10, k = r & 1023; sh[e] = mod[(size_t)j * 6144 + (w2 ? 3 * D : 0) + k]; }
    __syncthreads();
    if (wslot >= 0) {
        const int odd = l & 1, nin = odd ? LDO : LDE, total = nin + 2 * FFH;
        const bf16* wl = (const bf16*)(A->ws + WS_W + w_layer_off(l)); const bf16* w13 = (const bf16*)((const unsigned char*)wl + (odd ? W_IN_O : W_IN_E) + W_OUT);
        float* cb = (float*)(A->ws + WS_CB);
        for (int n = wslot; n < total; n += nslots) {
            const bool up = n >= nin; const bf16* wr = up ? w13 + (size_t)(n - nin) * D : wl + (size_t)n * D;
            const v4u w0 = *(const v4u*)(wr + lane * 16), w1 = *(const v4u*)(wr + lane * 16 + 8);
            float wv[16];
#pragma unroll
            for (int q = 0; q < 4; ++q) { wv[2 * q] = __builtin_bit_cast(float, w0[q] << 16); wv[2 * q + 1] = __builtin_bit_cast(float, w0[q] & 0xffff0000u); wv[8 + 2 * q] = __builtin_bit_cast(float, w1[q] << 16); wv[8 + 2 * q + 1] = __builtin_bit_cast(float, w1[q] & 0xffff0000u); }
            const LAS float* sp = sh + (up ? 9216 : 0) + lane * 16;
            float acc[9];
#pragma unroll
            for (int j = 0; j < 9; ++j) { float a = 0.f;
#pragma unroll
                for (int q = 0; q < 4; ++q) { const f32x4 s4 = *(const LAS f32x4*)(sp + j * 1024 + 4 * q); a += (wv[4 * q] * s4[0] + wv[4 * q + 1] * s4[1]) + (wv[4 * q + 2] * s4[2] + wv[4 * q + 3] * s4[3]); }
                acc[j] = wave_sum(a); }
            if (lane < 9) { float v = acc[0];
#pragma unroll
                for (int j = 1; j < 9; ++j) v = lane == j ? acc[j] : v;
                cb[up ? (size_t)9 * LDE + (size_t)lane * 2 * FFH + (n - nin) : (size_t)lane * LDE + n] = v; }
        }
    }
    __syncthreads();
}
template <class Sched> __device__ __forceinline__ void rtab_build(const Sched& S, const float* SQ, LAS float* rtab, int tid) {
    f32x4 v[4][4]; bool ok[4];
#pragma unroll
    for (int it = 0; it < 4; ++it) { const int e = tid + 512 * it; pg8::Unit u; ok[it] = (e < 7 * 256) && S.next(e >> 8, u);
        const f32x4* p = (const f32x4*)(SQ + ((size_t)(ok[it] ? u.pm : 0) * 256 + (e & 255)) * 16);
#pragma unroll
        for (int q = 0; q < 4; ++q) v[it][q] = p[q]; }
#pragma unroll
    for (int it = 0; it < 4; ++it) { const f32x4 a = v[it][0], b = v[it][1], c = v[it][2], d = v[it][3];
        const float s = ((a[0] + a[1]) + (a[2] + a[3])) + ((b[0] + b[1]) + (b[2] + b[3])) + ((c[0] + c[1]) + (c[2] + c[3])) + ((d[0] + d[1]) + (d[2] + d[3]));
        if (ok[it]) rtab[tid + 512 * it] = __builtin_amdgcn_rsqf(s * (1.f / D) + EPS); }
    __syncthreads();
}
__device__ __forceinline__ void final_phase(ArgP A, int gw, int NGW, int lane) {
    const bf16* X = (const bf16*)(A->ws + WS_HN);
    f32x4 gv[4];
#pragma unroll
    for (int j = 0; j < 4; ++j) gv[j] = *(const f32x4*)(A->in[I_FG] + lane * 4 + 256 * j);
    for (int r = gw; r < NB * SEQ; r += NGW) {
        const int b = r >> 11, t = r & 2047; const unsigned long long* xr = (const unsigned long long*)(X + ((size_t)b * RB + t) * D) + lane;
        f32x4 v[4]; float s = 0.f;
#pragma unroll
        for (int j = 0; j < 4; ++j) { const unsigned long long w = xr[64 * j]; const unsigned lo = (unsigned)w, hi = (unsigned)(w >> 32);
            v[j] = (f32x4){__builtin_bit_cast(float, lo << 16), __builtin_bit_cast(float, lo & 0xffff0000u), __builtin_bit_cast(float, hi << 16), __builtin_bit_cast(float, hi & 0xffff0000u)};
            s += (v[j].x * v[j].x + v[j].y * v[j].y) + (v[j].z * v[j].z + v[j].w * v[j].w); }
        const float rr = __builtin_amdgcn_rsqf(wave_sum(s) * (1.f / D) + EPS);
        float* orow = A->out + (size_t)r * D + lane * 4;
#pragma unroll
        for (int j = 0; j < 4; ++j) *(f32x4*)(orow + 256 * j) = v[j] * rr * gv[j];
    }
}
typedef unsigned u32x4v __attribute__((ext_vector_type(4)));
__device__ __forceinline__ float xor_sum8(float v) { return xl::sum8(v); }
__device__ __forceinline__ void head8(float (&x)[8], int lane, bool norm, const float (&gain)[8], bool latent, const float2* tab, int t, float outscale) {
    if (norm) { float ss = 0.f;
#pragma unroll
        for (int j = 0; j < 8; ++j) ss += x[j] * x[j];
        const float rs = __builtin_amdgcn_rsqf(xor_sum8(ss) * (1.f / 64.f) + EPS);
#pragma unroll
        for (int j = 0; j < 8; ++j) x[j] *= rs * gain[j]; }
    if (latent) {
        const int pos = (lane & 4) ? (t & 63) : (t >> 6); const f32x4* tp = (const f32x4*)(tab + pos * 16 + 8 * (lane & 1));
        const bool second = lane & 2;
#pragma unroll
        for (int j4 = 0; j4 < 4; ++j4) { const f32x4 cs = tp[j4];
            const float p0 = xl::xor2(x[2 * j4]), p1 = xl::xor2(x[2 * j4 + 1]);
            x[2 * j4] = x[2 * j4] * cs[0] + (second ? p0 : -p0) * cs[1]; x[2 * j4 + 1] = x[2 * j4 + 1] * cs[2] + (second ? p1 : -p1) * cs[3]; }
    }
#pragma unroll
    for (int j = 0; j < 8; ++j) x[j] *= outscale;
}
__device__ __forceinline__ void unpack8(const u32x4v w, float (&x)[8]) {
#pragma unroll
    for (int j = 0; j < 4; ++j) { x[2 * j] = __builtin_bit_cast(float, w[j] << 16); x[2 * j + 1] = __builtin_bit_cast(float, w[j] & 0xffff0000u); } }
__device__ __forceinline__ u32x4v pack8(const float (&x)[8]) { u32x4v w; w[0] = pk2(x[0], x[1]); w[1] = pk2(x[2], x[3]); w[2] = pk2(x[4], x[5]); w[3] = pk2(x[6], x[7]); return w; }
}
namespace fwpost {
struct Ctx { unsigned short* P; int ld; int even; const float* qn; const float* kn; const float2* tab; const float* LR; float* DEC; const float* gkw; const float* gkb; };
__device__ __forceinline__ void run(const Ctx& c, int pm, int pn, int tid_in) {
    using namespace fw;
    int tid = tid_in; asm volatile("" : "+v"(tid));
    const int lane = tid & 63, wave = __builtin_amdgcn_readfirstlane(tid >> 6); const int b = pm / 9, j = pm - 9 * b; const bool latent = j < 8; const int t0 = 256 * j;
    const size_t m0 = (size_t)pm * 256;
    const bool ktile = c.even ? pn == 8 : pn == 4;
    float gain[8];
#pragma unroll
    for (int q = 0; q < 8; ++q) gain[q] = c.even ? (ktile ? c.kn : c.qn)[8 * (lane & 7) + q] : 1.f;
    if (!ktile) return;
    if (c.even || latent) {
        unsigned short* p0 = c.P + (m0 + wave * 32 + (lane >> 4)) * c.ld + pn * 256 + 8 * (lane & 15);
#pragma nounroll
        for (int h4 = 0; h4 < 2; ++h4) {
            u32x4v raw[4];
#pragma unroll
            for (int s = 0; s < 4; ++s) raw[s] = *(const u32x4v*)(p0 + (size_t)(16 * h4 + 4 * s) * c.ld);
#pragma unroll
            for (int s = 0; s < 4; ++s) { float x[8]; unpack8(raw[s], x); head8(x, lane, c.even, gain, latent, c.tab, t0 + wave * 32 + 16 * h4 + 4 * s + (lane >> 4), 1.f); raw[s] = pack8(x); }
#pragma unroll
            for (int s = 0; s < 4; ++s) *(u32x4v*)(p0 + (size_t)(16 * h4 + 4 * s) * c.ld) = raw[s];
        }
    }
}
}
namespace fw {
__device__ __forceinline__ gla::Ctx gla_base(ArgP A, int i) {
    gla::Ctx X; X.P = (const gla::bf16*)(A->ws + WS_PROJ); X.DEC = (float*)(A->ws + WS_DEC); X.LR = (const float*)(A->ws + WS_LR); X.gkw = A->in[I_GKW] + (size_t)i * 2 * 16 * 256; X.gkb = A->in[I_GKB] + (size_t)i * 512; X.mbase = 0; X.h = 0; X.bh = 0;
    X.US = (gla::bf16*)(A->ws + WS_US); X.SB = (gla::bf16*)(A->ws + WS_SB); X.DD = (float*)(A->ws + WS_DD); X.MIX = (gla::bf16*)(A->ws + WS_MIX); X.gg = A->in[I_GLAG] + i * 64; return X;
}
__device__ __forceinline__ int q_next(gu32* ctr, volatile LAS unsigned* slot, int tid) {
    __syncthreads();
    if (tid == 0) slot[0] = __hip_atomic_fetch_add(ctr, 1u, RLX_AGENT);
    __syncthreads();
    return (int)slot[0];
}
__device__ __forceinline__ void mixer_even(ArgP A, int l, LAS unsigned char* ldsl, char* lds, volatile LAS unsigned* MISC, int tid, int rep) {
    const int i = l >> 1; gu32* ctr = (gu32*)(A->ws + WS_CTL) + CW_Q + 64 * l + 16 * rep;
    const ab::bf16* P = (const ab::bf16*)(A->ws + WS_PROJ); ab::bf16* MIXp = (ab::bf16*)(A->ws + WS_MIX);
    constexpr int NSCAN = 64;
    const int total = NSCAN + 512 + 64;
    int qi = q_next(ctr, MISC + 16, tid);
    while (qi < total) {
        const int idx = qi - NSCAN;
        if (idx < 0) {
#ifndef NO_GLA
            { int t_ = tid; asm volatile("" : "+v"(t_)); const int sidx = idx + NSCAN;
              const gla::Ctx X = gla::ctx_of(gla_base(A, i), sidx); gla::unit_b(X, (__attribute__((address_space(3))) char*)ldsl, t_);
            }
#endif
        } else {
            ab::AUnit U; int b, head, j;
            if (idx < 512) { const int r = idx; b = r >> 6; head = (r >> 3) & 7; j = r & 7; U.r1 = 0; U.NT = 36; }
            else { const int r = idx - 512; b = r >> 3; head = r & 7; j = 8; U.r1 = SEQ; U.NT = 4; }
            const size_t row0 = (size_t)b * RB, qrow = row0 + 256 * j;
            U.Q = P + qrow * LDE + E_BQ + 64 * head; U.K = P + row0 * LDE + E_BK + 64 * (head >> 2); U.V = P + row0 * LDE + E_BV + 64 * (head >> 2);
            U.O = MIXp + qrow * 1024 + 512 + 64 * head; U.r2 = 0; U.q0 = 256 * j; U.sink2 = -INFINITY; U.sinkv = nullptr; U.qgain = A->in[I_QNG] + i * 64; U.tab = j < 8 ? (const float2*)(A->ws + WS_TAB) : nullptr;
#ifndef NO_ATTB
            { int t_ = tid; asm volatile("" : "+v"(t_)); ab::attn_unit<LDE, 0, 8, false>(U, lds, t_); }
#endif
        }
        qi = q_next(ctr, MISC + 16, tid);
    }
}
__device__ __forceinline__ void mixer_odd(ArgP A, int l, bool with_ctx, char* lds, volatile LAS unsigned* MISC, int tid, int rep, int vcu, int G) {
    const int i = l >> 1; (void)MISC; (void)rep;
    const ab::bf16* P = (const ab::bf16*)(A->ws + WS_PROJ); ab::bf16* MIXp = (ab::bf16*)(A->ws + WS_MIX);
    const int total = 1024 + (with_ctx ? 128 : 0);
    int idx = vcu; bool in_ctx = false;
    if (idx >= 1024) { idx = 1024 + vcu; in_ctx = true; }
    while (idx < total) {
        ab::AUnit U; int b, kvh, q0; bool latent;
        U.r1 = SEQ;
        if (idx < 1024) { b = idx >> 7; kvh = (idx >> 6) & 1; q0 = 32 * (idx & 63); latent = true;
            int lo = max(0, (q0 - 128) & ~63), hi = min(SEQ, ((q0 + 159) | 63) + 1);
            U.r2 = lo; U.NT = 4 + (hi - lo) / 64; }
        else { const int r = idx - 1024; b = r >> 4; kvh = (r >> 3) & 1; q0 = SEQ + 32 * (r & 7); latent = false; U.r2 = 0; U.NT = 4; }
        const size_t row0 = (size_t)b * RB, qrow = row0 + q0;
        U.Q = P + qrow * LDO + O_Q + 512 * kvh; U.K = P + row0 * LDO + O_K + 64 * kvh; U.V = P + row0 * LDO + O_V + 64 * kvh;
        U.O = MIXp + qrow * 1024 + 512 * kvh; U.q0 = q0; U.sink2 = 0.f; U.sinkv = A->in[I_SINK] + i * 16 + 8 * kvh; U.qgain = nullptr; U.tab = latent ? (const float2*)(A->ws + WS_TAB) : nullptr;
#ifndef NO_ATTC
        { int t_ = tid; asm volatile("" : "+v"(t_)); ab::attn_unit<LDO, 1, 8, true>(U, lds, t_); }
#endif
        if (!in_ctx) { idx += G; if (idx >= 1024) { idx = 1024 + vcu; in_ctx = true; } } else idx += G;
    }
}

#ifndef REPEAT_N
#define REPEAT_N 1
#endif
#ifndef REPEAT_PARITY
#define REPEAT_OK(ph) true
#else
#define REPEAT_OK(ph) ((ph) == 0 || (ph) == N_PHASES - 1 || (((((ph) - 1) / PH_PER_LAYER) & 1) == REPEAT_PARITY))
#endif
#ifndef KSPLIT_DOWN
#define KSPLIT_DOWN 8
#endif
__global__ void __launch_bounds__(NWAVES * 64, 2) fwd(Args A_) {
    extern __shared__ __attribute__((aligned(16))) unsigned char lds[];
    LAS unsigned char* ldsl = (LAS unsigned char*)lds;
    volatile LAS unsigned* MISC = (volatile LAS unsigned*)(ldsl + MISC_OFF);
    for (int u = threadIdx.x; u < (LDS_BYTES - GLA_LDS_BYTES) / 4; u += NWAVES * 64) ((LAS unsigned*)(ldsl + GLA_LDS_BYTES))[u] = 0u;
    __syncthreads();
    const int wave_s = __builtin_amdgcn_readfirstlane(threadIdx.x >> 6);
    const int ph_lo = A_.ph_lo, ph_hi = A_.ph_hi;
    gu32* ctl = (gu32*)(A_.ws + WS_CTL);
    XcdBarrier bar; bar.bar = (unsigned*)(ctl + CW_BAR); bar.x = 0; bar.st = nullptr;
    const bool multi = (ph_hi - ph_lo) > 1;
    if (multi) bar = xcd_barrier_post((unsigned*)(ctl + CW_BAR), MISC + 8);
    int rep_ = 0;
#pragma nounroll
    for (int ph = ph_lo; ph < ph_hi; ++ph) {
        if (!phase_active(ph)) continue;
        ArgP A = (ArgP)__builtin_amdgcn_kernarg_segment_ptr(); asm volatile("" : "+s"(A));
        const int lane = olane(), wave = wave_s, tid = wave * 64 + lane;
        const int G = ogrid(), bx = obid(), vcu = (G % 8 == 0) ? (bx % 8) * (G / 8) + bx / 8 : bx;
        const int gw = vcu * NWAVES + wave, NGW = G * NWAVES;
        if (ph == 0) {
#ifndef NO_P0M
            p0_mods(A, ldsl, 0, 1, vcu, G, tid, lane, wave);
#endif
            __syncthreads();
#ifndef NO_P0W
#ifdef P0_DEFER
            conv_layer(A, 0, ldsl, gw, NGW, lane, wave, 1);
#else
            conv_layer(A, 0, ldsl, gw, NGW, lane, wave);
#endif
#endif
#ifndef NO_P0T
            if (vcu == G - 1) p0_tab(A, tid);
#endif
        } else if (ph == N_PHASES - 1) {
            final_phase(A, gw, NGW, lane);
        } else {
            const int l = (ph - 1) / PH_PER_LAYER, s = (ph - 1) - l * PH_PER_LAYER, i = l >> 1; const bool odd = l & 1, with_ctx = l < DEPTH - 1;
            unsigned char* wl = A->ws + WS_W + w_layer_off(l); const size_t w_in_b = odd ? W_IN_O : W_IN_E;
            const float* mod = (const float*)(A->ws + WS_MOD) + (size_t)l * 9 * 6144;
            if (s == S_NORM1) { cb_layer(A, 0, ldsl, gw, NGW, tid, lane); xg_phase(A, gw, NGW, lane); }
            else if (s == S_G1) {
                pg8::Gemm g{(const pg8::bf16_t*)(A->ws + WS_HN), (const pg8::bf16_t*)wl, M, odd ? LDO : LDE, D, (float*)(A->ws + WS_SLAB), (unsigned*)(A->ws + WS_CTL) + CW_SPLIT + (4 * l + 0) * 2048};
                pg8::RowSched S; S.init(0, odd ? LDO : LDE, G, bx, D);
                rtab_build(S, (const float*)(A->ws + WS_SQ), (LAS float*)(ldsl + RTAB_OFF), tid);
                const fwpost::Ctx pc{(unsigned short*)(A->ws + WS_PROJ), odd ? LDO : LDE, odd ? 0 : 1, A->in[I_QNG] + i * 64, A->in[I_KNG] + i * 64, (const float2*)(A->ws + WS_TAB), (const float*)(A->ws + WS_LR),
                                     (float*)(A->ws + WS_DEC), A->in[I_GKW] + (size_t)i * 2 * 16 * 256, A->in[I_GKB] + (size_t)i * 512};
                pg8::EpiProj E{(pg8::bf16_t*)(A->ws + WS_PROJ), odd ? LDO : LDE, (float*)(A->ws + WS_LR), odd ? -1 : 9, (const LAS float*)(ldsl + RTAB_OFF), (const float*)(A->ws + WS_CB), LDE, &pc, odd ? 4 : 8, odd ? 4 : 8};
#ifndef NO_G1
                pg8::gemm_phase<pg8::EpiProj, pg8::RowSched, true, true>(ldsl, g, S, E, tid);
#endif
            }
            else if (s == S_GLAA) { gla::phase_a(gla_base(A, i), (__attribute__((address_space(3))) char*)ldsl, gw, NGW, wave, lane); }
            else if (s == S_GLAC) { gla::phase_c(gla_base(A, i), (__attribute__((address_space(3))) char*)ldsl, gw, NGW, wave, lane); }
            else if (s == S_MIX) { if (odd) mixer_odd(A, l, with_ctx, (char*)lds, MISC, tid, rep_, vcu, G); else mixer_even(A, l, ldsl, (char*)lds, MISC, tid, rep_); }
            else {
                const bool do_resid = s == S_G2 || s == S_G4 || (s == S_G3 && with_ctx && rep_ == 0), do_up = s == S_G3 || s == S_G3B;
                {
                    const bool down = s == S_G4; const int rows = s == S_G2 ? 1 : (s == S_G3 ? 2 : (with_ctx ? 0 : 1));
                    int t_ = tid; asm volatile("" : "+v"(t_));
                    if (do_resid) {
                        int busy_ = 0;
#pragma nounroll
                        for (int pass = 0; pass < 2; ++pass) {
                        int tp_ = wave * 64 + olane(); asm volatile("" : "+v"(tp_));
                        pg8::Gemm g{(const pg8::bf16_t*)(A->ws + (down ? WS_H : WS_MIX)), (const pg8::bf16_t*)(wl + w_in_b + (down ? W_OUT + W_13 : 0)), M, D, down ? FFH : D, (float*)(A->ws + WS_SLAB), (unsigned*)(A->ws + WS_CTL) + CW_SPLIT + (4 * l + (down ? 3 : 1)) * 2048};
                        pg8::RowSched S; S.init(rows, D, G, bx, down ? FFH : D, down ? KSPLIT_DOWN : 1);
#ifdef DOWN_TWO_PASS
                        const bool two = S.sp > 1;
#else
                        const bool two = false;
#endif
                        if (pass == 1 && !two) break;
                        if (two) { if (pass == 0) S.i_hi = S.R - 1; else S.i_lo = S.R - 1; }
                        busy_ = S.sp > 1 ? S.rem * S.sp : (S.rem < G ? S.rem : 0);
#ifdef REPEAT_MASK
                        const bool dry_ = ((REPEAT_MASK >> s) & 1) && rep_ < REPEAT_N && REPEAT_OK(ph) && s != S_G3;
#endif
                        const bool emit = !(down && l + 1 == DEPTH); const int nl = down ? l + 1 : l;
                        const bool last = down && l + 1 == DEPTH;
                        pg8::bf16_t* XB = (pg8::bf16_t*)A->out; pg8::bf16_t* XM = (pg8::bf16_t*)(A->ws + WS_XMID);
                        pg8::bf16_t* xo = last ? (pg8::bf16_t*)(A->ws + WS_HN) : (down ? XB : XM);
#ifdef REPEAT_MASK
                        if (dry_) xo = (pg8::bf16_t*)(A->ws + WS_SLAB);
#endif
                        pg8::EpiResid E{down ? XM : XB, xo, mod + (down ? 5 : 2) * D,
                                        emit, (pg8::bf16_t*)(A->ws + WS_HN), (float*)(A->ws + WS_SQ), (down ? A->in[I_N1G] : A->in[I_N2G]) + (size_t)(emit ? nl : 0) * D,
                                        (const float*)(A->ws + WS_MOD) + (size_t)(emit ? nl : 0) * 9 * 6144 + (down ? 1 : 4) * D, ldsl};
#ifndef NO_G2
                        pg8::gemm_phase<pg8::EpiResid, pg8::RowSched, true, true>(ldsl, g, S, E, tp_);
#endif
                        }
                        if (down && l + 1 < DEPTH && rep_ == 0) {
                            const int busy = busy_;
                            const bool all = busy >= G || busy == 0, mine = all || bx >= busy;
                            const int ln2 = olane();
                            cb_layer(A, l + 1, ldsl, mine ? (all ? gw : (bx - busy) * NWAVES + wave) : -1, all ? NGW : (G - busy) * NWAVES, wave * 64 + ln2, ln2);
                        }
                    }
                }
                {
                    const int rows = s == S_G3 ? 1 : 2, skew = (s == S_G3 && with_ctx) ? 32 : 0;
                    int t_ = tid; asm volatile("" : "+v"(t_));
                    if (do_up) {
                        pg8::Gemm g{(const pg8::bf16_t*)(A->ws + WS_HN), (const pg8::bf16_t*)(wl + w_in_b + W_OUT), M, 2 * FFH, D, (float*)(A->ws + WS_SLAB), (unsigned*)(A->ws + WS_CTL) + CW_SPLIT + (4 * l + 2) * 2048};
                        pg8::RowSched S; S.init(rows, 2 * FFH, G, bx, D, 1, skew);
                        rtab_build(S, (const float*)(A->ws + WS_SQ), (LAS float*)(ldsl + RTAB_OFF), t_);
                        pg8::EpiSwiglu E{(pg8::bf16_t*)(A->ws + WS_H), FFH, (const LAS float*)(ldsl + RTAB_OFF), (const float*)(A->ws + WS_CB) + (size_t)9 * LDE, 2 * FFH};
#ifndef NO_G3
                        pg8::gemm_phase<pg8::EpiSwiglu, pg8::RowSched, true, true>(ldsl, g, S, E, t_);
#endif
                        if (s == S_G3 && skew > 0 && l + 1 < DEPTH && rep_ == 0 && bx < skew) { const int ln2 = olane(); p0_mods(A, ldsl, l + 1, 1, bx, skew, wave * 64 + ln2, ln2, wave);
#ifdef P0_DEFER
                            if (l == 0) { __syncthreads(); conv_layer(A, 0, ldsl, bx * NWAVES + wave, skew * NWAVES, ln2, wave, 3); }
#endif
                        }
                        if (s == S_G3B && rep_ == 0) {
                            const int busy = S.so.nwg < G ? S.so.nwg : G;
                            const int ln2 = olane();
                            if (busy >= G) conv_layer(A, l + 1, ldsl, gw, NGW, ln2, wave); else if (bx >= busy) conv_layer(A, l + 1, ldsl, (bx - busy) * NWAVES + wave, (G - busy) * NWAVES, ln2, wave);
                        }
                    }
                }
            }
        }
#ifdef REPEAT_BAR
        if (ph + 1 < ph_hi) xcd_barrier(bar, tid == 0);
#endif
#ifdef REPEAT_MASK
        { const int s_ = (ph == 0) ? 12 : (ph == N_PHASES - 1 ? 13 : ((ph - 1) % PH_PER_LAYER)); if (((REPEAT_MASK >> s_) & 1) && rep_ < REPEAT_N && REPEAT_OK(ph)) { ++rep_; --ph; xcd_barrier(bar, tid == 0); continue; } rep_ = 0; }
#endif
        if (ph + 1 < ph_hi) xcd_barrier(bar, tid == 0);
    }
}

inline int grid_size() {
    static int grid = 0;
    if (grid == 0) {
        int dev = 0, cus = 0, per_cu = 0;
        if (hipGetDevice(&dev) != hipSuccess || hipDeviceGetAttribute(&cus, hipDeviceAttributeMultiprocessorCount, dev) != hipSuccess) { grid = -1; return grid; }
        if (hipFuncSetAttribute((const void*)fwd, hipFuncAttributeMaxDynamicSharedMemorySize, LDS_BYTES) != hipSuccess) { grid = -1; return grid; }
        if (hipOccupancyMaxActiveBlocksPerMultiprocessor(&per_cu, (const void*)fwd, NWAVES * 64, LDS_BYTES) != hipSuccess || per_cu < 1) per_cu = 1;
        (void)hipGetLastError();
        grid = cus;
    }
    return grid;
}
inline void launch_phases(hipStream_t st, const Args& a0, int lo, int hi) { Args a = a0; a.ph_lo = lo; a.ph_hi = hi; hipLaunchKernelGGL(fwd, dim3(grid_size()), dim3(NWAVES * 64), LDS_BYTES, st, a); }
inline Args make_args(void* const* d_in, void* d_out, void* d_ws) { Args a{}; for (int i = 0; i < 22; ++i) a.in[i] = (const float*)d_in[i]; a.out = (float*)d_out; a.ws = (unsigned char*)d_ws; return a; }
}
#ifndef MK_PER_PHASE
#define MK_PER_PHASE 1
#endif
extern "C" void kernel_launch(void* const* d_in, const int* in_sizes, int n_in, void* d_out, int out_size, void* d_ws, size_t ws_size, hipStream_t stream) {
    if (fw::grid_size() <= 0 || ws_size < fw::WS_END) return;
    (void)hipMemsetAsync((char*)d_ws + fw::WS_CTL, 0, fw::CTL_ZERO_BYTES, stream);
    const fw::Args a = fw::make_args(d_in, d_out, d_ws);
#if MK_PER_PHASE
    for (int ph = 0; ph < fw::N_PHASES; ++ph) if (fw::phase_active(ph)) fw::launch_phases(stream, a, ph, ph + 1);
#else
    fw::launch_phases(stream, a, 0, fw::N_PHASES);
#endif
}
```
